# Optimizing an MI355X kernel written in HIP

```python
import jax, jax.numpy as jnp
from jax import lax
import numpy as np

D_MODEL = 2048
BATCH = 4
SEQ = 8192
DEPTH = 2

GRID_W = 64
PLE_DIM = 256
EPS = 1e-6
NA_HEAD_DIM = 128
NA_HEADS = D_MODEL // NA_HEAD_DIM
NA_WIDTH = NA_HEADS * NA_HEAD_DIM
NA_KH_MAX = 8
NA_KW = 16
RET_HEADS = 8
RET_QK_DIM = D_MODEL // RET_HEADS
RET_V_DIM = D_MODEL // RET_HEADS
RET_QK_WIDTH = RET_HEADS * RET_QK_DIM
RET_V_WIDTH = RET_HEADS * RET_V_DIM
RET_CHUNK = 128
ROPE_BASE = 10000.0
IN_SPLITS = (NA_WIDTH, NA_WIDTH, NA_WIDTH, RET_QK_WIDTH, RET_QK_WIDTH, RET_V_WIDTH, RET_V_WIDTH, D_MODEL, D_MODEL)
N_IN = 3 * NA_WIDTH + 2 * RET_QK_WIDTH + 2 * RET_V_WIDTH + 2 * D_MODEL
N_GROUPS = 4
EXPERTS_PER_GROUP = 8
N_EXPERTS = N_GROUPS * EXPERTS_PER_GROUP
TOP_K = 2
D_FF_EXPERT = D_MODEL // 4
MOE_BLOCK = 128

kernel_name = "hybrid_na_retention_hmoe_encoder"


def rmsnorm(x, g):
    xf = x.astype(jnp.float32)
    y = xf * lax.rsqrt(jnp.mean(xf * xf, axis=-1, keepdims=True) + EPS)
    return (y * g.astype(jnp.float32)).astype(x.dtype)


def rotary(x, pos):
    half = x.shape[-1] // 2
    inv = ROPE_BASE ** (-jnp.arange(half, dtype=jnp.float32) / half)
    ang = pos.astype(jnp.float32)[:, None] * inv[None, :]
    cos = jnp.cos(ang)[None, :, None, :].astype(x.dtype)
    sin = jnp.sin(ang)[None, :, None, :].astype(x.dtype)
    x1, x2 = x[..., :half], x[..., half:]
    return jnp.concatenate([x1 * cos - x2 * sin, x1 * sin + x2 * cos], axis=-1)


def neighbourhood_attention(q, k, v, rpb):
    B, S, H, d = q.shape
    rows = S // GRID_W
    kh = min(NA_KH_MAX, rows)

    def grid(t):
        return t.reshape(B, rows, GRID_W, H, d).transpose(0, 3, 1, 2, 4)

    qg = grid(q * (d ** -0.5))
    kg, vg = grid(k), grid(v)
    col = jnp.arange(GRID_W)
    cs = jnp.clip(col - NA_KW // 2, 0, GRID_W - NA_KW)
    col_mask = (col[None, :] >= cs[:, None]) & (col[None, :] < cs[:, None] + NA_KW)
    dc_idx = jnp.clip(col[None, :] - col[:, None], -(NA_KW - 1), NA_KW - 1) + (NA_KW - 1)
    rpb_f = rpb.astype(jnp.float32)

    def row_block(r):
        rs = jnp.clip(r - kh // 2, 0, rows - kh)
        qr = lax.dynamic_index_in_dim(qg, r, axis=2, keepdims=False)
        kb = lax.dynamic_slice_in_dim(kg, rs, kh, axis=2)
        vb = lax.dynamic_slice_in_dim(vg, rs, kh, axis=2)
        dr_idx = rs + jnp.arange(kh) - r + (NA_KH_MAX - 1)
        bias = rpb_f[:, dr_idx[None, :, None], dc_idx[:, None, :]]
        s = jnp.einsum('bhqd,bhiwd->bhqiw', qr, kb).astype(jnp.float32) + bias[None]
        s = jnp.where(col_mask[:, None, :], s, -1e30)
        prob = jax.nn.softmax(s.reshape(B, H, GRID_W, kh * GRID_W), axis=-1)
        prob = prob.reshape(B, H, GRID_W, kh, GRID_W).astype(v.dtype)
        return jnp.einsum('bhqiw,bhiwd->bhqd', prob, vb)

    out = lax.map(row_block, jnp.arange(rows))
    return out.transpose(1, 0, 3, 2, 4).reshape(B, S, H * d)


def retention_direction(q, k, v, log_gamma, include_diag):
    B, H, S, dk = q.shape
    dv = v.shape[-1]
    C = RET_CHUNK
    n = S // C
    i = jnp.arange(C, dtype=jnp.float32)
    diff = i[:, None] - i[None, :]
    mask = (diff >= 0) if include_diag else (diff > 0)
    lg = log_gamma[:, None, None]
    d_intra = jnp.where(mask[None], jnp.exp(jnp.maximum(diff, 0.0)[None] * lg), 0.0).astype(q.dtype)
    xi = jnp.exp((i + 1.0)[None, :] * log_gamma[:, None]).astype(q.dtype)[:, :, None]
    zeta = jnp.exp((C - 1.0 - i)[None, :] * log_gamma[:, None]).astype(q.dtype)[:, :, None]
    chunk_decay = jnp.exp(C * log_gamma).astype(q.dtype)[:, None, None]

    def chunks(t):
        return t.reshape(B, H, n, C, t.shape[-1]).transpose(2, 0, 1, 3, 4)

    def step(state, inp):
        qc, kc, vc = inp
        intra = jnp.einsum('bhij,bhjv->bhiv', jnp.einsum('bhid,bhjd->bhij', qc, kc) * d_intra, vc)
        cross = jnp.einsum('bhid,bhdv->bhiv', qc, state) * xi
        state = state * chunk_decay + jnp.einsum('bhjd,bhjv->bhdv', kc * zeta, vc)
        return state, intra + cross

    state0 = jnp.zeros((B, H, dk, dv), q.dtype)
    _, out = lax.scan(step, state0, (chunks(q), chunks(k), chunks(v)))
    return out.transpose(1, 2, 0, 3, 4).reshape(B, H, S, dv)


def token_mixer(h, w_in, rpb, dec_f, dec_b, gn_g, w_out):
    B, S, _ = h.shape
    proj = h @ w_in
    split_at = np.cumsum(np.array(IN_SPLITS))[:-1].tolist()
    na_q, na_k, na_v, r_q, r_k, r_v, r_g, gate_na, gate_ret = jnp.split(proj, split_at, axis=-1)
    na = neighbourhood_attention(na_q.reshape(B, S, NA_HEADS, NA_HEAD_DIM),
                                 na_k.reshape(B, S, NA_HEADS, NA_HEAD_DIM),
                                 na_v.reshape(B, S, NA_HEADS, NA_HEAD_DIM), rpb)
    pos = jnp.arange(S)
    rq = rotary(r_q.reshape(B, S, RET_HEADS, RET_QK_DIM), pos).transpose(0, 2, 1, 3)
    rk = (rotary(r_k.reshape(B, S, RET_HEADS, RET_QK_DIM), pos) * (RET_QK_DIM ** -0.5)).transpose(0, 2, 1, 3)
    rv = r_v.reshape(B, S, RET_HEADS, RET_V_DIM).transpose(0, 2, 1, 3)
    lg_f = jax.nn.log_sigmoid(dec_f.astype(jnp.float32))
    lg_b = jax.nn.log_sigmoid(dec_b.astype(jnp.float32))
    fwd = retention_direction(rq, rk, rv, lg_f, True)
    bwd = retention_direction(rq[:, :, ::-1], rk[:, :, ::-1], rv[:, :, ::-1], lg_b, False)[:, :, ::-1]
    rf = (fwd + bwd).astype(jnp.float32)
    mu = jnp.mean(rf, axis=-1, keepdims=True)
    var = jnp.mean(jnp.square(rf - mu), axis=-1, keepdims=True)
    rn = ((rf - mu) * lax.rsqrt(var + EPS)).transpose(0, 2, 1, 3).reshape(B, S, RET_V_WIDTH)
    ret = (rn * gn_g.astype(jnp.float32)).astype(h.dtype) * jax.nn.silu(r_g)
    mix = jax.nn.sigmoid(gate_na) * na + jax.nn.sigmoid(gate_ret) * ret
    return mix @ w_out


def hierarchical_moe(h, w_rg, w_re, w_g, w_u, w_d):
    B, S, D = h.shape
    T = B * S
    ht = h.reshape(T, D)
    g_prob = jax.nn.softmax((ht @ w_rg).astype(jnp.float32), axis=-1)
    p_g, g_sel = lax.top_k(g_prob, 1)
    p_g, g_sel = p_g[:, 0], g_sel[:, 0]
    e_logits = (ht @ w_re).astype(jnp.float32).reshape(T, N_GROUPS, EXPERTS_PER_GROUP)
    e_sel = jnp.take_along_axis(e_logits, g_sel[:, None, None], axis=1)[:, 0]
    top_v, top_i = lax.top_k(e_sel, TOP_K)
    weights = p_g[:, None] * jax.nn.softmax(top_v, axis=-1)
    eid = (g_sel[:, None] * EXPERTS_PER_GROUP + top_i).reshape(-1).astype(jnp.int32)
    tok = jnp.repeat(jnp.arange(T, dtype=jnp.int32), TOP_K)
    wts = weights.reshape(-1)
    A = T * TOP_K
    order = jnp.argsort(eid)
    se, stok, sw = eid[order], tok[order], wts[order]
    counts = jax.ops.segment_sum(jnp.ones_like(eid), eid, num_segments=N_EXPERTS)
    starts = jnp.cumsum(counts) - counts
    blocks_per = (counts + MOE_BLOCK - 1) // MOE_BLOCK
    blk_end = jnp.cumsum(blocks_per)
    blk_start = blk_end - blocks_per
    dest = blk_start[se] * MOE_BLOCK + (jnp.arange(A, dtype=jnp.int32) - starts[se])
    nb = -(-A // MOE_BLOCK) + N_EXPERTS
    xp = jnp.zeros((nb * MOE_BLOCK, D), h.dtype).at[dest].set(ht[stok])
    block_expert = jnp.clip(jnp.searchsorted(blk_end, jnp.arange(nb), side='right'), 0, N_EXPERTS - 1)

    def expert_block(args):
        xb, e = args
        return (jax.nn.silu(xb @ w_g[e]) * (xb @ w_u[e])) @ w_d[e]

    yp = lax.map(expert_block, (xp.reshape(nb, MOE_BLOCK, D), block_expert)).reshape(nb * MOE_BLOCK, D)
    y = jnp.zeros((T, D), h.dtype).at[stok].add(yp[dest] * sw[:, None].astype(h.dtype))
    return y.reshape(B, S, D)


def setup_inputs(seed: int = 0) -> dict:
    key = jax.random.key(seed)
    ks = jax.random.split(key, 20)

    def nrm(k, shape, scale):
        return jax.random.normal(k, shape, jnp.float32) * scale

    base_decay = jnp.log(2.0 ** (5.0 + jnp.arange(RET_HEADS, dtype=jnp.float32)) - 1.0)
    return {
        "x": nrm(ks[0], (BATCH, SEQ, D_MODEL), 1.0),
        "p": nrm(ks[1], (DEPTH, BATCH, SEQ, PLE_DIM), 1.0),
        "norm_mix": 1.0 + nrm(ks[2], (DEPTH, D_MODEL), 0.05),
        "w_in": nrm(ks[3], (DEPTH, D_MODEL, N_IN), D_MODEL ** -0.5),
        "na_rpb": nrm(ks[4], (DEPTH, NA_HEADS, 2 * NA_KH_MAX - 1, 2 * NA_KW - 1), 0.1),
        "ret_decay_fwd": base_decay[None, :] + nrm(ks[5], (DEPTH, RET_HEADS), 0.1),
        "ret_decay_bwd": base_decay[None, :] + nrm(ks[6], (DEPTH, RET_HEADS), 0.1),
        "ret_gn": 1.0 + nrm(ks[7], (DEPTH, RET_V_WIDTH), 0.05),
        "w_out": nrm(ks[8], (DEPTH, D_MODEL, D_MODEL), D_MODEL ** -0.5),
        "norm_ffn": 1.0 + nrm(ks[9], (DEPTH, D_MODEL), 0.05),
        "w_router_group": nrm(ks[10], (DEPTH, D_MODEL, N_GROUPS), D_MODEL ** -0.5),
        "w_router_expert": nrm(ks[11], (DEPTH, D_MODEL, N_EXPERTS), D_MODEL ** -0.5),
        "w_gate_e": nrm(ks[12], (DEPTH, N_EXPERTS, D_MODEL, D_FF_EXPERT), D_MODEL ** -0.5),
        "w_up_e": nrm(ks[13], (DEPTH, N_EXPERTS, D_MODEL, D_FF_EXPERT), D_MODEL ** -0.5),
        "w_down_e": nrm(ks[14], (DEPTH, N_EXPERTS, D_FF_EXPERT, D_MODEL), D_FF_EXPERT ** -0.5),
        "norm_ple": 1.0 + nrm(ks[15], (DEPTH, D_MODEL), 0.05),
        "w_ple_gate": nrm(ks[16], (DEPTH, D_MODEL, D_MODEL), D_MODEL ** -0.5),
        "w_ple_proj": nrm(ks[17], (DEPTH, PLE_DIM, D_MODEL), PLE_DIM ** -0.5),
        "norm_final": 1.0 + nrm(ks[18], (D_MODEL,), 0.05),
    }


def reference(x, p, norm_mix, w_in, na_rpb, ret_decay_fwd, ret_decay_bwd, ret_gn, w_out,
              norm_ffn, w_router_group, w_router_expert, w_gate_e, w_up_e, w_down_e,
              norm_ple, w_ple_gate, w_ple_proj, norm_final):
    for i in range(DEPTH):
        h = rmsnorm(x, norm_mix[i])
        x = x + token_mixer(h, w_in[i], na_rpb[i], ret_decay_fwd[i], ret_decay_bwd[i], ret_gn[i], w_out[i])
        h = rmsnorm(x, norm_ffn[i])
        x = x + hierarchical_moe(h, w_router_group[i], w_router_expert[i], w_gate_e[i], w_up_e[i], w_down_e[i])
        gate = jax.nn.sigmoid(rmsnorm(x, norm_ple[i]) @ w_ple_gate[i])
        x = x + gate * (p[i] @ w_ple_proj[i])
    return rmsnorm(x, norm_final)
```

```cpp
#include <hip/hip_runtime.h>
#include <cstdio>
#include <cstdint>
namespace pg8 {
#define PG8_LAS __attribute__((address_space(3)))
typedef unsigned short bf16_t;
typedef short bf16x8 __attribute__((ext_vector_type(8)));
typedef float f32x4 __attribute__((ext_vector_type(4)));
typedef unsigned u32x4 __attribute__((ext_vector_type(4)));
typedef unsigned u32x2 __attribute__((ext_vector_type(2)));
constexpr int BM = 256, BK = 64, HALF = 128, HTB = HALF * BK * 2  , STAGE_BYTES = 8 * HTB, NXCD = 8, WGM = 8;

__host__ __device__ __forceinline__ int lds_byte(int r, int c) { const int st = (r >> 4) * 2 + (c >> 5), rr = r & 15, cc = c & 31, ob = rr * 64 + cc * 2; return st * 1024 + (ob ^ (((ob >> 9) & 1) << 5)); }
__host__ __device__ __forceinline__ void stage_rc(int b, int& R, int& C) { const int st = b / 1024, sb = b % 1024, swz = sb ^ (((sb >> 9) & 1) << 5); R = (st >> 1) * 16 + swz / 64; C = (st & 1) * 32 + (swz % 64) / 2; }
__host__ __device__ __forceinline__ int perm32(int rho) { const int n = rho >> 4, i = rho & 15; return 8 * (i >> 2) + 4 * n + (i & 3); }

struct Unit { int pm, pn, e; };

struct DenseOrder {
    int nM, nN, nwg, G, c;
    __device__ __forceinline__ void init(int M, int N, int G_, int c_) { nM = M / BM; nN = N / BM; nwg = nM * nN; G = G_; c = c_; }
    __device__ __forceinline__ bool next_mn(int i, int& pm, int& pn) const {
        const long L = (long)i * G + c; if (L >= nwg) return false;
        int wgid = (int)L; { const int q = nwg / NXCD, r = nwg % NXCD, xcd = wgid % NXCD, off = wgid / NXCD; wgid = (xcd < r ? xcd * (q + 1) : r * (q + 1) + (xcd - r) * q) + off; }
        const int nig = WGM * nN, gid = wgid / nig, fm = gid * WGM, gsz = (nM - fm) < WGM ? (nM - fm) : WGM;
        pm = fm + ((wgid % nig) % gsz); pn = (wgid % nig) / gsz; return true;
    }
};

__device__ __forceinline__ unsigned cvt_pk_bf16(float lo, float hi) { unsigned r; asm volatile("v_cvt_pk_bf16_f32 %0, %1, %2" : "=v"(r) : "v"(lo), "v"(hi)); return r; }

template <class Epi, class Sched>
__device__ __forceinline__ void gemm_phase(PG8_LAS unsigned char* lds, const bf16_t* Abase_, const int K, const Sched& S, const Epi& E) {
    const int tid = threadIdx.x, wid = __builtin_amdgcn_readfirstlane(tid >> 6), lane = tid & 63, wr = wid >> 2, wc = wid & 3, fr = lane & 15, fq = lane >> 4;
    const int nt = K / BK;
    const char* Abase = (const char*)Abase_;
    int RA0, RA1; unsigned CA0, CA1; unsigned voffB[2];
    { int R, C; stage_rc(tid * 16, R, C); RA0 = R; CA0 = (unsigned)C * 2u; const int Rb = Epi::PERM ? ((R & ~31) + perm32(R & 31)) : R; voffB[0] = (unsigned)(Rb * K + C) * 2u;
      stage_rc(tid * 16 + 8192, R, C); RA1 = R; CA1 = (unsigned)C * 2u; const int Rb1 = Epi::PERM ? ((R & ~31) + perm32(R & 31)) : R; voffB[1] = (unsigned)(Rb1 * K + C) * 2u; }
    const unsigned rowb = (unsigned)K * 2u;
    const size_t kstep = (size_t)(BK * 2);
    const size_t hstep = (size_t)HALF * K * 2;
    const unsigned ldsw = (unsigned)wid * 1024u;
    const int aoff = lds_byte(wr * 64 + fr, fq * 8), boff = lds_byte(wc * 32 + fr, fq * 8);
#define PG8_SA(b, h) (((b) * 2 + (h)) * HTB)
#define PG8_SB(b, h) ((4 + (b) * 2 + (h)) * HTB)
#define PG8_STAGE2(bufoff, gbase, o0, o1) do { \
        __builtin_amdgcn_global_load_lds((const unsigned*)((const char*)(gbase) + (o0)), (PG8_LAS unsigned*)(lds + (bufoff) + ldsw), 16, 0, 0); \
        __builtin_amdgcn_global_load_lds((const unsigned*)((const char*)(gbase) + (o1)), (PG8_LAS unsigned*)(lds + (bufoff) + ldsw + 8192), 16, 0, 0); } while (0)
#define PG8_STAGEB(bufoff, gbase) PG8_STAGE2(bufoff, gbase, voffB[0], voffB[1])
#define PG8_LDA(dst, b, h) do { _Pragma("unroll") for (int m = 0; m < 4; ++m) _Pragma("unroll") for (int k = 0; k < 2; ++k) dst[m][k] = *(const PG8_LAS bf16x8*)(lds + PG8_SA(b, h) + aoff + m * 2048 + k * 1024); } while (0)
#define PG8_LDB(dst, b, h) do { _Pragma("unroll") for (int n = 0; n < 2; ++n) _Pragma("unroll") for (int k = 0; k < 2; ++k) dst[n][k] = *(const PG8_LAS bf16x8*)(lds + PG8_SB(b, h) + boff + n * 2048 + k * 1024); } while (0)
#define PG8_MMA(ai, bj, At, Bt) do { __builtin_amdgcn_s_setprio(1); _Pragma("unroll") for (int m = 0; m < 4; ++m) _Pragma("unroll") for (int n = 0; n < 2; ++n) _Pragma("unroll") for (int k = 0; k < 2; ++k) \
        acc[ai][bj][m][n] = __builtin_amdgcn_mfma_f32_16x16x32_bf16(Bt[n][k], At[m][k], acc[ai][bj][m][n], 0, 0, 0); __builtin_amdgcn_s_setprio(0); } while (0)
#define PG8_WAIT_V(n) asm volatile("s_waitcnt vmcnt(" #n ")" ::: "memory")
#define PG8_WAIT_L(n) asm volatile("s_waitcnt lgkmcnt(" #n ")" ::: "memory")
#define PG8_BAR __builtin_amdgcn_s_barrier()
#define PG8_SCHED __builtin_amdgcn_sched_barrier(0)
    Unit cur, nxt; int ui = 0;
    if (!S.next(0, cur)) return;
    f32x4 acc[2][2][4][2];
#pragma unroll
    for (int a = 0; a < 2; ++a)
#pragma unroll
        for (int b = 0; b < 2; ++b)
#pragma unroll
            for (int m = 0; m < 4; ++m)
#pragma unroll
                for (int n = 0; n < 2; ++n) acc[a][b][m][n] = (f32x4){0.f, 0.f, 0.f, 0.f};
    bf16x8 At[4][2], B0[2][2], B1[2][2];
    unsigned v00, v01, v10, v11;
    if constexpr (Sched::GATHER) { v00 = S.a_row(cur, RA0) * rowb + CA0; v01 = S.a_row(cur, RA1) * rowb + CA1; v10 = S.a_row(cur, HALF + RA0) * rowb + CA0; v11 = S.a_row(cur, HALF + RA1) * rowb + CA1; }
    else { v00 = (unsigned)RA0 * rowb + CA0; v01 = (unsigned)RA1 * rowb + CA1; v10 = (unsigned)(HALF + RA0) * rowb + CA0; v11 = (unsigned)(HALF + RA1) * rowb + CA1; }
    const char* cA = Abase + S.a_off(cur, rowb);
    const char* cB = S.b_base(cur);
    PG8_STAGEB(PG8_SB(0, 0), cB); PG8_STAGEB(PG8_SB(0, 1), cB + hstep); PG8_STAGE2(PG8_SA(0, 0), cA, v00, v01); PG8_STAGE2(PG8_SA(0, 1), cA, v10, v11);
    if (wr == 1) PG8_BAR;
    PG8_WAIT_V(2); PG8_BAR;
    PG8_STAGEB(PG8_SB(1, 0), cB + kstep); PG8_STAGE2(PG8_SA(1, 0), cA + kstep, v00, v01); PG8_STAGEB(PG8_SB(1, 1), cB + hstep + kstep);
    PG8_WAIT_V(6); PG8_BAR;
    for (;;) {
        const bool has_next = S.next(ui + 1, nxt);
        unsigned n00 = v00, n01 = v01, n10 = v10, n11 = v11; const char* nB = cB; const char* nA = cA;
        if (has_next) { nB = S.b_base(nxt); nA = Abase + S.a_off(nxt, rowb);
            if constexpr (Sched::GATHER) { n00 = S.a_row(nxt, RA0) * rowb + CA0; n01 = S.a_row(nxt, RA1) * rowb + CA1; n10 = S.a_row(nxt, HALF + RA0) * rowb + CA0; n11 = S.a_row(nxt, HALF + RA1) * rowb + CA1; } }
#pragma unroll 1
        for (int t = 0; t < nt; t += 2) {
            const bool last = (t == nt - 2);
            const char* a1 = cA + (size_t)(t + 1) * kstep;
            const char* a2 = last ? nA : cA + (size_t)(t + 2) * kstep; const char* b2 = last ? nB : cB + (size_t)(t + 2) * kstep;
            const char* a3 = a2 + kstep; const char* b3 = b2 + kstep;
            unsigned w00 = v00, w01 = v01, w10 = v10, w11 = v11;
            if constexpr (Sched::GATHER) { w00 = last ? n00 : v00; w01 = last ? n01 : v01; w10 = last ? n10 : v10; w11 = last ? n11 : v11; }
            PG8_LDB(B0, 0, 0); PG8_LDB(B1, 0, 1); PG8_SCHED; PG8_LDA(At, 0, 0); PG8_STAGE2(PG8_SA(1, 1), a1, v10, v11);
            PG8_WAIT_V(8); PG8_WAIT_L(0); PG8_BAR; PG8_MMA(0, 0, At, B0); PG8_MMA(0, 1, At, B1); PG8_BAR; PG8_SCHED;
            PG8_LDA(At, 0, 1); PG8_STAGEB(PG8_SB(0, 0), b2); PG8_STAGEB(PG8_SB(0, 1), b2 + hstep); PG8_STAGE2(PG8_SA(0, 0), a2, w00, w01);
            PG8_WAIT_V(8); PG8_WAIT_L(0); PG8_BAR; PG8_MMA(1, 0, At, B0); PG8_MMA(1, 1, At, B1); PG8_BAR; PG8_SCHED;
            PG8_LDB(B0, 1, 0); PG8_LDB(B1, 1, 1); PG8_SCHED; PG8_LDA(At, 1, 0); PG8_STAGE2(PG8_SA(0, 1), a2, w10, w11);
            PG8_WAIT_V(8); PG8_WAIT_L(0); PG8_BAR; PG8_MMA(0, 0, At, B0); PG8_MMA(0, 1, At, B1); PG8_BAR; PG8_SCHED;
            PG8_LDA(At, 1, 1); PG8_STAGEB(PG8_SB(1, 0), b3); PG8_STAGEB(PG8_SB(1, 1), b3 + hstep); PG8_STAGE2(PG8_SA(1, 0), a3, w00, w01);
            PG8_WAIT_V(8); PG8_WAIT_L(0); PG8_BAR; PG8_MMA(1, 0, At, B0); PG8_MMA(1, 1, At, B1); PG8_BAR; PG8_SCHED;
        }
        if (wr == 0) PG8_BAR;
        E(acc, cur, wr, wc, fr, fq);
        if (!has_next) break;
#pragma unroll
        for (int a = 0; a < 2; ++a)
#pragma unroll
            for (int b = 0; b < 2; ++b)
#pragma unroll
                for (int m = 0; m < 4; ++m)
#pragma unroll
                    for (int n = 0; n < 2; ++n) acc[a][b][m][n] = (f32x4){0.f, 0.f, 0.f, 0.f};
        cur = nxt; cB = nB; cA = nA; ++ui;
        if constexpr (Sched::GATHER) { v00 = n00; v01 = n01; v10 = n10; v11 = n11; }
        if (wr == 1) PG8_BAR;
    }
    PG8_WAIT_V(0);
    PG8_BAR;
#undef PG8_SA
#undef PG8_SB
#undef PG8_STAGE2
#undef PG8_STAGEB
#undef PG8_LDA
#undef PG8_LDB
#undef PG8_MMA
#undef PG8_WAIT_V
#undef PG8_WAIT_L
#undef PG8_BAR
#undef PG8_SCHED
}
}
constexpr int NWAVES = 8;
constexpr int D = 2048, BATCH = 4, SEQ = 8192, T = BATCH * SEQ, DEPTH = 2;
constexpr int NIN = 18432, PLE = 256, NEXP = 32, DFF = 512;
constexpr int HT = 16384;
constexpr int NPROJ = 12288;
constexpr float EPS = 1e-6f;
constexpr int MAXTILES = 288;
constexpr int APAD = MAXTILES * 256;

constexpr size_t MiB = 1u << 20;
constexpr size_t WS_CTL = 0, CTL_ZERO_BYTES = 1 * MiB;
constexpr size_t WS_DT = 1 * MiB;
constexpr int DT_STRIDE = 512;
constexpr size_t WS_WR = 2 * MiB;
constexpr size_t WS_ROPE = 4 * MiB;
constexpr size_t WS_RS = 12 * MiB;
constexpr size_t WS_ROUTE = WS_RS + 128 * 1024;
constexpr size_t WS_INV = WS_ROUTE + 512 * 1024;
constexpr size_t WS_LTOK = WS_INV + 256 * 1024;
constexpr size_t WS_LW = WS_LTOK + 288 * 1024;
constexpr size_t WS_META = WS_LW + 288 * 1024;
constexpr size_t WS_PB = 16 * MiB;
constexpr size_t WS_W = 48 * MiB;
constexpr size_t W_IN = 0, W_OUT = 72 * MiB, W_GU = 80 * MiB, W_DN = 208 * MiB, W_PG = 272 * MiB, W_PP = 280 * MiB, W_LAYER = 282 * MiB;
constexpr size_t WS_HB = WS_W + 2 * W_LAYER;
constexpr size_t WS_PROJ = WS_HB + 128 * MiB;
constexpr size_t PJ = 64 * MiB;
constexpr size_t WS_QN = WS_PROJ, WS_KN = WS_PROJ + PJ, WS_VNT = WS_PROJ + 2 * PJ, WS_QR = WS_PROJ + 3 * PJ, WS_KR = WS_PROJ + 4 * PJ, WS_KZF = WS_PROJ + 5 * PJ, WS_KZB = WS_PROJ + 6 * PJ, WS_VRT = WS_PROJ + 7 * PJ;
constexpr size_t WS_MIX = WS_KN, WS_OF = WS_KR, WS_OB = WS_VNT;
constexpr size_t WS_PF = WS_PROJ + 8 * PJ, WS_PBW = WS_PF + 32 * MiB;
constexpr size_t WS_END = WS_PBW + 32 * MiB;
constexpr size_t WS_ACT = WS_PROJ;
constexpr size_t WS_YP = WS_PROJ + 72 * MiB;
constexpr size_t WS_PP = WS_PROJ + 360 * MiB;
static_assert(WS_PP + 128 * MiB <= WS_PF, "pp inside proj region");
constexpr int CW_BAR = 4096;

constexpr int RING_BYTES = 131072;
constexpr int MISC_OFF = RING_BYTES;
constexpr int LDS_BYTES = 147456;

#define GAS __attribute__((address_space(1)))
#define LAS __attribute__((address_space(3)))
typedef unsigned short bf16;
typedef unsigned v4u __attribute__((ext_vector_type(4)));
typedef unsigned v2u __attribute__((ext_vector_type(2)));
typedef float f32x4 __attribute__((ext_vector_type(4)));
typedef short bf16x8 __attribute__((ext_vector_type(8)));
#define LDS_WAIT() asm volatile("s_waitcnt lgkmcnt(0)" ::: "memory")
#define VM_WAIT() asm volatile("s_waitcnt vmcnt(0)" ::: "memory")
__device__ __forceinline__ unsigned f2bf(float f) { unsigned u = __builtin_bit_cast(unsigned, f); return (u + 0x7fffu + ((u >> 16) & 1u)) >> 16; }
__device__ __forceinline__ unsigned pk2(float lo, float hi) { return f2bf(lo) | (f2bf(hi) << 16); }
__device__ __forceinline__ float bf2f(unsigned b) { return __builtin_bit_cast(float, b << 16); }
__device__ __forceinline__ float bflo(unsigned w) { return __builtin_bit_cast(float, w << 16); }
__device__ __forceinline__ float bfhi(unsigned w) { return __builtin_bit_cast(float, w & 0xffff0000u); }
__device__ __forceinline__ float sigmoidf_(float x) { return 1.0f / (1.0f + __expf(-x)); }
__device__ __forceinline__ float siluf_(float x) { return x / (1.0f + __expf(-x)); }
__device__ __forceinline__ float wave_sum(float v) {
#pragma unroll
    for (int o = 1; o < 64; o <<= 1) v += __shfl_xor(v, o);
    return v;
}

#define XB_TMO      128
#define XB_XCNT(j)  (256  + 64 * (j))
#define XB_XSUB(j)  (1280 + 64 * (j))
#define XB_XGEN(j)  (2304 + 64 * (j))
#define XB_TOP      3328
#define XB_TOPGEN   3392
#define XCD_BAR_WORDS 3456
#define XB_SPIN_CAP (1u << 18)
__device__ __forceinline__ unsigned xb_ld(unsigned* p)              { return __hip_atomic_load(p, __ATOMIC_RELAXED, __HIP_MEMORY_SCOPE_AGENT); }
__device__ __forceinline__ unsigned xb_add(unsigned* p, unsigned v) { return __hip_atomic_fetch_add(p, v, __ATOMIC_RELAXED, __HIP_MEMORY_SCOPE_AGENT); }
__device__ __forceinline__ unsigned xb_xcc_id() { return (unsigned)__builtin_amdgcn_s_getreg((3 << 11) | 20) & 0xFu; }
#define XB_SPIN(cond, bar) do { unsigned _sp = 0; while (cond) { __builtin_amdgcn_s_sleep(1); \
    if ((++_sp & 255u) == 0u) { if (xb_ld(&(bar)[XB_TMO])) break; if (_sp > XB_SPIN_CAP) { atomicAdd(&(bar)[XB_TMO], 1u); break; } } } } while (0)
struct XcdBarrier { unsigned* bar; unsigned x; volatile LAS unsigned* st; };
__device__ __forceinline__ XcdBarrier xcd_barrier_post(unsigned* bar, volatile LAS unsigned* st) {
    XcdBarrier b; b.bar = bar; b.x = xb_xcc_id(); b.st = st;
    if (threadIdx.x == 0) (void)xb_add(&bar[XB_XCNT(b.x)], 1u);
    return b;
}
__device__ __forceinline__ void xcd_barrier_complete(unsigned* bar, unsigned x, unsigned& nloc, unsigned& nx) {
    const unsigned G = gridDim.x * gridDim.y * gridDim.z;
    unsigned sum, cnt, mine, sp = 0u;
    for (;;) {
        sum = 0u; cnt = 0u; mine = 0u;
#pragma unroll
        for (unsigned j = 0; j < 16; ++j) { const unsigned c = xb_ld(&bar[XB_XCNT(j)]); sum += c; cnt += (c > 0u) ? 1u : 0u; mine = (j == x) ? c : mine; }
        if (sum == G) break;
        __builtin_amdgcn_s_sleep(1);
        if ((++sp & 255u) == 0u) { if (xb_ld(&bar[XB_TMO])) break; if (sp > XB_SPIN_CAP) { atomicAdd(&bar[XB_TMO], 1u); break; } }
    }
    nloc = mine > 0u ? mine : 1u; nx = cnt > 0u ? cnt : 1u;
}
__device__ __forceinline__ void xcd_barrier(const XcdBarrier& b) {
    asm volatile("s_waitcnt vmcnt(0)" ::: "memory");
    __syncthreads();
    if (threadIdx.x == 0) {
        unsigned* bar = b.bar;
        __builtin_amdgcn_s_waitcnt(0);
        unsigned nloc = b.st[0], nx = b.st[1];
        if (nloc == 0u) { xcd_barrier_complete(bar, b.x, nloc, nx); b.st[0] = nloc; b.st[1] = nx; }
        const unsigned old = xb_add(&bar[XB_XSUB(b.x)], 1u);
        const unsigned gen = old / nloc;
        if (old + 1u == (gen + 1u) * nloc) {
            __builtin_amdgcn_fence(__ATOMIC_RELEASE, "agent");
            asm volatile("s_waitcnt vmcnt(0)" ::: "memory");
            const unsigned og = xb_add(&bar[XB_TOP], 1u);
            const unsigned tg = og / nx;
            if (og + 1u == (tg + 1u) * nx) xb_add(&bar[XB_TOPGEN], 1u);
            else XB_SPIN(xb_ld(&bar[XB_TOPGEN]) == tg, bar);
            __builtin_amdgcn_fence(__ATOMIC_ACQUIRE, "agent");
            xb_add(&bar[XB_XGEN(b.x)], 1u);
            asm volatile("s_waitcnt vmcnt(0)" ::: "memory");
        } else {
            XB_SPIN(xb_ld(&bar[XB_XGEN(b.x)]) == gen, bar);
            __builtin_amdgcn_fence(__ATOMIC_ACQUIRE, "agent");
            asm volatile("s_waitcnt vmcnt(0)" ::: "memory");
        }
    }
    __syncthreads();
}

struct Frame {
    LAS unsigned char* lds;
    volatile LAS unsigned* MISC;
    int tid, lane, wave, vcu, G;
    unsigned char* ws;
    float* out;
};
__device__ __forceinline__ void tr_item(const float* W, int K, int N, const float* gain, bf16* WT, int mode, LAS float* scr, int item, int lane) {
    const int nblk = N / 32, kb = item / nblk, nb = item % nblk, k0 = 64 * kb, n0 = 32 * nb;
    float cs = 1.0f;
    if (mode == 1) { if (n0 < 2048) cs = 0.08838834764831845f; else if (n0 >= 8192 && n0 < 10240) cs = 0.0625f; }
#pragma unroll 8
    for (int i = 0; i < 32; ++i) { const int kk = 2 * i + (lane >> 5); const float g = gain ? gain[k0 + kk] * cs : cs; scr[kk * 33 + (lane & 31)] = W[(size_t)(k0 + kk) * N + n0 + (lane & 31)] * g; }
    LDS_WAIT(); asm volatile("" ::: "memory");
    const int c = lane & 7;
#pragma unroll
    for (int j = 0; j < 4; ++j) { const int n = (lane >> 3) + 8 * j; const LAS float* s = scr + (8 * c) * 33 + n;
        v4u o; o.x = pk2(s[0 * 33], s[1 * 33]); o.y = pk2(s[2 * 33], s[3 * 33]); o.z = pk2(s[4 * 33], s[5 * 33]); o.w = pk2(s[6 * 33], s[7 * 33]);
        const int nn = n0 + n; int dr = nn; if (mode == 2) dr = (nn >> 2) * 8 + (nn & 3); else if (mode == 3) dr = (nn >> 2) * 8 + 4 + (nn & 3);
        *(GAS v4u*)(WT + (size_t)dr * K + k0 + 8 * c) = o; }
    LDS_WAIT(); asm volatile("" ::: "memory");
}
__device__ __forceinline__ float log_sigmoidf_(float x) { return x >= 0.f ? -log1pf(expf(-x)) : x - log1pf(expf(x)); }

__device__ __forceinline__ void p0_prologue(Frame& F, const float* in_p, const float* in_nmix, const float* in_win, const float* in_decf, const float* in_decb, const float* in_wout, const float* in_nffn,
        const float* in_wrg, const float* in_wre, const float* in_wg, const float* in_wu, const float* in_wd, const float* in_nple, const float* in_wpg, const float* in_wpp) {
    LAS float* scr = (LAS float*)(F.lds + F.wave * 16384);
    const int gw = F.vcu * NWAVES + F.wave, NGW = F.G * NWAVES;
    constexpr int I_IN = 32 * 576, I_SQ = 2048, I_EX = 16384, I_PP = 256;
    constexpr int PER_LAYER = I_IN + I_SQ + 3 * I_EX + I_SQ + I_PP;
    for (int it = gw; it < DEPTH * PER_LAYER; it += NGW) {
        const int l = it / PER_LAYER; int r = it % PER_LAYER;
        unsigned char* wl = F.ws + WS_W + (size_t)l * W_LAYER;
        if (r < I_IN) { tr_item(in_win + (size_t)l * D * NIN, D, NIN, in_nmix + l * D, (bf16*)(wl + W_IN), 1, scr, r, F.lane); continue; } r -= I_IN;
        if (r < I_SQ) { tr_item(in_wout + (size_t)l * D * D, D, D, nullptr, (bf16*)(wl + W_OUT), 0, scr, r, F.lane); continue; } r -= I_SQ;
        if (r < I_EX) { const int e = r >> 9; tr_item(in_wg + ((size_t)l * NEXP + e) * D * DFF, D, DFF, in_nffn + l * D, (bf16*)(wl + W_GU) + (size_t)e * 1024 * D, 2, scr, r & 511, F.lane); continue; } r -= I_EX;
        if (r < I_EX) { const int e = r >> 9; tr_item(in_wu + ((size_t)l * NEXP + e) * D * DFF, D, DFF, in_nffn + l * D, (bf16*)(wl + W_GU) + (size_t)e * 1024 * D, 3, scr, r & 511, F.lane); continue; } r -= I_EX;
        if (r < I_EX) { const int e = r >> 9; tr_item(in_wd + ((size_t)l * NEXP + e) * DFF * D, DFF, D, nullptr, (bf16*)(wl + W_DN) + (size_t)e * D * DFF, 0, scr, r & 511, F.lane); continue; } r -= I_EX;
        if (r < I_SQ) { tr_item(in_wpg + (size_t)l * D * D, D, D, in_nple + l * D, (bf16*)(wl + W_PG), 0, scr, r, F.lane); continue; } r -= I_SQ;
        tr_item(in_wpp + (size_t)l * PLE * D, PLE, D, nullptr, (bf16*)(wl + W_PP), 0, scr, r, F.lane);
    }
    const int gt = F.vcu * (NWAVES * 64) + F.tid, NGT = F.G * NWAVES * 64;
    { float* cosT = (float*)(F.ws + WS_ROPE); float* sinT = cosT + SEQ * 128;
      for (int i = gt; i < SEQ * 128; i += NGT) { const int s = i >> 7, d = i & 127; const float inv = powf(10000.0f, -(float)d / 128.0f); const float ang = (float)s * inv; float sn, cs; sincosf(ang, &sn, &cs); cosT[i] = cs; sinT[i] = sn; } }
    { const float* p = in_p; bf16* pb = (bf16*)(F.ws + WS_PB);
      for (int i = gt; i < DEPTH * T * PLE / 8; i += NGT) { const f32x4 a = ((const GAS f32x4*)p)[2 * i], b = ((const GAS f32x4*)p)[2 * i + 1];
          v4u o; o.x = pk2(a.x, a.y); o.y = pk2(a.z, a.w); o.z = pk2(b.x, b.y); o.w = pk2(b.z, b.w); ((GAS v4u*)pb)[i] = o; } }
    { bf16* wr = (bf16*)(F.ws + WS_WR);
      for (int i = gt; i < DEPTH * 48 * D; i += NGT) { const int l = i / (48 * D), n = (i / D) % 48, k = i % D; float v = 0.f;
          if (n < 4) v = in_wrg[((size_t)l * D + k) * 4 + n]; else if (n < 36) v = in_wre[((size_t)l * D + k) * 32 + (n - 4)];
          v *= in_nffn[l * D + k];
          const unsigned hi = f2bf(v); const float lo = v - bf2f(hi);
          wr[((size_t)(l * 2 + 0) * 48 + n) * D + k] = (bf16)hi; wr[((size_t)(l * 2 + 1) * 48 + n) * D + k] = (bf16)f2bf(lo); } }
    { float* dt = (float*)(F.ws + WS_DT);
      for (int i = gt; i < DEPTH * 2 * 8 * 128; i += NGT) { const int j = i & 127, h = (i >> 7) & 7, dir = (i >> 10) & 1, l = i >> 11;
          const float x = dir == 0 ? in_decf[l * 8 + h] : in_decb[l * 8 + h]; const float lg = log_sigmoidf_(x);
          float* e = dt + (size_t)((l * 2 + dir) * 8 + h) * DT_STRIDE;
          if (j == 0) { e[0] = lg; e[1] = expf(128.0f * lg); }
          e[128 + j] = dir == 0 ? expf((float)(j + 1) * lg) : expf((float)(128 - j) * lg);
          e[256 + j] = dir == 0 ? expf((float)(127 - j) * lg) : expf((float)j * lg); } }
}

template <int MODE>
__device__ __forceinline__ void rowpass(Frame& F, const float* src, float* dst, const float* gfin) {
    const int gw = F.vcu * NWAVES + F.wave, NGW = F.G * NWAVES;
    bf16* hb = (bf16*)(F.ws + WS_HB); float* rs = (float*)(F.ws + WS_RS);
    const int* inv = (const int*)(F.ws + WS_INV); const bf16* yp = (const bf16*)(F.ws + WS_YP);
    for (int m = gw; m < T; m += NGW) {
        const GAS f32x4* xr = (const GAS f32x4*)(src + (size_t)m * D) + F.lane;
        f32x4 v[8]; float s = 0.f;
#pragma unroll
        for (int j = 0; j < 8; ++j) v[j] = xr[64 * j];
        if (MODE == 1) {
            const int p0 = inv[2 * m], p1 = inv[2 * m + 1];
            const GAS v2u* y0 = (const GAS v2u*)(yp + (size_t)p0 * D) + F.lane; const GAS v2u* y1 = (const GAS v2u*)(yp + (size_t)p1 * D) + F.lane;
#pragma unroll
            for (int j = 0; j < 8; ++j) { const v2u a = y0[64 * j], b = y1[64 * j];
                v[j].x += bflo(a.x) + bflo(b.x); v[j].y += bfhi(a.x) + bfhi(b.x); v[j].z += bflo(a.y) + bflo(b.y); v[j].w += bfhi(a.y) + bfhi(b.y); }
            GAS f32x4* xo = (GAS f32x4*)(dst + (size_t)m * D) + F.lane;
#pragma unroll
            for (int j = 0; j < 8; ++j) xo[64 * j] = v[j];
        }
#pragma unroll
        for (int j = 0; j < 8; ++j) s += (v[j].x * v[j].x + v[j].y * v[j].y) + (v[j].z * v[j].z + v[j].w * v[j].w);
        const float r = 1.0f / sqrtf(wave_sum(s) * (1.0f / D) + EPS);
        if (MODE == 2) {
            GAS f32x4* xo = (GAS f32x4*)(dst + (size_t)m * D) + F.lane; const GAS f32x4* gg = (const GAS f32x4*)gfin + F.lane;
#pragma unroll
            for (int j = 0; j < 8; ++j) { const f32x4 g = gg[64 * j]; xo[64 * j] = v[j] * r * g; }
        } else {
            GAS v2u* o8 = (GAS v2u*)(hb + (size_t)m * D) + F.lane;
#pragma unroll
            for (int j = 0; j < 8; ++j) { v2u o; o.x = pk2(v[j].x, v[j].y); o.y = pk2(v[j].z, v[j].w); o8[64 * j] = o; }
            if (F.lane == 0) rs[m] = r;
        }
    }
}

__device__ __forceinline__ void router_phase(Frame& F, const float* x, int layer) {
    const int gw = F.vcu * NWAVES + F.wave, NGW = F.G * NWAVES, fr = F.lane & 15, g = F.lane >> 4;
    const bf16* wr = (const bf16*)(F.ws + WS_WR) + (size_t)layer * 2 * 48 * D;
    const float* rs = (const float*)(F.ws + WS_RS); v4u* route = (v4u*)(F.ws + WS_ROUTE);
    LAS float* lg = (LAS float*)(F.lds + F.wave * 4096);
    for (int tile = gw; tile < T / 16; tile += NGW) {
        const int t0 = tile * 16;
        f32x4 acc[3]; acc[0] = acc[1] = acc[2] = (f32x4){0.f, 0.f, 0.f, 0.f};
        const float* xrow = x + (size_t)(t0 + fr) * D + 8 * g;
#pragma unroll 2
        for (int ks = 0; ks < 64; ++ks) {
            const f32x4 a = *(const GAS f32x4*)(xrow + 32 * ks), b = *(const GAS f32x4*)(xrow + 32 * ks + 4);
            v4u hi, lo; float l0, l1;
            hi.x = pk2(a.x, a.y); l0 = a.x - bflo(hi.x); l1 = a.y - bfhi(hi.x); lo.x = pk2(l0, l1);
            hi.y = pk2(a.z, a.w); l0 = a.z - bflo(hi.y); l1 = a.w - bfhi(hi.y); lo.y = pk2(l0, l1);
            hi.z = pk2(b.x, b.y); l0 = b.x - bflo(hi.z); l1 = b.y - bfhi(hi.z); lo.z = pk2(l0, l1);
            hi.w = pk2(b.z, b.w); l0 = b.z - bflo(hi.w); l1 = b.w - bfhi(hi.w); lo.w = pk2(l0, l1);
            const bf16x8 ah = __builtin_bit_cast(bf16x8, hi), al = __builtin_bit_cast(bf16x8, lo);
#pragma unroll
            for (int nt = 0; nt < 3; ++nt) {
                const bf16x8 bh = *(const GAS bf16x8*)(wr + (size_t)(16 * nt + fr) * D + 32 * ks + 8 * g);
                const bf16x8 bl = *(const GAS bf16x8*)(wr + (size_t)(48 + 16 * nt + fr) * D + 32 * ks + 8 * g);
                acc[nt] = __builtin_amdgcn_mfma_f32_16x16x32_bf16(ah, bh, acc[nt], 0, 0, 0);
                acc[nt] = __builtin_amdgcn_mfma_f32_16x16x32_bf16(al, bh, acc[nt], 0, 0, 0);
                acc[nt] = __builtin_amdgcn_mfma_f32_16x16x32_bf16(ah, bl, acc[nt], 0, 0, 0);
            }
        }
#pragma unroll
        for (int nt = 0; nt < 3; ++nt)
#pragma unroll
            for (int r = 0; r < 4; ++r) lg[(4 * g + r) * 52 + 16 * nt + fr] = acc[nt][r];
        LDS_WAIT(); asm volatile("" ::: "memory");
        if (F.lane < 16) {
            const int t = t0 + F.lane; const float rr = rs[t]; const LAS float* L = lg + F.lane * 52;
            float gl[4]; int gs = 0; float gm = -3.0e38f;
#pragma unroll
            for (int i = 0; i < 4; ++i) { gl[i] = L[i] * rr; if (gl[i] > gm) { gm = gl[i]; gs = i; } }
            float se = 0.f;
#pragma unroll
            for (int i = 0; i < 4; ++i) se += expf(gl[i] - gm);
            const float pg = 1.0f / se;
            float v0 = -3.0e38f, v1 = -3.0e38f; int i0 = 0, i1 = 0;
            for (int i = 0; i < 8; ++i) { const float v = L[4 + 8 * gs + i] * rr;
                if (v > v0) { v1 = v0; i1 = i0; v0 = v; i0 = i; } else if (v > v1) { v1 = v; i1 = i; } }
            const float e1 = expf(v1 - v0); const float w0 = pg / (1.0f + e1), w1 = pg * e1 / (1.0f + e1);
            v4u o; o.x = (unsigned)(gs * 8 + i0); o.y = (unsigned)(gs * 8 + i1); o.z = __builtin_bit_cast(unsigned, w0); o.w = __builtin_bit_cast(unsigned, w1);
            route[t] = o;
        }
        LDS_WAIT(); asm volatile("" ::: "memory");
    }
}

__device__ __forceinline__ void lists_phase(Frame& F) {
    const v4u* route = (const v4u*)(F.ws + WS_ROUTE);
    int* inv = (int*)(F.ws + WS_INV); int* ltok = (int*)(F.ws + WS_LTOK); float* lw = (float*)(F.ws + WS_LW); int* meta = (int*)(F.ws + WS_META);
    LAS int* hist = (LAS int*)F.lds;
    const int c = F.vcu; if (c >= 256) return;
    const int e = c >> 3, part = c & 7;
    if (F.tid < 64) hist[F.tid] = 0;
    __syncthreads();
    int own_before = 0;
    for (int t = F.tid; t < T; t += NWAVES * 64) { const v4u r = route[t];
        __hip_atomic_fetch_add(&hist[r.x], 1, __ATOMIC_RELAXED, __HIP_MEMORY_SCOPE_WORKGROUP); __hip_atomic_fetch_add(&hist[r.y], 1, __ATOMIC_RELAXED, __HIP_MEMORY_SCOPE_WORKGROUP);
        if (t < part * (T / 8)) own_before += ((int)r.x == e) + ((int)r.y == e); }
    own_before = (int)wave_sum((float)own_before);
    if (F.lane == 0) __hip_atomic_fetch_add(&hist[32], own_before, __ATOMIC_RELAXED, __HIP_MEMORY_SCOPE_WORKGROUP);
    __syncthreads();
    if (F.tid == 0) { int acc = 0; for (int i = 0; i < 32; ++i) { hist[64 + i] = acc; acc += (hist[i] + 255) >> 8; } hist[96] = acc; }
    __syncthreads();
    if (c == 0 && F.tid < 33) meta[F.tid] = hist[64 + F.tid];
    const int region = hist[64 + e] * 256; int base = hist[32];
    const int cnt_e = hist[e];
    for (int ch = 0; ch < (T / 8) / 512; ++ch) {
        const int t = part * (T / 8) + ch * 512 + F.tid; const v4u r = route[t];
        const int m0 = ((int)r.x == e), m1 = ((int)r.y == e);
        const int mt = m0 | m1;
        const unsigned long long bal = __ballot(mt);
        const int pre = __popcll(bal & ((1ull << F.lane) - 1ull)); const int wc = __popcll(bal);
        __syncthreads();
        if (F.lane == 0) hist[40 + F.wave] = wc;
        __syncthreads();
        int woff = 0, tot = 0;
#pragma unroll
        for (int w = 0; w < NWAVES; ++w) { const int cw = hist[40 + w]; if (w < F.wave) woff += cw; tot += cw; }
        if (mt) { const int pos = region + base + woff + pre; ltok[pos] = t; lw[pos] = __builtin_bit_cast(float, m0 ? r.z : r.w); inv[2 * t + (m0 ? 0 : 1)] = pos; }
        base += tot;
    }
    if (part == 7) { const int padend = ((cnt_e + 255) >> 8) * 256; for (int p = cnt_e + F.tid; p < padend; p += NWAVES * 64) { ltok[region + p] = 0; lw[region + p] = 0.f; } }
    __syncthreads();
}

__device__ __forceinline__ bf16x8 ld_frag16(const bf16* p) { return *(const GAS bf16x8*)p; }
__device__ __forceinline__ void na_unit(Frame& F, const bf16* Qn, const bf16* Kn, const bf16* VnT, bf16* out, const float* rpb, int u) {
    const int bl = u >> 11, h = (u >> 7) & 15, r = u & 127;
    const int qb = F.wave & 3, kh = F.wave >> 2, fr = F.lane & 15, g = F.lane >> 4;
    const int rs_row = min(max(r - 4, 0), 120);
    const int kc0 = qb == 0 ? 0 : (qb == 1 ? 8 : (qb == 2 ? 24 : 32));
    const int tq = bl * SEQ + r * 64 + 16 * qb + fr;
    LAS float* M = (LAS float*)F.lds;
    LAS float* OX = (LAS float*)(F.lds + 1024);
    bf16x8 qf[4];
#pragma unroll
    for (int ks = 0; ks < 4; ++ks) qf[ks] = ld_frag16(Qn + (size_t)tq * D + h * 128 + 32 * ks + 8 * g);
    f32x4 sc[4][2];
#pragma unroll
    for (int i = 0; i < 4; ++i)
#pragma unroll
        for (int kb = 0; kb < 2; ++kb) {
            const int tk = bl * SEQ + (rs_row + 4 * kh + i) * 64 + kc0 + 16 * kb + fr;
            f32x4 a = (f32x4){0.f, 0.f, 0.f, 0.f};
#pragma unroll
            for (int ks = 0; ks < 4; ++ks) { const bf16x8 kf = ld_frag16(Kn + (size_t)tk * D + h * 128 + 32 * ks + 8 * g); a = __builtin_amdgcn_mfma_f32_16x16x32_bf16(kf, qf[ks], a, 0, 0, 0); }
            sc[i][kb] = a;
        }
    const int qc = 16 * qb + fr, cs = min(max(qc - 8, 0), 48);
    float mx = -1e30f;
#pragma unroll
    for (int i = 0; i < 4; ++i) { const int dr = (rs_row + 4 * kh + i) - r + 7;
#pragma unroll
        for (int kb = 0; kb < 2; ++kb)
#pragma unroll
            for (int rg = 0; rg < 4; ++rg) { const int kcol = kc0 + 16 * kb + 4 * g + rg; const bool valid = (kcol >= cs) && (kcol < cs + 16);
                const int dc = min(max(kcol - qc, -15), 15) + 15; const float b = rpb[(h * 15 + dr) * 31 + dc];
                const float s = valid ? sc[i][kb][rg] + b : -1e30f; sc[i][kb][rg] = s; mx = fmaxf(mx, s); } }
    mx = fmaxf(mx, __shfl_xor(mx, 16)); mx = fmaxf(mx, __shfl_xor(mx, 32));
    if (g == 0) M[F.wave * 16 + fr] = mx;
    __syncthreads();
    const float m = fmaxf(mx, M[(F.wave ^ 4) * 16 + fr]);
    float ls = 0.f;
#pragma unroll
    for (int i = 0; i < 4; ++i)
#pragma unroll
        for (int kb = 0; kb < 2; ++kb)
#pragma unroll
            for (int rg = 0; rg < 4; ++rg) { const float p = __expf(sc[i][kb][rg] - m); sc[i][kb][rg] = p; ls += p; }
    ls += __shfl_xor(ls, 16); ls += __shfl_xor(ls, 32);
    f32x4 o[8];
#pragma unroll
    for (int dt = 0; dt < 8; ++dt) o[dt] = (f32x4){0.f, 0.f, 0.f, 0.f};
#pragma unroll
    for (int i = 0; i < 4; ++i) {
        v4u pw; pw.x = pk2(sc[i][0][0], sc[i][0][1]); pw.y = pk2(sc[i][0][2], sc[i][0][3]); pw.z = pk2(sc[i][1][0], sc[i][1][1]); pw.w = pk2(sc[i][1][2], sc[i][1][3]);
        const bf16x8 pf = __builtin_bit_cast(bf16x8, pw);
        const int s0 = (rs_row + 4 * kh + i) * 64 + kc0 + 4 * g;
#pragma unroll
        for (int dt = 0; dt < 8; ++dt) { const bf16* vp = VnT + ((size_t)((bl * 16 + h) * 128 + 16 * dt + fr)) * SEQ + s0;
            const v2u a = *(const GAS v2u*)vp, b = *(const GAS v2u*)(vp + 16); v4u vw; vw.x = a.x; vw.y = a.y; vw.z = b.x; vw.w = b.y;
            o[dt] = __builtin_amdgcn_mfma_f32_16x16x32_bf16(__builtin_bit_cast(bf16x8, vw), pf, o[dt], 0, 0, 0); }
    }
    if (kh == 1) {
#pragma unroll
        for (int dt = 0; dt < 8; ++dt)
#pragma unroll
            for (int rg = 0; rg < 4; ++rg) OX[((F.wave - 4) * 32 + dt * 4 + rg) * 64 + F.lane] = o[dt][rg];
        if (g == 0) M[128 + (F.wave - 4) * 16 + fr] = ls;
    }
    __syncthreads();
    if (kh == 0) {
        const float inv = 1.0f / (ls + M[128 + F.wave * 16 + fr]);
#pragma unroll
        for (int dt = 0; dt < 8; ++dt) { float v[4];
#pragma unroll
            for (int rg = 0; rg < 4; ++rg) v[rg] = (o[dt][rg] + OX[(F.wave * 32 + dt * 4 + rg) * 64 + F.lane]) * inv;
            v2u w; w.x = pk2(v[0], v[1]); w.y = pk2(v[2], v[3]);
            *(GAS v2u*)(out + (size_t)tq * D + h * 128 + 16 * dt + 4 * g) = w; }
    }
    __syncthreads();
}

__device__ __forceinline__ void rp_unit(Frame& F, const bf16* Qr, const bf16* Kr, bf16* Pf, bf16* Pb, const float* dtl  , int u) {
    const int bl = u >> 9, h = (u >> 6) & 7, c = u & 63, fr = F.lane & 15, g = F.lane >> 4;
    const int t0 = bl * SEQ + c * 128, il = 16 * F.wave + fr;
    const float lgf = dtl[(0 * 8 + h) * DT_STRIDE], lgb = dtl[(1 * 8 + h) * DT_STRIDE];
    bf16x8 qf[8];
#pragma unroll
    for (int ks = 0; ks < 8; ++ks) qf[ks] = ld_frag16(Qr + (size_t)(t0 + il) * D + h * 256 + 32 * ks + 8 * g);
#pragma unroll 2
    for (int jt = 0; jt < 8; ++jt) {
        f32x4 a = (f32x4){0.f, 0.f, 0.f, 0.f};
#pragma unroll
        for (int ks = 0; ks < 8; ++ks) { const bf16x8 kf = ld_frag16(Kr + (size_t)(t0 + 16 * jt + fr) * D + h * 256 + 32 * ks + 8 * g); a = __builtin_amdgcn_mfma_f32_16x16x32_bf16(kf, qf[ks], a, 0, 0, 0); }
        float pf[4], pb[4];
#pragma unroll
        for (int rg = 0; rg < 4; ++rg) { const int j = 16 * jt + 4 * g + rg, diff = il - j;
            pf[rg] = diff >= 0 ? a[rg] * __expf((float)diff * lgf) : 0.f; pb[rg] = diff < 0 ? a[rg] * __expf((float)(-diff) * lgb) : 0.f; }
        v2u w; w.x = pk2(pf[0], pf[1]); w.y = pk2(pf[2], pf[3]); *(GAS v2u*)(Pf + ((size_t)u * 128 + il) * 128 + 16 * jt + 4 * g) = w;
        w.x = pk2(pb[0], pb[1]); w.y = pk2(pb[2], pb[3]); *(GAS v2u*)(Pb + ((size_t)u * 128 + il) * 128 + 16 * jt + 4 * g) = w;
    }
}

__device__ __forceinline__ void rs_job(Frame& F, const bf16* Qr, const bf16* KzT, const bf16* VrT, const bf16* P, bf16* O, const float* dte  , int bl, int h, int dir, int vs) {
    const int fr = F.lane & 15, g = F.lane >> 4, il = 16 * F.wave + fr;
    LAS bf16* Sbf = (LAS bf16*)F.lds;
    LAS bf16* VT = (LAS bf16*)(F.lds + 34816);
    const float gC = dte[1]; const float xi = dte[128 + il];
    f32x4 accS[4][2];
#pragma unroll
    for (int vt = 0; vt < 4; ++vt)
#pragma unroll
        for (int dd = 0; dd < 2; ++dd) accS[vt][dd] = (f32x4){0.f, 0.f, 0.f, 0.f};
    for (int i = F.tid; i < 64 * 264 / 2; i += NWAVES * 64) ((LAS unsigned*)Sbf)[i] = 0u;
    const int vrow = F.tid >> 3, vj0 = (F.tid & 7) * 16;
    const bf16* vsrc = VrT + ((size_t)((bl * 8 + h) * 256 + vs * 64 + vrow)) * SEQ + vj0;
    const int c0 = dir == 0 ? 0 : 63;
    v4u vr0 = *(const GAS v4u*)(vsrc + c0 * 128), vr1 = *(const GAS v4u*)(vsrc + c0 * 128 + 8);
    for (int step = 0; step < 64; ++step) {
        const int c = dir == 0 ? step : 63 - step; const int t0 = bl * SEQ + c * 128; const int unit = (bl * 8 + h) * 64 + c;
        *(LAS v4u*)(VT + vrow * 136 + vj0) = vr0; *(LAS v4u*)(VT + vrow * 136 + vj0 + 8) = vr1;
        __syncthreads();
        if (step < 63) { const int cn = dir == 0 ? c + 1 : c - 1; vr0 = *(const GAS v4u*)(vsrc + cn * 128); vr1 = *(const GAS v4u*)(vsrc + cn * 128 + 8); }
        bf16x8 qf[8];
#pragma unroll
        for (int ks = 0; ks < 8; ++ks) qf[ks] = ld_frag16(Qr + (size_t)(t0 + il) * D + h * 256 + 32 * ks + 8 * g);
        bf16x8 pf[4];
#pragma unroll
        for (int ks = 0; ks < 4; ++ks) pf[ks] = ld_frag16(P + ((size_t)unit * 128 + il) * 128 + 32 * ks + 8 * g);
        bf16x8 kz[2][4];
#pragma unroll
        for (int dd = 0; dd < 2; ++dd)
#pragma unroll
            for (int ks = 0; ks < 4; ++ks) kz[dd][ks] = ld_frag16(KzT + ((size_t)((bl * 8 + h) * 256 + 16 * (2 * F.wave + dd) + fr)) * SEQ + c * 128 + 32 * ks + 8 * g);
        f32x4 accO[4];
#pragma unroll
        for (int vt = 0; vt < 4; ++vt) { f32x4 a = (f32x4){0.f, 0.f, 0.f, 0.f};
#pragma unroll
            for (int ks = 0; ks < 8; ++ks) { const bf16x8 sf = *(const LAS bf16x8*)(Sbf + (16 * vt + fr) * 264 + 32 * ks + 8 * g); a = __builtin_amdgcn_mfma_f32_16x16x32_bf16(sf, qf[ks], a, 0, 0, 0); }
            accO[vt] = a * xi; }
#pragma unroll
        for (int vt = 0; vt < 4; ++vt)
#pragma unroll
            for (int dd = 0; dd < 2; ++dd) accS[vt][dd] = accS[vt][dd] * gC;
#pragma unroll
        for (int ks = 0; ks < 4; ++ks)
#pragma unroll
            for (int vt = 0; vt < 4; ++vt) { const bf16x8 vf = *(const LAS bf16x8*)(VT + (16 * vt + fr) * 136 + 32 * ks + 8 * g);
                accO[vt] = __builtin_amdgcn_mfma_f32_16x16x32_bf16(vf, pf[ks], accO[vt], 0, 0, 0);
                accS[vt][0] = __builtin_amdgcn_mfma_f32_16x16x32_bf16(vf, kz[0][ks], accS[vt][0], 0, 0, 0);
                accS[vt][1] = __builtin_amdgcn_mfma_f32_16x16x32_bf16(vf, kz[1][ks], accS[vt][1], 0, 0, 0); }
#pragma unroll
        for (int vt = 0; vt < 4; ++vt) { v2u w; w.x = pk2(accO[vt][0], accO[vt][1]); w.y = pk2(accO[vt][2], accO[vt][3]);
            *(GAS v2u*)(O + (size_t)(t0 + il) * D + h * 256 + vs * 64 + 16 * vt + 4 * g) = w; }
        __syncthreads();
#pragma unroll
        for (int vt = 0; vt < 4; ++vt)
#pragma unroll
            for (int dd = 0; dd < 2; ++dd)
#pragma unroll
                for (int rg = 0; rg < 4; ++rg) Sbf[(16 * vt + 4 * g + rg) * 264 + 16 * (2 * F.wave + dd) + fr] = (bf16)f2bf(accS[vt][dd][rg]);
    }
    __syncthreads();
}

__device__ __forceinline__ void rn_phase(Frame& F, bf16* Of, const bf16* Ob, const float* gn) {
    const int gw = F.vcu * NWAVES + F.wave, NGW = F.G * NWAVES;
    for (int m = gw; m < HT; m += NGW) {
#pragma unroll
        for (int j = 0; j < 4; ++j) {
            const int col = j * 512 + F.lane * 8;
            const v4u a = *(const GAS v4u*)(Of + (size_t)m * D + col), b = *(const GAS v4u*)(Ob + (size_t)m * D + col);
            float x[8]; x[0] = bflo(a.x) + bflo(b.x); x[1] = bfhi(a.x) + bfhi(b.x); x[2] = bflo(a.y) + bflo(b.y); x[3] = bfhi(a.y) + bfhi(b.y);
            x[4] = bflo(a.z) + bflo(b.z); x[5] = bfhi(a.z) + bfhi(b.z); x[6] = bflo(a.w) + bflo(b.w); x[7] = bfhi(a.w) + bfhi(b.w);
            float s = 0.f;
#pragma unroll
            for (int i = 0; i < 8; ++i) s += x[i];
#pragma unroll
            for (int o = 1; o < 32; o <<= 1) s += __shfl_xor(s, o);
            const float mu = s * (1.0f / 256.0f); float q = 0.f;
#pragma unroll
            for (int i = 0; i < 8; ++i) { x[i] -= mu; q += x[i] * x[i]; }
#pragma unroll
            for (int o = 1; o < 32; o <<= 1) q += __shfl_xor(q, o);
            const float rstd = 1.0f / sqrtf(q * (1.0f / 256.0f) + EPS);
            const f32x4 g0 = *(const GAS f32x4*)(gn + col), g1 = *(const GAS f32x4*)(gn + col + 4);
            v4u o; o.x = pk2(x[0] * rstd * g0.x, x[1] * rstd * g0.y); o.y = pk2(x[2] * rstd * g0.z, x[3] * rstd * g0.w);
            o.z = pk2(x[4] * rstd * g1.x, x[5] * rstd * g1.y); o.w = pk2(x[6] * rstd * g1.z, x[7] * rstd * g1.w);
            *(GAS v4u*)(Of + (size_t)m * D + col) = o;
        }
    }
}
struct LinSched {
    pg8::DenseOrder o; unsigned row0; const char* Bt; size_t tstep;
    __device__ __forceinline__ void init(int M, int N, int K, int G, int c, unsigned row0_, const bf16* Bt_) { o.init(M, N, G, c); row0 = row0_; Bt = (const char*)Bt_; tstep = (size_t)256 * K * 2; }
    __device__ __forceinline__ bool next(int i, pg8::Unit& u) const { u.e = 0; return o.next_mn(i, u.pm, u.pn); }
    static constexpr bool GATHER = false;
    __device__ __forceinline__ unsigned a_row(const pg8::Unit& u, int r) const { return 0u; }
    __device__ __forceinline__ size_t a_off(const pg8::Unit& u, unsigned rowb) const { return (size_t)(row0 + (unsigned)u.pm * 256u) * rowb; }
    __device__ __forceinline__ const char* b_base(const pg8::Unit& u) const { return Bt + (size_t)u.pn * tstep; }
};
template <bool GATHER_>
struct MoeSched {
    const volatile LAS int* ts; int ncol, G, c; const int* ltok; const char* Bt; size_t estep, tstep;
    __device__ __forceinline__ bool next(int i, pg8::Unit& u) const {
        const int L = i * G + c; const int total = ts[32] * ncol; if (L >= total) return false;
        const int tile = L / ncol; u.pm = tile; u.pn = L % ncol; int e = 0;
#pragma unroll 1
        for (int k = 1; k < 32; ++k) if (ts[k] <= tile) e = k;
        u.e = e; return true;
    }
    static constexpr bool GATHER = GATHER_;
    __device__ __forceinline__ unsigned a_row(const pg8::Unit& u, int r) const { return (unsigned)ltok[u.pm * 256 + r]; }
    __device__ __forceinline__ size_t a_off(const pg8::Unit& u, unsigned rowb) const { return GATHER_ ? (size_t)0 : (size_t)((unsigned)u.pm * 256u) * rowb; }
    __device__ __forceinline__ const char* b_base(const pg8::Unit& u) const { return Bt + (size_t)u.e * estep + (size_t)u.pn * tstep; }
};

using pg8::Unit; using pg8::cvt_pk_bf16;
typedef const f32x4 (&AccRef)[2][2][4][2];

struct EpiProj {
    static constexpr bool PERM = true;
    bf16 *Qn, *Kn, *VnT, *Qr, *Kr, *KzTf, *KzTb, *VrT; const float* rs; const float *cosT, *sinT; const float* dtl;
    __device__ __forceinline__ void operator()(AccRef acc, const Unit& u, int wr, int wc, int fr, int fq) const {
        const int type = u.pn >> 3, hh = u.pn & 7, c0 = wc * 32 + 8 * fq;
#pragma unroll
        for (int ai = 0; ai < 2; ++ai)
#pragma unroll
            for (int m = 0; m < 4; ++m) {
                const int r = u.pm * 256 + ai * 128 + wr * 64 + m * 16 + fr; const float rv = rs[r]; const int bl = r >> 13, s = r & (SEQ - 1);
                if (type <= 1) { bf16* dst = (type == 0 ? Qn : Kn) + (size_t)r * D + hh * 256 + c0;
#pragma unroll
                    for (int bj = 0; bj < 2; ++bj) { const f32x4 v0 = acc[ai][bj][m][0] * rv, v1 = acc[ai][bj][m][1] * rv; v4u w; w.x = cvt_pk_bf16(v0[0], v0[1]); w.y = cvt_pk_bf16(v0[2], v0[3]); w.z = cvt_pk_bf16(v1[0], v1[1]); w.w = cvt_pk_bf16(v1[2], v1[3]);
                        *(GAS v4u*)(dst + bj * 128) = w; }
                } else if (type == 2) {
#pragma unroll
                    for (int bj = 0; bj < 2; ++bj) { bf16* dst = VnT + ((size_t)((bl * 16 + hh * 2 + bj) * 128 + c0)) * SEQ + s;
#pragma unroll
                        for (int n = 0; n < 2; ++n)
#pragma unroll
                            for (int e = 0; e < 4; ++e) dst[(size_t)(4 * n + e) * SEQ] = (bf16)f2bf(acc[ai][bj][m][n][e] * rv); }
                } else if (type == 5) {
#pragma unroll
                    for (int bj = 0; bj < 2; ++bj) { bf16* dst = VrT + ((size_t)((bl * 8 + hh) * 256 + bj * 128 + c0)) * SEQ + s;
#pragma unroll
                        for (int n = 0; n < 2; ++n)
#pragma unroll
                            for (int e = 0; e < 4; ++e) dst[(size_t)(4 * n + e) * SEQ] = (bf16)f2bf(acc[ai][bj][m][n][e] * rv); }
                } else {
                    float o1[8], o2[8];
#pragma unroll
                    for (int n = 0; n < 2; ++n) { const f32x4 cs = *(const GAS f32x4*)(cosT + (size_t)s * 128 + c0 + 4 * n), sn = *(const GAS f32x4*)(sinT + (size_t)s * 128 + c0 + 4 * n);
#pragma unroll
                        for (int e = 0; e < 4; ++e) { const float x1 = acc[ai][0][m][n][e] * rv, x2 = acc[ai][1][m][n][e] * rv; o1[4 * n + e] = x1 * cs[e] - x2 * sn[e]; o2[4 * n + e] = x1 * sn[e] + x2 * cs[e]; } }
                    bf16* dst = (type == 3 ? Qr : Kr) + (size_t)r * D + hh * 256 + c0;
                    v4u w; w.x = cvt_pk_bf16(o1[0], o1[1]); w.y = cvt_pk_bf16(o1[2], o1[3]); w.z = cvt_pk_bf16(o1[4], o1[5]); w.w = cvt_pk_bf16(o1[6], o1[7]); *(GAS v4u*)dst = w;
                    w.x = cvt_pk_bf16(o2[0], o2[1]); w.y = cvt_pk_bf16(o2[2], o2[3]); w.z = cvt_pk_bf16(o2[4], o2[5]); w.w = cvt_pk_bf16(o2[6], o2[7]); *(GAS v4u*)(dst + 128) = w;
                    if (type == 4) {
                        const float zf = dtl[(0 * 8 + hh) * DT_STRIDE + 256 + (s & 127)], zb = dtl[(1 * 8 + hh) * DT_STRIDE + 256 + (s & 127)];
                        bf16* df = KzTf + ((size_t)((bl * 8 + hh) * 256 + c0)) * SEQ + s; bf16* db = KzTb + ((size_t)((bl * 8 + hh) * 256 + c0)) * SEQ + s;
#pragma unroll
                        for (int e = 0; e < 8; ++e) { df[(size_t)e * SEQ] = (bf16)f2bf(o1[e] * zf); df[(size_t)(128 + e) * SEQ] = (bf16)f2bf(o2[e] * zf);
                            db[(size_t)e * SEQ] = (bf16)f2bf(o1[e] * zb); db[(size_t)(128 + e) * SEQ] = (bf16)f2bf(o2[e] * zb); }
                    }
                }
            }
    }
};
struct EpiGate1 {
    static constexpr bool PERM = true;
    bf16* retn; const bf16* na; bf16* mix; const float* rs;
    __device__ __forceinline__ void operator()(AccRef acc, const Unit& u, int wr, int wc, int fr, int fq) const {
        const bool isg = u.pn < 8; const int cg = (u.pn & 7) * 256 + wc * 32 + 8 * fq;
#pragma unroll
        for (int ai = 0; ai < 2; ++ai)
#pragma unroll
            for (int m = 0; m < 4; ++m) { const int r = u.pm * 256 + ai * 128 + wr * 64 + m * 16 + fr; const float rv = rs[r];
#pragma unroll
                for (int bj = 0; bj < 2; ++bj) { const size_t off = (size_t)r * D + cg + bj * 128;
                    const v4u in = *(const GAS v4u*)((isg ? retn : na) + off);
                    const f32x4 v0 = acc[ai][bj][m][0] * rv, v1 = acc[ai][bj][m][1] * rv; float o[8];
                    const float x[8] = {bflo(in.x), bfhi(in.x), bflo(in.y), bfhi(in.y), bflo(in.z), bfhi(in.z), bflo(in.w), bfhi(in.w)};
#pragma unroll
                    for (int e = 0; e < 4; ++e) { o[e] = x[e] * (isg ? siluf_(v0[e]) : sigmoidf_(v0[e])); o[4 + e] = x[4 + e] * (isg ? siluf_(v1[e]) : sigmoidf_(v1[e])); }
                    v4u w; w.x = cvt_pk_bf16(o[0], o[1]); w.y = cvt_pk_bf16(o[2], o[3]); w.z = cvt_pk_bf16(o[4], o[5]); w.w = cvt_pk_bf16(o[6], o[7]);
                    *(GAS v4u*)((isg ? retn : mix) + off) = w; } }
    }
};
struct EpiGate2 {
    static constexpr bool PERM = true;
    const bf16* t2; bf16* mix; const float* rs;
    __device__ __forceinline__ void operator()(AccRef acc, const Unit& u, int wr, int wc, int fr, int fq) const {
        const int cg = u.pn * 256 + wc * 32 + 8 * fq;
#pragma unroll
        for (int ai = 0; ai < 2; ++ai)
#pragma unroll
            for (int m = 0; m < 4; ++m) { const int r = u.pm * 256 + ai * 128 + wr * 64 + m * 16 + fr; const float rv = rs[r];
#pragma unroll
                for (int bj = 0; bj < 2; ++bj) { const size_t off = (size_t)r * D + cg + bj * 128;
                    const v4u a = *(const GAS v4u*)(t2 + off), b = *(const GAS v4u*)(mix + off);
                    const f32x4 v0 = acc[ai][bj][m][0] * rv, v1 = acc[ai][bj][m][1] * rv; float o[8];
                    const float x[8] = {bflo(a.x), bfhi(a.x), bflo(a.y), bfhi(a.y), bflo(a.z), bfhi(a.z), bflo(a.w), bfhi(a.w)};
                    const float y[8] = {bflo(b.x), bfhi(b.x), bflo(b.y), bfhi(b.y), bflo(b.z), bfhi(b.z), bflo(b.w), bfhi(b.w)};
#pragma unroll
                    for (int e = 0; e < 4; ++e) { o[e] = y[e] + x[e] * sigmoidf_(v0[e]); o[4 + e] = y[4 + e] + x[4 + e] * sigmoidf_(v1[e]); }
                    v4u w; w.x = cvt_pk_bf16(o[0], o[1]); w.y = cvt_pk_bf16(o[2], o[3]); w.z = cvt_pk_bf16(o[4], o[5]); w.w = cvt_pk_bf16(o[6], o[7]);
                    *(GAS v4u*)(mix + off) = w; } }
    }
};
struct EpiRes {
    static constexpr bool PERM = false;
    const float* src; float* dst; int row0;
    __device__ __forceinline__ void operator()(AccRef acc, const Unit& u, int wr, int wc, int fr, int fq) const {
        const int col0 = u.pn * 256 + wc * 32 + 4 * fq;
#pragma unroll
        for (int ai = 0; ai < 2; ++ai)
#pragma unroll
            for (int m = 0; m < 4; ++m) { const size_t off = (size_t)(row0 + u.pm * 256 + ai * 128 + wr * 64 + m * 16 + fr) * D + col0;
#pragma unroll
                for (int bj = 0; bj < 2; ++bj)
#pragma unroll
                    for (int n = 0; n < 2; ++n) { const f32x4 b = *(const GAS f32x4*)(src + off + bj * 128 + n * 16); *(GAS f32x4*)(dst + off + bj * 128 + n * 16) = b + acc[ai][bj][m][n]; } }
    }
};
struct EpiPle {
    static constexpr bool PERM = false;
    float* x; const bf16* pp; const float* rs;
    __device__ __forceinline__ void operator()(AccRef acc, const Unit& u, int wr, int wc, int fr, int fq) const {
        const int col0 = u.pn * 256 + wc * 32 + 4 * fq;
#pragma unroll
        for (int ai = 0; ai < 2; ++ai)
#pragma unroll
            for (int m = 0; m < 4; ++m) { const int r = u.pm * 256 + ai * 128 + wr * 64 + m * 16 + fr; const float rv = rs[r]; const size_t off = (size_t)r * D + col0;
#pragma unroll
                for (int bj = 0; bj < 2; ++bj)
#pragma unroll
                    for (int n = 0; n < 2; ++n) { const size_t o2 = off + bj * 128 + n * 16; const f32x4 b = *(const GAS f32x4*)(x + o2); const v2u p = *(const GAS v2u*)(pp + o2); const f32x4 a = acc[ai][bj][m][n] * rv;
                        f32x4 o; o.x = b.x + sigmoidf_(a.x) * bflo(p.x); o.y = b.y + sigmoidf_(a.y) * bfhi(p.x); o.z = b.z + sigmoidf_(a.z) * bflo(p.y); o.w = b.w + sigmoidf_(a.w) * bfhi(p.y);
                        *(GAS f32x4*)(x + o2) = o; } }
    }
};
struct EpiBf {
    static constexpr bool PERM = true;
    bf16* O; int ldc; const float* rowscale;
    __device__ __forceinline__ void operator()(AccRef acc, const Unit& u, int wr, int wc, int fr, int fq) const {
        const int col0 = u.pn * 256 + wc * 32 + 8 * fq;
#pragma unroll
        for (int ai = 0; ai < 2; ++ai)
#pragma unroll
            for (int m = 0; m < 4; ++m) { const int r = u.pm * 256 + ai * 128 + wr * 64 + m * 16 + fr; const float rv = rowscale ? rowscale[r] : 1.0f;
#pragma unroll
                for (int bj = 0; bj < 2; ++bj) { const f32x4 v0 = acc[ai][bj][m][0] * rv, v1 = acc[ai][bj][m][1] * rv; v4u w; w.x = cvt_pk_bf16(v0[0], v0[1]); w.y = cvt_pk_bf16(v0[2], v0[3]); w.z = cvt_pk_bf16(v1[0], v1[1]); w.w = cvt_pk_bf16(v1[2], v1[3]);
                    *(GAS v4u*)(O + (size_t)r * ldc + col0 + bj * 128) = w; } }
    }
};
struct EpiGU {
    static constexpr bool PERM = true;
    bf16* act; const float* rs; const int* ltok;
    __device__ __forceinline__ void operator()(AccRef acc, const Unit& u, int wr, int wc, int fr, int fq) const {
        const int col0 = u.pn * 128 + wc * 16 + 4 * fq;
#pragma unroll
        for (int ai = 0; ai < 2; ++ai)
#pragma unroll
            for (int m = 0; m < 4; ++m) { const int r = u.pm * 256 + ai * 128 + wr * 64 + m * 16 + fr; const float rv = rs[ltok[r]];
#pragma unroll
                for (int bj = 0; bj < 2; ++bj) { const f32x4 gt = acc[ai][bj][m][0] * rv, up = acc[ai][bj][m][1] * rv;
                    v2u w; w.x = cvt_pk_bf16(siluf_(gt[0]) * up[0], siluf_(gt[1]) * up[1]); w.y = cvt_pk_bf16(siluf_(gt[2]) * up[2], siluf_(gt[3]) * up[3]);
                    *(GAS v2u*)(act + (size_t)r * DFF + col0 + bj * 64) = w; } }
    }
};

struct Args { const float* in[19]; float* out; unsigned char* ws; int ph_lo, ph_hi; };
enum { PH_PRO = 0, PH_L0 = 1, PH_PER_HALF = 7, PH_PER_LAYER = 2 * PH_PER_HALF + 9, PH_FINAL = PH_L0 + DEPTH * PH_PER_LAYER, PH_COUNT = PH_FINAL + 1 };

template <int ONLYC>
__global__ void __launch_bounds__(NWAVES * 64, 2) fwd_kernel(Args args) {
    extern __shared__ __attribute__((aligned(16))) unsigned char lds_raw[];
    Frame F;
    F.lds = (LAS unsigned char*)lds_raw;
    F.MISC = (volatile LAS unsigned*)(F.lds + MISC_OFF);
    F.tid = threadIdx.x; F.lane = F.tid & 63; F.wave = __builtin_amdgcn_readfirstlane(F.tid >> 6);
    F.G = gridDim.x; { const int bx = blockIdx.x; F.vcu = (F.G % 8 == 0) ? (bx % 8) * (F.G / 8) + bx / 8 : bx; }
    F.ws = args.ws; F.out = args.out;
    if (F.tid < 64) F.MISC[F.tid] = 0u;
    __syncthreads();
    unsigned* ctl = (unsigned*)(F.ws + WS_CTL);
    const int lo = args.ph_lo, hi = args.ph_hi;
    XcdBarrier bar; bar.bar = ctl + CW_BAR; bar.x = 0; bar.st = nullptr;
    if (hi - lo > 1) bar = xcd_barrier_post(ctl + CW_BAR, F.MISC);
#define EN(cls) (ONLYC < 0 || ONLYC == (cls))
#define IN(k) (lo <= (k) && (k) < hi)
#define SEAM(k) do { if (IN((k) + 1)) xcd_barrier(bar); } while (0)

    float* xres = F.out;
    bf16* hb = (bf16*)(F.ws + WS_HB); float* rs = (float*)(F.ws + WS_RS);

    if (EN(0) && IN(PH_PRO)) { p0_prologue(F, args.in[1], args.in[2], args.in[3], args.in[5], args.in[6], args.in[8], args.in[9], args.in[10], args.in[11], args.in[12], args.in[13], args.in[14], args.in[15], args.in[16], args.in[17]); SEAM(PH_PRO); }

    for (int layer = 0; layer < DEPTH; ++layer) {
        const int pb0 = PH_L0 + layer * PH_PER_LAYER;
        unsigned char* wl = F.ws + WS_W + (size_t)layer * W_LAYER;
        const float* dtl = (const float*)(F.ws + WS_DT) + (size_t)layer * 16 * DT_STRIDE;
        const float* xsrc = layer == 0 ? args.in[0] : xres;
        if (EN(1) && IN(pb0)) { rowpass<0>(F, xsrc, nullptr, nullptr); SEAM(pb0); }
        for (int half = 0; half < 2; ++half) {
            const int ph = pb0 + 1 + half * PH_PER_HALF;
            const unsigned row0 = (unsigned)half * HT;
            bf16 *Qn = (bf16*)(F.ws + WS_QN), *Kn = (bf16*)(F.ws + WS_KN), *VnT = (bf16*)(F.ws + WS_VNT), *Qr = (bf16*)(F.ws + WS_QR), *Kr = (bf16*)(F.ws + WS_KR),
                 *KzTf = (bf16*)(F.ws + WS_KZF), *KzTb = (bf16*)(F.ws + WS_KZB), *VrT = (bf16*)(F.ws + WS_VRT), *Pf = (bf16*)(F.ws + WS_PF), *Pb = (bf16*)(F.ws + WS_PBW),
                 *mix = (bf16*)(F.ws + WS_MIX), *Of = (bf16*)(F.ws + WS_OF), *Ob = (bf16*)(F.ws + WS_OB);
            if (EN(2) && IN(ph + 0)) {
                LinSched S; S.init(HT, NPROJ, D, F.G, (int)blockIdx.x, row0, (const bf16*)(wl + W_IN));
                EpiProj E{Qn, Kn, VnT, Qr, Kr, KzTf, KzTb, VrT, rs + row0, (const float*)(F.ws + WS_ROPE), (const float*)(F.ws + WS_ROPE) + SEQ * 128, dtl};
                pg8::gemm_phase<EpiProj, LinSched>(F.lds, hb, D, S, E);
                SEAM(ph + 0);
            }
            if (EN(3) && IN(ph + 1)) {
                const float* rpb = args.in[4] + (size_t)layer * 16 * 15 * 31;
                for (int k = 0; k < 16; ++k) na_unit(F, Qn, Kn, VnT, Qn, rpb, F.vcu * 16 + k);
                for (int k = 0; k < 4; ++k) rp_unit(F, Qr, Kr, Pf, Pb, dtl, F.vcu * 4 + k);
                SEAM(ph + 1);
            }
            if (EN(4) && IN(ph + 2)) {
                if ((F.vcu & 1) == 0) { const int job = F.vcu >> 1; const int vs = job & 3, dir = (job >> 2) & 1, h = (job >> 3) & 7, bl = job >> 6;
                    rs_job(F, Qr, dir == 0 ? KzTf : KzTb, VrT, dir == 0 ? Pf : Pb, dir == 0 ? Of : Ob, dtl + (size_t)(dir * 8 + h) * DT_STRIDE, bl, h, dir, vs); }
                SEAM(ph + 2);
            }
            if (EN(5) && IN(ph + 3)) { rn_phase(F, Of, Ob, args.in[7] + (size_t)layer * D); SEAM(ph + 3); }
            if (EN(6) && IN(ph + 4)) {
                LinSched S; S.init(HT, 4096, D, F.G, (int)blockIdx.x, row0, (const bf16*)(wl + W_IN) + (size_t)NPROJ * D);
                EpiGate1 E{Of, Qn, mix, rs + row0};
                pg8::gemm_phase<EpiGate1, LinSched>(F.lds, hb, D, S, E);
                SEAM(ph + 4);
            }
            if (EN(7) && IN(ph + 5)) {
                LinSched S; S.init(HT, 2048, D, F.G, (int)blockIdx.x, row0, (const bf16*)(wl + W_IN) + (size_t)(NPROJ + 4096) * D);
                EpiGate2 E{Of, mix, rs + row0};
                pg8::gemm_phase<EpiGate2, LinSched>(F.lds, hb, D, S, E);
                SEAM(ph + 5);
            }
            if (EN(8) && IN(ph + 6)) {
                LinSched S; S.init(HT, D, D, F.G, (int)blockIdx.x, 0u, (const bf16*)(wl + W_OUT));
                EpiRes E{xsrc, xres, (int)row0};
                pg8::gemm_phase<EpiRes, LinSched>(F.lds, mix, D, S, E);
                SEAM(ph + 6);
            }
        }
        const int pm0 = pb0 + 1 + 2 * PH_PER_HALF;
        if (EN(1) && IN(pm0 + 0)) { rowpass<0>(F, xres, nullptr, nullptr); SEAM(pm0 + 0); }
        if (EN(9) && IN(pm0 + 1)) { router_phase(F, xres, layer); SEAM(pm0 + 1); }
        if (EN(10) && IN(pm0 + 2)) { lists_phase(F); SEAM(pm0 + 2); }
        if (IN(pm0 + 3) || IN(pm0 + 4)) {
            const int* meta = (const int*)(F.ws + WS_META);
            if (F.tid < 33) F.MISC[16 + F.tid] = (unsigned)__hip_atomic_load(meta + F.tid, __ATOMIC_RELAXED, __HIP_MEMORY_SCOPE_AGENT);
            __syncthreads();
        }
        if (EN(11) && IN(pm0 + 3)) {
            MoeSched<true> S{(const volatile LAS int*)(F.MISC + 16), 4, F.G, (int)blockIdx.x, (const int*)(F.ws + WS_LTOK), (const char*)(wl + W_GU), (size_t)1024 * D * 2, (size_t)256 * D * 2};
            EpiGU E{(bf16*)(F.ws + WS_ACT), rs, (const int*)(F.ws + WS_LTOK)};
            pg8::gemm_phase<EpiGU, MoeSched<true>>(F.lds, hb, D, S, E);
            SEAM(pm0 + 3);
        }
        if (EN(12) && IN(pm0 + 4)) {
            MoeSched<false> S{(const volatile LAS int*)(F.MISC + 16), 8, F.G, (int)blockIdx.x, nullptr, (const char*)(wl + W_DN), (size_t)D * DFF * 2, (size_t)256 * DFF * 2};
            EpiBf E{(bf16*)(F.ws + WS_YP), D, (const float*)(F.ws + WS_LW)};
            pg8::gemm_phase<EpiBf, MoeSched<false>>(F.lds, (const bf16*)(F.ws + WS_ACT), DFF, S, E);
            SEAM(pm0 + 4);
        }
        if (EN(13) && IN(pm0 + 5)) { rowpass<1>(F, xres, xres, nullptr); SEAM(pm0 + 5); }
        if (EN(14) && IN(pm0 + 6)) {
            LinSched S; S.init(T, D, PLE, F.G, (int)blockIdx.x, 0u, (const bf16*)(wl + W_PP));
            EpiBf E{(bf16*)(F.ws + WS_PP), D, nullptr};
            pg8::gemm_phase<EpiBf, LinSched>(F.lds, (const bf16*)(F.ws + WS_PB) + (size_t)layer * T * PLE, PLE, S, E);
            SEAM(pm0 + 6);
        }
        if (EN(15) && IN(pm0 + 7)) {
            LinSched S; S.init(T, D, D, F.G, (int)blockIdx.x, 0u, (const bf16*)(wl + W_PG));
            EpiPle E{xres, (const bf16*)(F.ws + WS_PP), rs};
            pg8::gemm_phase<EpiPle, LinSched>(F.lds, hb, D, S, E);
            SEAM(pm0 + 7);
        }
    }
    if (EN(16) && IN(PH_FINAL)) rowpass<2>(F, xres, xres, args.in[18]);
#undef IN
#undef SEAM
}

#ifndef MK_SINGLE
#define MK_SINGLE 0
#endif
typedef void (*KernFn)(Args);
static int phase_class(int p) {
    if (p == PH_PRO) return 0; if (p == PH_FINAL) return 16;
    const int q = (p - PH_L0) % PH_PER_LAYER;
    if (q == 0) return 1;
    if (q <= 2 * PH_PER_HALF) return 2 + (q - 1) % PH_PER_HALF;
    static const int tail[8] = {1, 9, 10, 11, 12, 13, 14, 15};
    return tail[q - 1 - 2 * PH_PER_HALF];
}
extern "C" void kernel_launch(void* const* d_in, const int* in_sizes, int n_in, void* d_out, int out_size, void* d_ws, size_t ws_size, hipStream_t stream) {
    static int grid = 0;
#if MK_SINGLE
    static KernFn fns[1] = { fwd_kernel<-1> };
    constexpr int NF = 1;
#else
    static KernFn fns[17] = { fwd_kernel<0>, fwd_kernel<1>, fwd_kernel<2>, fwd_kernel<3>, fwd_kernel<4>, fwd_kernel<5>, fwd_kernel<6>, fwd_kernel<7>, fwd_kernel<8>, fwd_kernel<9>, fwd_kernel<10>, fwd_kernel<11>, fwd_kernel<12>, fwd_kernel<13>, fwd_kernel<14>, fwd_kernel<15>, fwd_kernel<16> };
    constexpr int NF = 17;
#endif
    if (grid == 0) {
        if (n_in != 19 || out_size != T * D || ws_size < WS_END) { fprintf(stderr, "kernel_launch: unexpected shapes (n_in %d, out %d, ws %zu < %zu)\n", n_in, out_size, ws_size, (size_t)WS_END); grid = -1; return; }
        int dev = 0, cus = 0, per_cu = 0;
        if (hipGetDevice(&dev) != hipSuccess || hipDeviceGetAttribute(&cus, hipDeviceAttributeMultiprocessorCount, dev) != hipSuccess) { grid = -1; return; }
        for (int i = 0; i < NF; ++i) {
            if (hipFuncSetAttribute((const void*)fns[i], hipFuncAttributeMaxDynamicSharedMemorySize, LDS_BYTES) != hipSuccess) { fprintf(stderr, "kernel_launch: hipFuncSetAttribute failed\n"); grid = -1; return; }
            if (hipOccupancyMaxActiveBlocksPerMultiprocessor(&per_cu, (const void*)fns[i], NWAVES * 64, LDS_BYTES) != hipSuccess || per_cu < 1) { fprintf(stderr, "kernel_launch: occupancy query says %d for fn %d\n", per_cu, i); grid = -1; return; }
        }
        (void)hipGetLastError();
        grid = cus < 256 ? cus : 256;
    }
    if (grid < 0) return;
    (void)hipMemsetAsync((char*)d_ws + WS_CTL, 0, CTL_ZERO_BYTES, stream);
    Args a{};
    for (int i = 0; i < 19; ++i) a.in[i] = (const float*)d_in[i];
    a.out = (float*)d_out; a.ws = (unsigned char*)d_ws;
#if MK_SINGLE
    a.ph_lo = 0; a.ph_hi = PH_COUNT;
    hipLaunchKernelGGL(fns[0], dim3(grid), dim3(NWAVES * 64), LDS_BYTES, stream, a);
#else
    for (int p = 0; p < PH_COUNT; ++p) { a.ph_lo = p; a.ph_hi = p + 1; hipLaunchKernelGGL(fns[phase_class(p)], dim3(grid), dim3(NWAVES * 64), LDS_BYTES, stream, a); }
#endif
}
```

```cpp
#include <hip/hip_runtime.h>
#include <cstdio>
#include <cstdint>
namespace pg8 {
#define PG8_LAS __attribute__((address_space(3)))
typedef unsigned short bf16_t;
typedef short bf16x8 __attribute__((ext_vector_type(8)));
typedef float f32x4 __attribute__((ext_vector_type(4)));
typedef unsigned u32x4 __attribute__((ext_vector_type(4)));
typedef unsigned u32x2 __attribute__((ext_vector_type(2)));
constexpr int BM = 256, BK = 64, HALF = 128, HTB = HALF * BK * 2  , STAGE_BYTES = 8 * HTB, NXCD = 8, WGM = 8;

__host__ __device__ __forceinline__ int lds_byte(int r, int c) { const int st = (r >> 4) * 2 + (c >> 5), rr = r & 15, cc = c & 31, ob = rr * 64 + cc * 2; return st * 1024 + (ob ^ (((ob >> 9) & 1) << 5)); }
__host__ __device__ __forceinline__ void stage_rc(int b, int& R, int& C) { const int st = b / 1024, sb = b % 1024, swz = sb ^ (((sb >> 9) & 1) << 5); R = (st >> 1) * 16 + swz / 64; C = (st & 1) * 32 + (swz % 64) / 2; }
__host__ __device__ __forceinline__ int perm32(int rho) { const int n = rho >> 4, i = rho & 15; return 8 * (i >> 2) + 4 * n + (i & 3); }

struct Unit { int pm, pn, e; };

struct DenseOrder {
    int nM, nN, nwg, G, c;
    __device__ __forceinline__ void init(int M, int N, int G_, int c_) { nM = M / BM; nN = N / BM; nwg = nM * nN; G = G_; c = c_; }
    __device__ __forceinline__ bool next_mn(int i, int& pm, int& pn) const {
        const long L = (long)i * G + c; if (L >= nwg) return false;
        int wgid = (int)L; { const int q = nwg / NXCD, r = nwg % NXCD, xcd = wgid % NXCD, off = wgid / NXCD; wgid = (xcd < r ? xcd * (q + 1) : r * (q + 1) + (xcd - r) * q) + off; }
        const int nig = WGM * nN, gid = wgid / nig, fm = gid * WGM, gsz = (nM - fm) < WGM ? (nM - fm) : WGM;
        pm = fm + ((wgid % nig) % gsz); pn = (wgid % nig) / gsz; return true;
    }
};

__device__ __forceinline__ unsigned cvt_pk_bf16(float lo, float hi) { unsigned r; asm volatile("v_cvt_pk_bf16_f32 %0, %1, %2" : "=v"(r) : "v"(lo), "v"(hi)); return r; }

template <class Epi, class Sched>
__device__ __forceinline__ void gemm_phase(PG8_LAS unsigned char* lds, const bf16_t* Abase_, const int K, const Sched& S, const Epi& E) {
    int tid_ = threadIdx.x; asm volatile("" : "+v"(tid_));
    const int tid = tid_, wid = __builtin_amdgcn_readfirstlane(tid >> 6), lane = tid & 63, wr = wid >> 2, wc = wid & 3, fr = lane & 15, fq = lane >> 4;
    const int nt = K / BK;
    const char* Abase = (const char*)Abase_;
    int RA0, RA1; unsigned CA0, CA1; unsigned voffB[2];
    { int R, C; stage_rc(tid * 16, R, C); RA0 = R; CA0 = (unsigned)C * 2u; const int Rb = Epi::PERM ? ((R & ~31) + perm32(R & 31)) : R; voffB[0] = (unsigned)(Rb * K + C) * 2u;
      stage_rc(tid * 16 + 8192, R, C); RA1 = R; CA1 = (unsigned)C * 2u; const int Rb1 = Epi::PERM ? ((R & ~31) + perm32(R & 31)) : R; voffB[1] = (unsigned)(Rb1 * K + C) * 2u; }
    const unsigned rowb = (unsigned)K * 2u;
    const size_t kstep = (size_t)(BK * 2);
    const size_t hstep = (size_t)HALF * K * 2;
    const unsigned ldsw = (unsigned)wid * 1024u;
    const int aoff = lds_byte(wr * 64 + fr, fq * 8), boff = lds_byte(wc * 32 + fr, fq * 8);
#define PG8_SA(b, h) (((b) * 2 + (h)) * HTB)
#define PG8_SB(b, h) ((4 + (b) * 2 + (h)) * HTB)
#define PG8_STAGE2(bufoff, gbase, o0, o1) do { \
        __builtin_amdgcn_global_load_lds((const unsigned*)((const char*)(gbase) + (o0)), (PG8_LAS unsigned*)(lds + (bufoff) + ldsw), 16, 0, 0); \
        __builtin_amdgcn_global_load_lds((const unsigned*)((const char*)(gbase) + (o1)), (PG8_LAS unsigned*)(lds + (bufoff) + ldsw + 8192), 16, 0, 0); } while (0)
#define PG8_STAGEB(bufoff, gbase) PG8_STAGE2(bufoff, gbase, voffB[0], voffB[1])
#define PG8_LDA(dst, b, h) do { _Pragma("unroll") for (int m = 0; m < 4; ++m) _Pragma("unroll") for (int k = 0; k < 2; ++k) dst[m][k] = *(const PG8_LAS bf16x8*)(lds + PG8_SA(b, h) + aoff + m * 2048 + k * 1024); } while (0)
#define PG8_LDB(dst, b, h) do { _Pragma("unroll") for (int n = 0; n < 2; ++n) _Pragma("unroll") for (int k = 0; k < 2; ++k) dst[n][k] = *(const PG8_LAS bf16x8*)(lds + PG8_SB(b, h) + boff + n * 2048 + k * 1024); } while (0)
#define PG8_MMA(ai, bj, At, Bt) do { __builtin_amdgcn_s_setprio(1); _Pragma("unroll") for (int m = 0; m < 4; ++m) _Pragma("unroll") for (int n = 0; n < 2; ++n) _Pragma("unroll") for (int k = 0; k < 2; ++k) \
        acc[ai][bj][m][n] = __builtin_amdgcn_mfma_f32_16x16x32_bf16(Bt[n][k], At[m][k], acc[ai][bj][m][n], 0, 0, 0); __builtin_amdgcn_s_setprio(0); } while (0)
#define PG8_WAIT_V(n) asm volatile("s_waitcnt vmcnt(" #n ")" ::: "memory")
#define PG8_WAIT_L(n) asm volatile("s_waitcnt lgkmcnt(" #n ")" ::: "memory")
#define PG8_BAR __builtin_amdgcn_s_barrier()
#define PG8_SCHED __builtin_amdgcn_sched_barrier(0)
    Unit cur, nxt; int ui = 0;
    if (!S.next(0, cur)) return;
    f32x4 acc[2][2][4][2];
#pragma unroll
    for (int a = 0; a < 2; ++a)
#pragma unroll
        for (int b = 0; b < 2; ++b)
#pragma unroll
            for (int m = 0; m < 4; ++m)
#pragma unroll
                for (int n = 0; n < 2; ++n) acc[a][b][m][n] = (f32x4){0.f, 0.f, 0.f, 0.f};
    bf16x8 At[4][2], B0[2][2], B1[2][2];
    unsigned v00, v01, v10, v11;
    if constexpr (Sched::GATHER) { v00 = S.a_row(cur, RA0) * rowb + CA0; v01 = S.a_row(cur, RA1) * rowb + CA1; v10 = S.a_row(cur, HALF + RA0) * rowb + CA0; v11 = S.a_row(cur, HALF + RA1) * rowb + CA1; }
    else { v00 = (unsigned)RA0 * rowb + CA0; v01 = (unsigned)RA1 * rowb + CA1; v10 = (unsigned)(HALF + RA0) * rowb + CA0; v11 = (unsigned)(HALF + RA1) * rowb + CA1; }
    const char* cA = Abase + S.a_off(cur, rowb);
    const char* cB = S.b_base(cur);
    PG8_STAGEB(PG8_SB(0, 0), cB); PG8_STAGEB(PG8_SB(0, 1), cB + hstep); PG8_STAGE2(PG8_SA(0, 0), cA, v00, v01); PG8_STAGE2(PG8_SA(0, 1), cA, v10, v11);
    if (wr == 1) PG8_BAR;
    PG8_WAIT_V(2); PG8_BAR;
    PG8_STAGEB(PG8_SB(1, 0), cB + kstep); PG8_STAGE2(PG8_SA(1, 0), cA + kstep, v00, v01); PG8_STAGEB(PG8_SB(1, 1), cB + hstep + kstep);
    PG8_WAIT_V(6); PG8_BAR;
    for (;;) {
        const bool has_next = S.next(ui + 1, nxt);
        unsigned n00 = v00, n01 = v01, n10 = v10, n11 = v11; const char* nB = cB; const char* nA = cA;
        if (has_next) { nB = S.b_base(nxt); nA = Abase + S.a_off(nxt, rowb);
            if constexpr (Sched::GATHER) { n00 = S.a_row(nxt, RA0) * rowb + CA0; n01 = S.a_row(nxt, RA1) * rowb + CA1; n10 = S.a_row(nxt, HALF + RA0) * rowb + CA0; n11 = S.a_row(nxt, HALF + RA1) * rowb + CA1; } }
#pragma unroll 1
        for (int t = 0; t < nt; t += 2) {
            const bool last = (t == nt - 2);
            const char* a1 = cA + (size_t)(t + 1) * kstep;
            const char* a2 = last ? nA : cA + (size_t)(t + 2) * kstep; const char* b2 = last ? nB : cB + (size_t)(t + 2) * kstep;
            const char* a3 = a2 + kstep; const char* b3 = b2 + kstep;
            unsigned w00 = v00, w01 = v01, w10 = v10, w11 = v11;
            if constexpr (Sched::GATHER) { w00 = last ? n00 : v00; w01 = last ? n01 : v01; w10 = last ? n10 : v10; w11 = last ? n11 : v11; }
            PG8_LDB(B0, 0, 0); PG8_LDB(B1, 0, 1); PG8_SCHED; PG8_LDA(At, 0, 0); PG8_STAGE2(PG8_SA(1, 1), a1, v10, v11);
            PG8_WAIT_V(8); PG8_WAIT_L(0); PG8_BAR; PG8_MMA(0, 0, At, B0); PG8_MMA(0, 1, At, B1); PG8_BAR; PG8_SCHED;
            PG8_LDA(At, 0, 1); PG8_STAGEB(PG8_SB(0, 0), b2); PG8_STAGEB(PG8_SB(0, 1), b2 + hstep); PG8_STAGE2(PG8_SA(0, 0), a2, w00, w01);
            PG8_WAIT_V(8); PG8_WAIT_L(0); PG8_BAR; PG8_MMA(1, 0, At, B0); PG8_MMA(1, 1, At, B1); PG8_BAR; PG8_SCHED;
            PG8_LDB(B0, 1, 0); PG8_LDB(B1, 1, 1); PG8_SCHED; PG8_LDA(At, 1, 0); PG8_STAGE2(PG8_SA(0, 1), a2, w10, w11);
            PG8_WAIT_V(8); PG8_WAIT_L(0); PG8_BAR; PG8_MMA(0, 0, At, B0); PG8_MMA(0, 1, At, B1); PG8_BAR; PG8_SCHED;
            PG8_LDA(At, 1, 1); PG8_STAGEB(PG8_SB(1, 0), b3); PG8_STAGEB(PG8_SB(1, 1), b3 + hstep); PG8_STAGE2(PG8_SA(1, 0), a3, w00, w01);
            PG8_WAIT_V(8); PG8_WAIT_L(0); PG8_BAR; PG8_MMA(1, 0, At, B0); PG8_MMA(1, 1, At, B1); PG8_BAR; PG8_SCHED;
        }
        if (wr == 0) PG8_BAR;
        E(acc, cur, wr, wc, fr, fq);
        if (!has_next) break;
#pragma unroll
        for (int a = 0; a < 2; ++a)
#pragma unroll
            for (int b = 0; b < 2; ++b)
#pragma unroll
                for (int m = 0; m < 4; ++m)
#pragma unroll
                    for (int n = 0; n < 2; ++n) acc[a][b][m][n] = (f32x4){0.f, 0.f, 0.f, 0.f};
        cur = nxt; cB = nB; cA = nA; ++ui;
        if constexpr (Sched::GATHER) { v00 = n00; v01 = n01; v10 = n10; v11 = n11; }
        if (wr == 1) PG8_BAR;
    }
    PG8_WAIT_V(0);
    PG8_BAR;
#undef PG8_SA
#undef PG8_SB
#undef PG8_STAGE2
#undef PG8_STAGEB
#undef PG8_LDA
#undef PG8_LDB
#undef PG8_MMA
#undef PG8_WAIT_V
#undef PG8_WAIT_L
#undef PG8_BAR
#undef PG8_SCHED
}
}
constexpr int NWAVES = 8;
constexpr int D = 2048, BATCH = 4, SEQ = 8192, T = BATCH * SEQ, DEPTH = 2;
constexpr int NIN = 18432, PLE = 256, NEXP = 32, DFF = 512;
constexpr int HT = 16384;
constexpr int NPROJ = 12288;
constexpr float EPS = 1e-6f;
constexpr int MAXTILES = 288;
constexpr int APAD = MAXTILES * 256;

constexpr size_t MiB = 1u << 20;
constexpr size_t WS_CTL = 0, CTL_ZERO_BYTES = 1 * MiB;
constexpr size_t WS_DT = 1 * MiB;
constexpr int DT_STRIDE = 512;
constexpr size_t WS_WR = 2 * MiB;
constexpr size_t WS_ROPE = 4 * MiB;
constexpr size_t WS_RS = 12 * MiB;
constexpr size_t WS_ROUTE = WS_RS + 128 * 1024;
constexpr size_t WS_INV = WS_ROUTE + 512 * 1024;
constexpr size_t WS_LTOK = WS_INV + 256 * 1024;
constexpr size_t WS_LW = WS_LTOK + 288 * 1024;
constexpr size_t WS_META = WS_LW + 288 * 1024;
constexpr size_t WS_PB = 16 * MiB;
constexpr size_t WS_W = 48 * MiB;
constexpr size_t W_IN = 0, W_OUT = 72 * MiB, W_GU = 80 * MiB, W_DN = 208 * MiB, W_PG = 272 * MiB, W_PP = 280 * MiB, W_LAYER = 282 * MiB;
constexpr size_t WS_HB = WS_W + 2 * W_LAYER;
constexpr size_t WS_PROJ = WS_HB + 128 * MiB;
constexpr size_t PJ = 64 * MiB;
constexpr size_t WS_QN = WS_PROJ, WS_KN = WS_PROJ + PJ, WS_VNT = WS_PROJ + 2 * PJ, WS_QR = WS_PROJ + 3 * PJ, WS_KR = WS_PROJ + 4 * PJ, WS_KZF = WS_PROJ + 5 * PJ, WS_KZB = WS_PROJ + 6 * PJ, WS_VRT = WS_PROJ + 7 * PJ;
constexpr size_t WS_MIX = WS_KN, WS_OF = WS_KR, WS_OB = WS_VNT;
constexpr size_t WS_PF = WS_PROJ + 8 * PJ, WS_PBW = WS_PF + 32 * MiB;
constexpr size_t WS_END = WS_PBW + 32 * MiB;
constexpr size_t WS_ACT = WS_PROJ;
constexpr size_t WS_YP = WS_PROJ + 72 * MiB;
constexpr size_t WS_PP = WS_PROJ + 360 * MiB;
static_assert(WS_PP + 128 * MiB <= WS_PF, "pp inside proj region");
constexpr int CW_BAR = 4096;

constexpr int RING_BYTES = 131072;
constexpr int MISC_OFF = RING_BYTES;
constexpr int LDS_BYTES = 147456;

#define GAS __attribute__((address_space(1)))
#define LAS __attribute__((address_space(3)))
typedef unsigned short bf16;
typedef unsigned v4u __attribute__((ext_vector_type(4)));
typedef unsigned v2u __attribute__((ext_vector_type(2)));
typedef float f32x4 __attribute__((ext_vector_type(4)));
typedef short bf16x8 __attribute__((ext_vector_type(8)));
#define LDS_WAIT() asm volatile("s_waitcnt lgkmcnt(0)" ::: "memory")
#define VM_WAIT() asm volatile("s_waitcnt vmcnt(0)" ::: "memory")
__device__ __forceinline__ unsigned f2bf(float f) { unsigned u = __builtin_bit_cast(unsigned, f); return (u + 0x7fffu + ((u >> 16) & 1u)) >> 16; }
__device__ __forceinline__ unsigned pk2(float lo, float hi) { return f2bf(lo) | (f2bf(hi) << 16); }
__device__ __forceinline__ float bf2f(unsigned b) { return __builtin_bit_cast(float, b << 16); }
__device__ __forceinline__ float bflo(unsigned w) { return __builtin_bit_cast(float, w << 16); }
__device__ __forceinline__ float bfhi(unsigned w) { return __builtin_bit_cast(float, w & 0xffff0000u); }
__device__ __forceinline__ float sigmoidf_(float x) { return 1.0f / (1.0f + __expf(-x)); }
__device__ __forceinline__ float siluf_(float x) { return x / (1.0f + __expf(-x)); }
__device__ __forceinline__ float wave_sum(float v) {
#pragma unroll
    for (int o = 1; o < 64; o <<= 1) v += __shfl_xor(v, o);
    return v;
}

#define XB_TMO      128
#define XB_XCNT(j)  (256  + 64 * (j))
#define XB_XSUB(j)  (1280 + 64 * (j))
#define XB_XGEN(j)  (2304 + 64 * (j))
#define XB_TOP      3328
#define XB_TOPGEN   3392
#define XCD_BAR_WORDS 3456
#define XB_SPIN_CAP (1u << 18)
__device__ __forceinline__ unsigned xb_ld(unsigned* p)              { return __hip_atomic_load(p, __ATOMIC_RELAXED, __HIP_MEMORY_SCOPE_AGENT); }
__device__ __forceinline__ unsigned xb_add(unsigned* p, unsigned v) { return __hip_atomic_fetch_add(p, v, __ATOMIC_RELAXED, __HIP_MEMORY_SCOPE_AGENT); }
__device__ __forceinline__ unsigned xb_xcc_id() { return (unsigned)__builtin_amdgcn_s_getreg((3 << 11) | 20) & 0xFu; }
#define XB_SPIN(cond, bar) do { unsigned _sp = 0; while (cond) { __builtin_amdgcn_s_sleep(1); \
    if ((++_sp & 255u) == 0u) { if (xb_ld(&(bar)[XB_TMO])) break; if (_sp > XB_SPIN_CAP) { atomicAdd(&(bar)[XB_TMO], 1u); break; } } } } while (0)
struct XcdBarrier { unsigned* bar; unsigned x; volatile LAS unsigned* st; };
__device__ __forceinline__ XcdBarrier xcd_barrier_post(unsigned* bar, volatile LAS unsigned* st) {
    XcdBarrier b; b.bar = bar; b.x = xb_xcc_id(); b.st = st;
    if (threadIdx.x == 0) (void)xb_add(&bar[XB_XCNT(b.x)], 1u);
    return b;
}
__device__ __forceinline__ void xcd_barrier_complete(unsigned* bar, unsigned x, unsigned& nloc, unsigned& nx) {
    const unsigned G = gridDim.x * gridDim.y * gridDim.z;
    unsigned sum, cnt, mine, sp = 0u;
    for (;;) {
        sum = 0u; cnt = 0u; mine = 0u;
#pragma unroll
        for (unsigned j = 0; j < 16; ++j) { const unsigned c = xb_ld(&bar[XB_XCNT(j)]); sum += c; cnt += (c > 0u) ? 1u : 0u; mine = (j == x) ? c : mine; }
        if (sum == G) break;
        __builtin_amdgcn_s_sleep(1);
        if ((++sp & 255u) == 0u) { if (xb_ld(&bar[XB_TMO])) break; if (sp > XB_SPIN_CAP) { atomicAdd(&bar[XB_TMO], 1u); break; } }
    }
    nloc = mine > 0u ? mine : 1u; nx = cnt > 0u ? cnt : 1u;
}
__device__ __forceinline__ void xcd_barrier(const XcdBarrier& b) {
    asm volatile("s_waitcnt vmcnt(0)" ::: "memory");
    __syncthreads();
    if (threadIdx.x == 0) {
        unsigned* bar = b.bar;
        __builtin_amdgcn_s_waitcnt(0);
        unsigned nloc = b.st[0], nx = b.st[1];
        if (nloc == 0u) { xcd_barrier_complete(bar, b.x, nloc, nx); b.st[0] = nloc; b.st[1] = nx; }
        const unsigned old = xb_add(&bar[XB_XSUB(b.x)], 1u);
        const unsigned gen = old / nloc;
        if (old + 1u == (gen + 1u) * nloc) {
            __builtin_amdgcn_fence(__ATOMIC_RELEASE, "agent");
            asm volatile("s_waitcnt vmcnt(0)" ::: "memory");
            const unsigned og = xb_add(&bar[XB_TOP], 1u);
            const unsigned tg = og / nx;
            if (og + 1u == (tg + 1u) * nx) xb_add(&bar[XB_TOPGEN], 1u);
            else XB_SPIN(xb_ld(&bar[XB_TOPGEN]) == tg, bar);
            __builtin_amdgcn_fence(__ATOMIC_ACQUIRE, "agent");
            xb_add(&bar[XB_XGEN(b.x)], 1u);
            asm volatile("s_waitcnt vmcnt(0)" ::: "memory");
        } else {
            XB_SPIN(xb_ld(&bar[XB_XGEN(b.x)]) == gen, bar);
            __builtin_amdgcn_fence(__ATOMIC_ACQUIRE, "agent");
            asm volatile("s_waitcnt vmcnt(0)" ::: "memory");
        }
    }
    __syncthreads();
}

struct Frame {
    LAS unsigned char* lds;
    volatile LAS unsigned* MISC;
    int tid, lane, wave, vcu, G;
    unsigned char* ws;
    float* out;
};
__device__ __forceinline__ void tr_item(const float* W, int K, int N, const float* gain, bf16* WT, int mode, LAS float* scr, int item, int lane) {
    const int nblk = N / 32, kb = item / nblk, nb = item % nblk, k0 = 64 * kb, n0 = 32 * nb;
    float cs = 1.0f;
    if (mode == 1) { if (n0 < 2048) cs = 0.08838834764831845f; else if (n0 >= 8192 && n0 < 10240) cs = 0.0625f; }
#pragma unroll 8
    for (int i = 0; i < 32; ++i) { const int kk = 2 * i + (lane >> 5); const float g = gain ? gain[k0 + kk] * cs : cs; scr[kk * 33 + (lane & 31)] = W[(size_t)(k0 + kk) * N + n0 + (lane & 31)] * g; }
    LDS_WAIT(); asm volatile("" ::: "memory");
    const int c = lane & 7;
#pragma unroll
    for (int j = 0; j < 4; ++j) { const int n = (lane >> 3) + 8 * j; const LAS float* s = scr + (8 * c) * 33 + n;
        v4u o; o.x = pk2(s[0 * 33], s[1 * 33]); o.y = pk2(s[2 * 33], s[3 * 33]); o.z = pk2(s[4 * 33], s[5 * 33]); o.w = pk2(s[6 * 33], s[7 * 33]);
        const int nn = n0 + n; int dr = nn; if (mode == 2) dr = (nn >> 2) * 8 + (nn & 3); else if (mode == 3) dr = (nn >> 2) * 8 + 4 + (nn & 3);
        *(GAS v4u*)(WT + (size_t)dr * K + k0 + 8 * c) = o; }
    LDS_WAIT(); asm volatile("" ::: "memory");
}
__device__ __forceinline__ float log_sigmoidf_(float x) { return x >= 0.f ? -log1pf(expf(-x)) : x - log1pf(expf(x)); }

__device__ __forceinline__ void p0_prologue(Frame& F, const float* in_p, const float* in_nmix, const float* in_win, const float* in_decf, const float* in_decb, const float* in_wout, const float* in_nffn,
        const float* in_wrg, const float* in_wre, const float* in_wg, const float* in_wu, const float* in_wd, const float* in_nple, const float* in_wpg, const float* in_wpp) {
    LAS float* scr = (LAS float*)(F.lds + F.wave * 16384);
    const int gw = F.vcu * NWAVES + F.wave, NGW = F.G * NWAVES;
    constexpr int I_IN = 32 * 576, I_SQ = 2048, I_EX = 16384, I_PP = 256;
    constexpr int PER_LAYER = I_IN + I_SQ + 3 * I_EX + I_SQ + I_PP;
    for (int it = gw; it < DEPTH * PER_LAYER; it += NGW) {
        const int l = it / PER_LAYER; int r = it % PER_LAYER;
        unsigned char* wl = F.ws + WS_W + (size_t)l * W_LAYER;
        if (r < I_IN) { tr_item(in_win + (size_t)l * D * NIN, D, NIN, in_nmix + l * D, (bf16*)(wl + W_IN), 1, scr, r, F.lane); continue; } r -= I_IN;
        if (r < I_SQ) { tr_item(in_wout + (size_t)l * D * D, D, D, nullptr, (bf16*)(wl + W_OUT), 0, scr, r, F.lane); continue; } r -= I_SQ;
        if (r < I_EX) { const int e = r >> 9; tr_item(in_wg + ((size_t)l * NEXP + e) * D * DFF, D, DFF, in_nffn + l * D, (bf16*)(wl + W_GU) + (size_t)e * 1024 * D, 2, scr, r & 511, F.lane); continue; } r -= I_EX;
        if (r < I_EX) { const int e = r >> 9; tr_item(in_wu + ((size_t)l * NEXP + e) * D * DFF, D, DFF, in_nffn + l * D, (bf16*)(wl + W_GU) + (size_t)e * 1024 * D, 3, scr, r & 511, F.lane); continue; } r -= I_EX;
        if (r < I_EX) { const int e = r >> 9; tr_item(in_wd + ((size_t)l * NEXP + e) * DFF * D, DFF, D, nullptr, (bf16*)(wl + W_DN) + (size_t)e * D * DFF, 0, scr, r & 511, F.lane); continue; } r -= I_EX;
        if (r < I_SQ) { tr_item(in_wpg + (size_t)l * D * D, D, D, in_nple + l * D, (bf16*)(wl + W_PG), 0, scr, r, F.lane); continue; } r -= I_SQ;
        tr_item(in_wpp + (size_t)l * PLE * D, PLE, D, nullptr, (bf16*)(wl + W_PP), 0, scr, r, F.lane);
    }
    const int gt = F.vcu * (NWAVES * 64) + F.tid, NGT = F.G * NWAVES * 64;
    { float* cosT = (float*)(F.ws + WS_ROPE); float* sinT = cosT + SEQ * 128;
      for (int i = gt; i < SEQ * 128; i += NGT) { const int s = i >> 7, d = i & 127; const float inv = powf(10000.0f, -(float)d / 128.0f); const float ang = (float)s * inv; float sn, cs; sincosf(ang, &sn, &cs); cosT[i] = cs; sinT[i] = sn; } }
    { const float* p = in_p; bf16* pb = (bf16*)(F.ws + WS_PB);
      for (int i = gt; i < DEPTH * T * PLE / 8; i += NGT) { const f32x4 a = ((const GAS f32x4*)p)[2 * i], b = ((const GAS f32x4*)p)[2 * i + 1];
          v4u o; o.x = pk2(a.x, a.y); o.y = pk2(a.z, a.w); o.z = pk2(b.x, b.y); o.w = pk2(b.z, b.w); ((GAS v4u*)pb)[i] = o; } }
    { bf16* wr = (bf16*)(F.ws + WS_WR);
      for (int i = gt; i < DEPTH * 48 * D; i += NGT) { const int l = i / (48 * D), n = (i / D) % 48, k = i % D; float v = 0.f;
          if (n < 4) v = in_wrg[((size_t)l * D + k) * 4 + n]; else if (n < 36) v = in_wre[((size_t)l * D + k) * 32 + (n - 4)];
          v *= in_nffn[l * D + k];
          const unsigned hi = f2bf(v); const float lo = v - bf2f(hi);
          wr[((size_t)(l * 2 + 0) * 48 + n) * D + k] = (bf16)hi; wr[((size_t)(l * 2 + 1) * 48 + n) * D + k] = (bf16)f2bf(lo); } }
    { float* dt = (float*)(F.ws + WS_DT);
      for (int i = gt; i < DEPTH * 2 * 8 * 128; i += NGT) { const int j = i & 127, h = (i >> 7) & 7, dir = (i >> 10) & 1, l = i >> 11;
          const float x = dir == 0 ? in_decf[l * 8 + h] : in_decb[l * 8 + h]; const float lg = log_sigmoidf_(x);
          float* e = dt + (size_t)((l * 2 + dir) * 8 + h) * DT_STRIDE;
          if (j == 0) { e[0] = lg; e[1] = expf(128.0f * lg); }
          e[128 + j] = dir == 0 ? expf((float)(j + 1) * lg) : expf((float)(128 - j) * lg);
          e[256 + j] = dir == 0 ? expf((float)(127 - j) * lg) : expf((float)j * lg); } }
}

template <int MODE>
__device__ __forceinline__ void rowpass(Frame& F, const float* src, float* dst, const float* gfin) {
    const int gw = F.vcu * NWAVES + F.wave, NGW = F.G * NWAVES;
    bf16* hb = (bf16*)(F.ws + WS_HB); float* rs = (float*)(F.ws + WS_RS);
    const int* inv = (const int*)(F.ws + WS_INV); const bf16* yp = (const bf16*)(F.ws + WS_YP);
    for (int m = gw; m < T; m += NGW) {
        const GAS f32x4* xr = (const GAS f32x4*)(src + (size_t)m * D) + F.lane;
        f32x4 v[8]; float s = 0.f;
#pragma unroll
        for (int j = 0; j < 8; ++j) v[j] = xr[64 * j];
        if (MODE == 1) {
            const int p0 = inv[2 * m], p1 = inv[2 * m + 1];
            const GAS v2u* y0 = (const GAS v2u*)(yp + (size_t)p0 * D) + F.lane; const GAS v2u* y1 = (const GAS v2u*)(yp + (size_t)p1 * D) + F.lane;
#pragma unroll
            for (int j = 0; j < 8; ++j) { const v2u a = y0[64 * j], b = y1[64 * j];
                v[j].x += bflo(a.x) + bflo(b.x); v[j].y += bfhi(a.x) + bfhi(b.x); v[j].z += bflo(a.y) + bflo(b.y); v[j].w += bfhi(a.y) + bfhi(b.y); }
            GAS f32x4* xo = (GAS f32x4*)(dst + (size_t)m * D) + F.lane;
#pragma unroll
            for (int j = 0; j < 8; ++j) xo[64 * j] = v[j];
        }
#pragma unroll
        for (int j = 0; j < 8; ++j) s += (v[j].x * v[j].x + v[j].y * v[j].y) + (v[j].z * v[j].z + v[j].w * v[j].w);
        const float r = 1.0f / sqrtf(wave_sum(s) * (1.0f / D) + EPS);
        if (MODE == 2) {
            GAS f32x4* xo = (GAS f32x4*)(dst + (size_t)m * D) + F.lane; const GAS f32x4* gg = (const GAS f32x4*)gfin + F.lane;
#pragma unroll
            for (int j = 0; j < 8; ++j) { const f32x4 g = gg[64 * j]; xo[64 * j] = v[j] * r * g; }
        } else {
            GAS v2u* o8 = (GAS v2u*)(hb + (size_t)m * D) + F.lane;
#pragma unroll
            for (int j = 0; j < 8; ++j) { v2u o; o.x = pk2(v[j].x, v[j].y); o.y = pk2(v[j].z, v[j].w); o8[64 * j] = o; }
            if (F.lane == 0) rs[m] = r;
        }
    }
}

__device__ __forceinline__ void router_phase(Frame& F, const float* x, int layer) {
    const int gw = F.vcu * NWAVES + F.wave, NGW = F.G * NWAVES, fr = F.lane & 15, g = F.lane >> 4;
    const bf16* wr = (const bf16*)(F.ws + WS_WR) + (size_t)layer * 2 * 48 * D;
    const float* rs = (const float*)(F.ws + WS_RS); v4u* route = (v4u*)(F.ws + WS_ROUTE);
    LAS float* lg = (LAS float*)(F.lds + F.wave * 4096);
    for (int tile = gw; tile < T / 16; tile += NGW) {
        const int t0 = tile * 16;
        f32x4 acc[3]; acc[0] = acc[1] = acc[2] = (f32x4){0.f, 0.f, 0.f, 0.f};
        const float* xrow = x + (size_t)(t0 + fr) * D + 8 * g;
#pragma unroll 2
        for (int ks = 0; ks < 64; ++ks) {
            const f32x4 a = *(const GAS f32x4*)(xrow + 32 * ks), b = *(const GAS f32x4*)(xrow + 32 * ks + 4);
            v4u hi, lo; float l0, l1;
            hi.x = pk2(a.x, a.y); l0 = a.x - bflo(hi.x); l1 = a.y - bfhi(hi.x); lo.x = pk2(l0, l1);
            hi.y = pk2(a.z, a.w); l0 = a.z - bflo(hi.y); l1 = a.w - bfhi(hi.y); lo.y = pk2(l0, l1);
            hi.z = pk2(b.x, b.y); l0 = b.x - bflo(hi.z); l1 = b.y - bfhi(hi.z); lo.z = pk2(l0, l1);
            hi.w = pk2(b.z, b.w); l0 = b.z - bflo(hi.w); l1 = b.w - bfhi(hi.w); lo.w = pk2(l0, l1);
            const bf16x8 ah = __builtin_bit_cast(bf16x8, hi), al = __builtin_bit_cast(bf16x8, lo);
#pragma unroll
            for (int nt = 0; nt < 3; ++nt) {
                const bf16x8 bh = *(const GAS bf16x8*)(wr + (size_t)(16 * nt + fr) * D + 32 * ks + 8 * g);
                const bf16x8 bl = *(const GAS bf16x8*)(wr + (size_t)(48 + 16 * nt + fr) * D + 32 * ks + 8 * g);
                acc[nt] = __builtin_amdgcn_mfma_f32_16x16x32_bf16(ah, bh, acc[nt], 0, 0, 0);
                acc[nt] = __builtin_amdgcn_mfma_f32_16x16x32_bf16(al, bh, acc[nt], 0, 0, 0);
                acc[nt] = __builtin_amdgcn_mfma_f32_16x16x32_bf16(ah, bl, acc[nt], 0, 0, 0);
            }
        }
#pragma unroll
        for (int nt = 0; nt < 3; ++nt)
#pragma unroll
            for (int r = 0; r < 4; ++r) lg[(4 * g + r) * 52 + 16 * nt + fr] = acc[nt][r];
        LDS_WAIT(); asm volatile("" ::: "memory");
        if (F.lane < 16) {
            const int t = t0 + F.lane; const float rr = rs[t]; const LAS float* L = lg + F.lane * 52;
            float gl[4]; int gs = 0; float gm = -3.0e38f;
#pragma unroll
            for (int i = 0; i < 4; ++i) { gl[i] = L[i] * rr; if (gl[i] > gm) { gm = gl[i]; gs = i; } }
            float se = 0.f;
#pragma unroll
            for (int i = 0; i < 4; ++i) se += expf(gl[i] - gm);
            const float pg = 1.0f / se;
            float v0 = -3.0e38f, v1 = -3.0e38f; int i0 = 0, i1 = 0;
            for (int i = 0; i < 8; ++i) { const float v = L[4 + 8 * gs + i] * rr;
                if (v > v0) { v1 = v0; i1 = i0; v0 = v; i0 = i; } else if (v > v1) { v1 = v; i1 = i; } }
            const float e1 = expf(v1 - v0); const float w0 = pg / (1.0f + e1), w1 = pg * e1 / (1.0f + e1);
            v4u o; o.x = (unsigned)(gs * 8 + i0); o.y = (unsigned)(gs * 8 + i1); o.z = __builtin_bit_cast(unsigned, w0); o.w = __builtin_bit_cast(unsigned, w1);
            route[t] = o;
        }
        LDS_WAIT(); asm volatile("" ::: "memory");
    }
}

__device__ __forceinline__ void lists_phase(Frame& F) {
    const v4u* route = (const v4u*)(F.ws + WS_ROUTE);
    int* inv = (int*)(F.ws + WS_INV); int* ltok = (int*)(F.ws + WS_LTOK); float* lw = (float*)(F.ws + WS_LW); int* meta = (int*)(F.ws + WS_META);
    LAS int* hist = (LAS int*)F.lds;
    const int c = F.vcu; if (c >= 256) return;
    const int e = c >> 3, part = c & 7;
    if (F.tid < 64) hist[F.tid] = 0;
    __syncthreads();
    int own_before = 0;
    for (int t = F.tid; t < T; t += NWAVES * 64) { const v4u r = route[t];
        __hip_atomic_fetch_add(&hist[r.x], 1, __ATOMIC_RELAXED, __HIP_MEMORY_SCOPE_WORKGROUP); __hip_atomic_fetch_add(&hist[r.y], 1, __ATOMIC_RELAXED, __HIP_MEMORY_SCOPE_WORKGROUP);
        if (t < part * (T / 8)) own_before += ((int)r.x == e) + ((int)r.y == e); }
    own_before = (int)wave_sum((float)own_before);
    if (F.lane == 0) __hip_atomic_fetch_add(&hist[32], own_before, __ATOMIC_RELAXED, __HIP_MEMORY_SCOPE_WORKGROUP);
    __syncthreads();
    if (F.tid == 0) { int acc = 0; for (int i = 0; i < 32; ++i) { hist[64 + i] = acc; acc += (hist[i] + 255) >> 8; } hist[96] = acc; }
    __syncthreads();
    if (c == 0 && F.tid < 33) meta[F.tid] = hist[64 + F.tid];
    const int region = hist[64 + e] * 256; int base = hist[32];
    const int cnt_e = hist[e];
    for (int ch = 0; ch < (T / 8) / 512; ++ch) {
        const int t = part * (T / 8) + ch * 512 + F.tid; const v4u r = route[t];
        const int m0 = ((int)r.x == e), m1 = ((int)r.y == e);
        const int mt = m0 | m1;
        const unsigned long long bal = __ballot(mt);
        const int pre = __popcll(bal & ((1ull << F.lane) - 1ull)); const int wc = __popcll(bal);
        __syncthreads();
        if (F.lane == 0) hist[40 + F.wave] = wc;
        __syncthreads();
        int woff = 0, tot = 0;
#pragma unroll
        for (int w = 0; w < NWAVES; ++w) { const int cw = hist[40 + w]; if (w < F.wave) woff += cw; tot += cw; }
        if (mt) { const int pos = region + base + woff + pre; ltok[pos] = t; lw[pos] = __builtin_bit_cast(float, m0 ? r.z : r.w); inv[2 * t + (m0 ? 0 : 1)] = pos; }
        base += tot;
    }
    if (part == 7) { const int padend = ((cnt_e + 255) >> 8) * 256; for (int p = cnt_e + F.tid; p < padend; p += NWAVES * 64) { ltok[region + p] = 0; lw[region + p] = 0.f; } }
    __syncthreads();
}

__device__ __forceinline__ bf16x8 ld_frag16(const bf16* p) { return *(const GAS bf16x8*)p; }
__device__ __forceinline__ void na_unit(Frame& F, const bf16* Qn, const bf16* Kn, const bf16* VnT, bf16* out, const float* rpb, int u) {
    const int bl = u >> 11, h = (u >> 7) & 15, r = u & 127;
    const int qb = F.wave & 3, kh = F.wave >> 2, fr = F.lane & 15, g = F.lane >> 4;
    const int rs_row = min(max(r - 4, 0), 120);
    const int kc0 = qb == 0 ? 0 : (qb == 1 ? 8 : (qb == 2 ? 24 : 32));
    const int tq = bl * SEQ + r * 64 + 16 * qb + fr;
    LAS float* M = (LAS float*)F.lds;
    LAS float* OX = (LAS float*)(F.lds + 1024);
    bf16x8 qf[4];
#pragma unroll
    for (int ks = 0; ks < 4; ++ks) qf[ks] = ld_frag16(Qn + (size_t)tq * D + h * 128 + 32 * ks + 8 * g);
    f32x4 sc[4][2];
#pragma unroll
    for (int i = 0; i < 4; ++i)
#pragma unroll
        for (int kb = 0; kb < 2; ++kb) {
            const int tk = bl * SEQ + (rs_row + 4 * kh + i) * 64 + kc0 + 16 * kb + fr;
            f32x4 a = (f32x4){0.f, 0.f, 0.f, 0.f};
#pragma unroll
            for (int ks = 0; ks < 4; ++ks) { const bf16x8 kf = ld_frag16(Kn + (size_t)tk * D + h * 128 + 32 * ks + 8 * g); a = __builtin_amdgcn_mfma_f32_16x16x32_bf16(kf, qf[ks], a, 0, 0, 0); }
            sc[i][kb] = a;
        }
    const int qc = 16 * qb + fr, cs = min(max(qc - 8, 0), 48);
    float mx = -1e30f;
#pragma unroll
    for (int i = 0; i < 4; ++i) { const int dr = (rs_row + 4 * kh + i) - r + 7;
#pragma unroll
        for (int kb = 0; kb < 2; ++kb)
#pragma unroll
            for (int rg = 0; rg < 4; ++rg) { const int kcol = kc0 + 16 * kb + 4 * g + rg; const bool valid = (kcol >= cs) && (kcol < cs + 16);
                const int dc = min(max(kcol - qc, -15), 15) + 15; const float b = rpb[(h * 15 + dr) * 31 + dc];
                const float s = valid ? sc[i][kb][rg] + b : -1e30f; sc[i][kb][rg] = s; mx = fmaxf(mx, s); } }
    mx = fmaxf(mx, __shfl_xor(mx, 16)); mx = fmaxf(mx, __shfl_xor(mx, 32));
    if (g == 0) M[F.wave * 16 + fr] = mx;
    __syncthreads();
    const float m = fmaxf(mx, M[(F.wave ^ 4) * 16 + fr]);
    float ls = 0.f;
#pragma unroll
    for (int i = 0; i < 4; ++i)
#pragma unroll
        for (int kb = 0; kb < 2; ++kb)
#pragma unroll
            for (int rg = 0; rg < 4; ++rg) { const float p = __expf(sc[i][kb][rg] - m); sc[i][kb][rg] = p; ls += p; }
    ls += __shfl_xor(ls, 16); ls += __shfl_xor(ls, 32);
    f32x4 o[8];
#pragma unroll
    for (int dt = 0; dt < 8; ++dt) o[dt] = (f32x4){0.f, 0.f, 0.f, 0.f};
#pragma unroll
    for (int i = 0; i < 4; ++i) {
        v4u pw; pw.x = pk2(sc[i][0][0], sc[i][0][1]); pw.y = pk2(sc[i][0][2], sc[i][0][3]); pw.z = pk2(sc[i][1][0], sc[i][1][1]); pw.w = pk2(sc[i][1][2], sc[i][1][3]);
        const bf16x8 pf = __builtin_bit_cast(bf16x8, pw);
        const int s0 = (rs_row + 4 * kh + i) * 64 + kc0 + 4 * g;
#pragma unroll
        for (int dt = 0; dt < 8; ++dt) { const bf16* vp = VnT + ((size_t)((bl * 16 + h) * 128 + 16 * dt + fr)) * SEQ + s0;
            const v2u a = *(const GAS v2u*)vp, b = *(const GAS v2u*)(vp + 16); v4u vw; vw.x = a.x; vw.y = a.y; vw.z = b.x; vw.w = b.y;
            o[dt] = __builtin_amdgcn_mfma_f32_16x16x32_bf16(__builtin_bit_cast(bf16x8, vw), pf, o[dt], 0, 0, 0); }
    }
    if (kh == 1) {
#pragma unroll
        for (int dt = 0; dt < 8; ++dt)
#pragma unroll
            for (int rg = 0; rg < 4; ++rg) OX[((F.wave - 4) * 32 + dt * 4 + rg) * 64 + F.lane] = o[dt][rg];
        if (g == 0) M[128 + (F.wave - 4) * 16 + fr] = ls;
    }
    __syncthreads();
    if (kh == 0) {
        const float inv = 1.0f / (ls + M[128 + F.wave * 16 + fr]);
#pragma unroll
        for (int dt = 0; dt < 8; ++dt) { float v[4];
#pragma unroll
            for (int rg = 0; rg < 4; ++rg) v[rg] = (o[dt][rg] + OX[(F.wave * 32 + dt * 4 + rg) * 64 + F.lane]) * inv;
            v2u w; w.x = pk2(v[0], v[1]); w.y = pk2(v[2], v[3]);
            *(GAS v2u*)(out + (size_t)tq * D + h * 128 + 16 * dt + 4 * g) = w; }
    }
    __syncthreads();
}

__device__ __forceinline__ void rp_unit(Frame& F, const bf16* Qr, const bf16* Kr, bf16* Pf, bf16* Pb, const float* dtl  , int u) {
    const int bl = u >> 9, h = (u >> 6) & 7, c = u & 63, fr = F.lane & 15, g = F.lane >> 4;
    const int t0 = bl * SEQ + c * 128, il = 16 * F.wave + fr;
    const float lgf = dtl[(0 * 8 + h) * DT_STRIDE], lgb = dtl[(1 * 8 + h) * DT_STRIDE];
    bf16x8 qf[8];
#pragma unroll
    for (int ks = 0; ks < 8; ++ks) qf[ks] = ld_frag16(Qr + (size_t)(t0 + il) * D + h * 256 + 32 * ks + 8 * g);
#pragma unroll 2
    for (int jt = 0; jt < 8; ++jt) {
        f32x4 a = (f32x4){0.f, 0.f, 0.f, 0.f};
#pragma unroll
        for (int ks = 0; ks < 8; ++ks) { const bf16x8 kf = ld_frag16(Kr + (size_t)(t0 + 16 * jt + fr) * D + h * 256 + 32 * ks + 8 * g); a = __builtin_amdgcn_mfma_f32_16x16x32_bf16(kf, qf[ks], a, 0, 0, 0); }
        float pf[4], pb[4];
#pragma unroll
        for (int rg = 0; rg < 4; ++rg) { const int j = 16 * jt + 4 * g + rg, diff = il - j;
            pf[rg] = diff >= 0 ? a[rg] * __expf((float)diff * lgf) : 0.f; pb[rg] = diff < 0 ? a[rg] * __expf((float)(-diff) * lgb) : 0.f; }
        v2u w; w.x = pk2(pf[0], pf[1]); w.y = pk2(pf[2], pf[3]); *(GAS v2u*)(Pf + ((size_t)u * 128 + il) * 128 + 16 * jt + 4 * g) = w;
        w.x = pk2(pb[0], pb[1]); w.y = pk2(pb[2], pb[3]); *(GAS v2u*)(Pb + ((size_t)u * 128 + il) * 128 + 16 * jt + 4 * g) = w;
    }
}

__device__ __forceinline__ void rs_job(Frame& F, const bf16* Qr, const bf16* KzT, const bf16* VrT, const bf16* P, bf16* O, const float* dte  , int bl, int h, int dir, int vs) {
    const int fr = F.lane & 15, g = F.lane >> 4, il = 16 * F.wave + fr;
    LAS bf16* Sbf = (LAS bf16*)F.lds;
    LAS bf16* VT = (LAS bf16*)(F.lds + 34816);
    const float gC = dte[1]; const float xi = dte[128 + il];
    f32x4 accS[4][2];
#pragma unroll
    for (int vt = 0; vt < 4; ++vt)
#pragma unroll
        for (int dd = 0; dd < 2; ++dd) accS[vt][dd] = (f32x4){0.f, 0.f, 0.f, 0.f};
    for (int i = F.tid; i < 64 * 264 / 2; i += NWAVES * 64) ((LAS unsigned*)Sbf)[i] = 0u;
    const int vrow = F.tid >> 3, vj0 = (F.tid & 7) * 16;
    const bf16* vsrc = VrT + ((size_t)((bl * 8 + h) * 256 + vs * 64 + vrow)) * SEQ + vj0;
    const int c0 = dir == 0 ? 0 : 63;
    v4u vr0 = *(const GAS v4u*)(vsrc + c0 * 128), vr1 = *(const GAS v4u*)(vsrc + c0 * 128 + 8);
    for (int step = 0; step < 64; ++step) {
        const int c = dir == 0 ? step : 63 - step; const int t0 = bl * SEQ + c * 128; const int unit = (bl * 8 + h) * 64 + c;
        *(LAS v4u*)(VT + vrow * 136 + vj0) = vr0; *(LAS v4u*)(VT + vrow * 136 + vj0 + 8) = vr1;
        __syncthreads();
        if (step < 63) { const int cn = dir == 0 ? c + 1 : c - 1; vr0 = *(const GAS v4u*)(vsrc + cn * 128); vr1 = *(const GAS v4u*)(vsrc + cn * 128 + 8); }
        bf16x8 qf[8];
#pragma unroll
        for (int ks = 0; ks < 8; ++ks) qf[ks] = ld_frag16(Qr + (size_t)(t0 + il) * D + h * 256 + 32 * ks + 8 * g);
        bf16x8 pf[4];
#pragma unroll
        for (int ks = 0; ks < 4; ++ks) pf[ks] = ld_frag16(P + ((size_t)unit * 128 + il) * 128 + 32 * ks + 8 * g);
        bf16x8 kz[2][4];
#pragma unroll
        for (int dd = 0; dd < 2; ++dd)
#pragma unroll
            for (int ks = 0; ks < 4; ++ks) kz[dd][ks] = ld_frag16(KzT + ((size_t)((bl * 8 + h) * 256 + 16 * (2 * F.wave + dd) + fr)) * SEQ + c * 128 + 32 * ks + 8 * g);
        f32x4 accO[4];
#pragma unroll
        for (int vt = 0; vt < 4; ++vt) { f32x4 a = (f32x4){0.f, 0.f, 0.f, 0.f};
#pragma unroll
            for (int ks = 0; ks < 8; ++ks) { const bf16x8 sf = *(const LAS bf16x8*)(Sbf + (16 * vt + fr) * 264 + 32 * ks + 8 * g); a = __builtin_amdgcn_mfma_f32_16x16x32_bf16(sf, qf[ks], a, 0, 0, 0); }
            accO[vt] = a * xi; }
#pragma unroll
        for (int vt = 0; vt < 4; ++vt)
#pragma unroll
            for (int dd = 0; dd < 2; ++dd) accS[vt][dd] = accS[vt][dd] * gC;
#pragma unroll
        for (int ks = 0; ks < 4; ++ks)
#pragma unroll
            for (int vt = 0; vt < 4; ++vt) { const bf16x8 vf = *(const LAS bf16x8*)(VT + (16 * vt + fr) * 136 + 32 * ks + 8 * g);
                accO[vt] = __builtin_amdgcn_mfma_f32_16x16x32_bf16(vf, pf[ks], accO[vt], 0, 0, 0);
                accS[vt][0] = __builtin_amdgcn_mfma_f32_16x16x32_bf16(vf, kz[0][ks], accS[vt][0], 0, 0, 0);
                accS[vt][1] = __builtin_amdgcn_mfma_f32_16x16x32_bf16(vf, kz[1][ks], accS[vt][1], 0, 0, 0); }
#pragma unroll
        for (int vt = 0; vt < 4; ++vt) { v2u w; w.x = pk2(accO[vt][0], accO[vt][1]); w.y = pk2(accO[vt][2], accO[vt][3]);
            *(GAS v2u*)(O + (size_t)(t0 + il) * D + h * 256 + vs * 64 + 16 * vt + 4 * g) = w; }
        __syncthreads();
#pragma unroll
        for (int vt = 0; vt < 4; ++vt)
#pragma unroll
            for (int dd = 0; dd < 2; ++dd)
#pragma unroll
                for (int rg = 0; rg < 4; ++rg) Sbf[(16 * vt + 4 * g + rg) * 264 + 16 * (2 * F.wave + dd) + fr] = (bf16)f2bf(accS[vt][dd][rg]);
    }
    __syncthreads();
}

__device__ __forceinline__ void rn_phase(Frame& F, bf16* Of, const bf16* Ob, const float* gn) {
    const int gw = F.vcu * NWAVES + F.wave, NGW = F.G * NWAVES;
    for (int m = gw; m < HT; m += NGW) {
#pragma unroll
        for (int j = 0; j < 4; ++j) {
            const int col = j * 512 + F.lane * 8;
            const v4u a = *(const GAS v4u*)(Of + (size_t)m * D + col), b = *(const GAS v4u*)(Ob + (size_t)m * D + col);
            float x[8]; x[0] = bflo(a.x) + bflo(b.x); x[1] = bfhi(a.x) + bfhi(b.x); x[2] = bflo(a.y) + bflo(b.y); x[3] = bfhi(a.y) + bfhi(b.y);
            x[4] = bflo(a.z) + bflo(b.z); x[5] = bfhi(a.z) + bfhi(b.z); x[6] = bflo(a.w) + bflo(b.w); x[7] = bfhi(a.w) + bfhi(b.w);
            float s = 0.f;
#pragma unroll
            for (int i = 0; i < 8; ++i) s += x[i];
#pragma unroll
            for (int o = 1; o < 32; o <<= 1) s += __shfl_xor(s, o);
            const float mu = s * (1.0f / 256.0f); float q = 0.f;
#pragma unroll
            for (int i = 0; i < 8; ++i) { x[i] -= mu; q += x[i] * x[i]; }
#pragma unroll
            for (int o = 1; o < 32; o <<= 1) q += __shfl_xor(q, o);
            const float rstd = 1.0f / sqrtf(q * (1.0f / 256.0f) + EPS);
            const f32x4 g0 = *(const GAS f32x4*)(gn + col), g1 = *(const GAS f32x4*)(gn + col + 4);
            v4u o; o.x = pk2(x[0] * rstd * g0.x, x[1] * rstd * g0.y); o.y = pk2(x[2] * rstd * g0.z, x[3] * rstd * g0.w);
            o.z = pk2(x[4] * rstd * g1.x, x[5] * rstd * g1.y); o.w = pk2(x[6] * rstd * g1.z, x[7] * rstd * g1.w);
            *(GAS v4u*)(Of + (size_t)m * D + col) = o;
        }
    }
}
struct LinSched {
    pg8::DenseOrder o; unsigned row0; const char* Bt; size_t tstep;
    __device__ __forceinline__ void init(int M, int N, int K, int G, int c, unsigned row0_, const bf16* Bt_) { o.init(M, N, G, c); row0 = row0_; Bt = (const char*)Bt_; tstep = (size_t)256 * K * 2; }
    __device__ __forceinline__ bool next(int i, pg8::Unit& u) const { u.e = 0; return o.next_mn(i, u.pm, u.pn); }
    static constexpr bool GATHER = false;
    __device__ __forceinline__ unsigned a_row(const pg8::Unit& u, int r) const { return 0u; }
    __device__ __forceinline__ size_t a_off(const pg8::Unit& u, unsigned rowb) const { return (size_t)(row0 + (unsigned)u.pm * 256u) * rowb; }
    __device__ __forceinline__ const char* b_base(const pg8::Unit& u) const { return Bt + (size_t)u.pn * tstep; }
};
template <bool GATHER_>
struct MoeSched {
    const volatile LAS int* ts; int ncol, G, c; const int* ltok; const char* Bt; size_t estep, tstep;
    __device__ __forceinline__ bool next(int i, pg8::Unit& u) const {
        const int L = i * G + c; const int total = ts[32] * ncol; if (L >= total) return false;
        const int tile = L / ncol; u.pm = tile; u.pn = L % ncol; int e = 0;
#pragma unroll 1
        for (int k = 1; k < 32; ++k) if (ts[k] <= tile) e = k;
        u.e = e; return true;
    }
    static constexpr bool GATHER = GATHER_;
    __device__ __forceinline__ unsigned a_row(const pg8::Unit& u, int r) const { return (unsigned)ltok[u.pm * 256 + r]; }
    __device__ __forceinline__ size_t a_off(const pg8::Unit& u, unsigned rowb) const { return GATHER_ ? (size_t)0 : (size_t)((unsigned)u.pm * 256u) * rowb; }
    __device__ __forceinline__ const char* b_base(const pg8::Unit& u) const { return Bt + (size_t)u.e * estep + (size_t)u.pn * tstep; }
};

using pg8::Unit; using pg8::cvt_pk_bf16;
typedef const f32x4 (&AccRef)[2][2][4][2];

struct EpiProj {
    static constexpr bool PERM = true;
    unsigned char* ws; const float* rs; const float* dtl;
    __device__ __forceinline__ void operator()(AccRef acc, const Unit& u, int wr, int wc, int fr, int fq) const {
        const int type = u.pn >> 3, hh = u.pn & 7, c0 = wc * 32 + 8 * fq;
        bf16 *Qn = (bf16*)(ws + WS_QN), *Kn = (bf16*)(ws + WS_KN), *VnT = (bf16*)(ws + WS_VNT), *Qr = (bf16*)(ws + WS_QR), *Kr = (bf16*)(ws + WS_KR), *KzTf = (bf16*)(ws + WS_KZF), *KzTb = (bf16*)(ws + WS_KZB), *VrT = (bf16*)(ws + WS_VRT);
        const float* cosT = (const float*)(ws + WS_ROPE); const float* sinT = cosT + SEQ * 128;
#pragma unroll
        for (int ai = 0; ai < 2; ++ai)
#pragma unroll
            for (int m = 0; m < 4; ++m) {
                const int r = u.pm * 256 + ai * 128 + wr * 64 + m * 16 + fr; const float rv = rs[r]; const int bl = r >> 13, s = r & (SEQ - 1);
                if (type <= 1) { bf16* dst = (type == 0 ? Qn : Kn) + (size_t)r * D + hh * 256 + c0;
#pragma unroll
                    for (int bj = 0; bj < 2; ++bj) { const f32x4 v0 = acc[ai][bj][m][0] * rv, v1 = acc[ai][bj][m][1] * rv; v4u w; w.x = cvt_pk_bf16(v0[0], v0[1]); w.y = cvt_pk_bf16(v0[2], v0[3]); w.z = cvt_pk_bf16(v1[0], v1[1]); w.w = cvt_pk_bf16(v1[2], v1[3]);
                        *(GAS v4u*)(dst + bj * 128) = w; }
                } else if (type == 2) {
#pragma unroll
                    for (int bj = 0; bj < 2; ++bj) { bf16* dst = VnT + ((size_t)((bl * 16 + hh * 2 + bj) * 128 + c0)) * SEQ + s;
#pragma unroll
                        for (int n = 0; n < 2; ++n)
#pragma unroll
                            for (int e = 0; e < 4; ++e) dst[(size_t)(4 * n + e) * SEQ] = (bf16)f2bf(acc[ai][bj][m][n][e] * rv); }
                } else if (type == 5) {
#pragma unroll
                    for (int bj = 0; bj < 2; ++bj) { bf16* dst = VrT + ((size_t)((bl * 8 + hh) * 256 + bj * 128 + c0)) * SEQ + s;
#pragma unroll
                        for (int n = 0; n < 2; ++n)
#pragma unroll
                            for (int e = 0; e < 4; ++e) dst[(size_t)(4 * n + e) * SEQ] = (bf16)f2bf(acc[ai][bj][m][n][e] * rv); }
                } else {
                    float o1[8], o2[8];
#pragma unroll
                    for (int n = 0; n < 2; ++n) { const f32x4 cs = *(const GAS f32x4*)(cosT + (size_t)s * 128 + c0 + 4 * n), sn = *(const GAS f32x4*)(sinT + (size_t)s * 128 + c0 + 4 * n);
#pragma unroll
                        for (int e = 0; e < 4; ++e) { const float x1 = acc[ai][0][m][n][e] * rv, x2 = acc[ai][1][m][n][e] * rv; o1[4 * n + e] = x1 * cs[e] - x2 * sn[e]; o2[4 * n + e] = x1 * sn[e] + x2 * cs[e]; } }
                    bf16* dst = (type == 3 ? Qr : Kr) + (size_t)r * D + hh * 256 + c0;
                    v4u w; w.x = cvt_pk_bf16(o1[0], o1[1]); w.y = cvt_pk_bf16(o1[2], o1[3]); w.z = cvt_pk_bf16(o1[4], o1[5]); w.w = cvt_pk_bf16(o1[6], o1[7]); *(GAS v4u*)dst = w;
                    w.x = cvt_pk_bf16(o2[0], o2[1]); w.y = cvt_pk_bf16(o2[2], o2[3]); w.z = cvt_pk_bf16(o2[4], o2[5]); w.w = cvt_pk_bf16(o2[6], o2[7]); *(GAS v4u*)(dst + 128) = w;
                    if (type == 4) {
                        const float zf = dtl[(0 * 8 + hh) * DT_STRIDE + 256 + (s & 127)], zb = dtl[(1 * 8 + hh) * DT_STRIDE + 256 + (s & 127)];
                        bf16* df = KzTf + ((size_t)((bl * 8 + hh) * 256 + c0)) * SEQ + s; bf16* db = KzTb + ((size_t)((bl * 8 + hh) * 256 + c0)) * SEQ + s;
#pragma unroll
                        for (int e = 0; e < 8; ++e) { df[(size_t)e * SEQ] = (bf16)f2bf(o1[e] * zf); df[(size_t)(128 + e) * SEQ] = (bf16)f2bf(o2[e] * zf);
                            db[(size_t)e * SEQ] = (bf16)f2bf(o1[e] * zb); db[(size_t)(128 + e) * SEQ] = (bf16)f2bf(o2[e] * zb); }
                    }
                }
            }
    }
};
struct EpiGate1 {
    static constexpr bool PERM = true;
    bf16* retn; const bf16* na; bf16* mix; const float* rs;
    __device__ __forceinline__ void operator()(AccRef acc, const Unit& u, int wr, int wc, int fr, int fq) const {
        const bool isg = u.pn < 8; const int cg = (u.pn & 7) * 256 + wc * 32 + 8 * fq;
#pragma unroll
        for (int ai = 0; ai < 2; ++ai)
#pragma unroll
            for (int m = 0; m < 4; ++m) { const int r = u.pm * 256 + ai * 128 + wr * 64 + m * 16 + fr; const float rv = rs[r];
#pragma unroll
                for (int bj = 0; bj < 2; ++bj) { const size_t off = (size_t)r * D + cg + bj * 128;
                    const v4u in = *(const GAS v4u*)((isg ? retn : na) + off);
                    const f32x4 v0 = acc[ai][bj][m][0] * rv, v1 = acc[ai][bj][m][1] * rv; float o[8];
                    const float x[8] = {bflo(in.x), bfhi(in.x), bflo(in.y), bfhi(in.y), bflo(in.z), bfhi(in.z), bflo(in.w), bfhi(in.w)};
#pragma unroll
                    for (int e = 0; e < 4; ++e) { const float s0 = sigmoidf_(v0[e]), s1 = sigmoidf_(v1[e]); o[e] = x[e] * (isg ? v0[e] * s0 : s0); o[4 + e] = x[4 + e] * (isg ? v1[e] * s1 : s1); }
                    v4u w; w.x = cvt_pk_bf16(o[0], o[1]); w.y = cvt_pk_bf16(o[2], o[3]); w.z = cvt_pk_bf16(o[4], o[5]); w.w = cvt_pk_bf16(o[6], o[7]);
                    *(GAS v4u*)((isg ? retn : mix) + off) = w; }
                asm volatile("" ::: "memory"); }
    }
};
struct EpiGate2 {
    static constexpr bool PERM = true;
    const bf16* t2; bf16* mix; const float* rs;
    __device__ __forceinline__ void operator()(AccRef acc, const Unit& u, int wr, int wc, int fr, int fq) const {
        const int cg = u.pn * 256 + wc * 32 + 8 * fq;
#pragma unroll
        for (int ai = 0; ai < 2; ++ai)
#pragma unroll
            for (int m = 0; m < 4; ++m) { const int r = u.pm * 256 + ai * 128 + wr * 64 + m * 16 + fr; const float rv = rs[r];
#pragma unroll
                for (int bj = 0; bj < 2; ++bj) { const size_t off = (size_t)r * D + cg + bj * 128;
                    const v4u a = *(const GAS v4u*)(t2 + off), b = *(const GAS v4u*)(mix + off);
                    const f32x4 v0 = acc[ai][bj][m][0] * rv, v1 = acc[ai][bj][m][1] * rv; float o[8];
                    const float x[8] = {bflo(a.x), bfhi(a.x), bflo(a.y), bfhi(a.y), bflo(a.z), bfhi(a.z), bflo(a.w), bfhi(a.w)};
                    const float y[8] = {bflo(b.x), bfhi(b.x), bflo(b.y), bfhi(b.y), bflo(b.z), bfhi(b.z), bflo(b.w), bfhi(b.w)};
#pragma unroll
                    for (int e = 0; e < 4; ++e) { o[e] = y[e] + x[e] * sigmoidf_(v0[e]); o[4 + e] = y[4 + e] + x[4 + e] * sigmoidf_(v1[e]); }
                    v4u w; w.x = cvt_pk_bf16(o[0], o[1]); w.y = cvt_pk_bf16(o[2], o[3]); w.z = cvt_pk_bf16(o[4], o[5]); w.w = cvt_pk_bf16(o[6], o[7]);
                    *(GAS v4u*)(mix + off) = w; }
                asm volatile("" ::: "memory"); }
    }
};
struct EpiRes {
    static constexpr bool PERM = false;
    const float* src; float* dst; int row0;
    __device__ __forceinline__ void operator()(AccRef acc, const Unit& u, int wr, int wc, int fr, int fq) const {
        const int col0 = u.pn * 256 + wc * 32 + 4 * fq;
#pragma unroll
        for (int ai = 0; ai < 2; ++ai)
#pragma unroll
            for (int m = 0; m < 4; ++m) { const size_t off = (size_t)(row0 + u.pm * 256 + ai * 128 + wr * 64 + m * 16 + fr) * D + col0;
#pragma unroll
                for (int bj = 0; bj < 2; ++bj)
#pragma unroll
                    for (int n = 0; n < 2; ++n) { const f32x4 b = *(const GAS f32x4*)(src + off + bj * 128 + n * 16); *(GAS f32x4*)(dst + off + bj * 128 + n * 16) = b + acc[ai][bj][m][n]; }
                asm volatile("" ::: "memory"); }
    }
};
struct EpiPle {
    static constexpr bool PERM = false;
    float* x; const bf16* pp; const float* rs;
    __device__ __forceinline__ void operator()(AccRef acc, const Unit& u, int wr, int wc, int fr, int fq) const {
        const int col0 = u.pn * 256 + wc * 32 + 4 * fq;
#pragma unroll
        for (int ai = 0; ai < 2; ++ai)
#pragma unroll
            for (int m = 0; m < 4; ++m) { const int r = u.pm * 256 + ai * 128 + wr * 64 + m * 16 + fr; const float rv = rs[r]; const size_t off = (size_t)r * D + col0;
#pragma unroll
                for (int bj = 0; bj < 2; ++bj)
#pragma unroll
                    for (int n = 0; n < 2; ++n) { const size_t o2 = off + bj * 128 + n * 16; const f32x4 b = *(const GAS f32x4*)(x + o2); const v2u p = *(const GAS v2u*)(pp + o2); const f32x4 a = acc[ai][bj][m][n] * rv;
                        f32x4 o; o.x = b.x + sigmoidf_(a.x) * bflo(p.x); o.y = b.y + sigmoidf_(a.y) * bfhi(p.x); o.z = b.z + sigmoidf_(a.z) * bflo(p.y); o.w = b.w + sigmoidf_(a.w) * bfhi(p.y);
                        *(GAS f32x4*)(x + o2) = o; }
                asm volatile("" ::: "memory"); }
    }
};
struct EpiBf {
    static constexpr bool PERM = true;
    bf16* O; int ldc; const float* rowscale;
    __device__ __forceinline__ void operator()(AccRef acc, const Unit& u, int wr, int wc, int fr, int fq) const {
        const int col0 = u.pn * 256 + wc * 32 + 8 * fq;
#pragma unroll
        for (int ai = 0; ai < 2; ++ai)
#pragma unroll
            for (int m = 0; m < 4; ++m) { const int r = u.pm * 256 + ai * 128 + wr * 64 + m * 16 + fr; const float rv = rowscale ? rowscale[r] : 1.0f;
#pragma unroll
                for (int bj = 0; bj < 2; ++bj) { const f32x4 v0 = acc[ai][bj][m][0] * rv, v1 = acc[ai][bj][m][1] * rv; v4u w; w.x = cvt_pk_bf16(v0[0], v0[1]); w.y = cvt_pk_bf16(v0[2], v0[3]); w.z = cvt_pk_bf16(v1[0], v1[1]); w.w = cvt_pk_bf16(v1[2], v1[3]);
                    *(GAS v4u*)(O + (size_t)r * ldc + col0 + bj * 128) = w; } }
    }
};
struct EpiGU {
    static constexpr bool PERM = true;
    bf16* act; const float* rs; const int* ltok;
    __device__ __forceinline__ void operator()(AccRef acc, const Unit& u, int wr, int wc, int fr, int fq) const {
        const int col0 = u.pn * 128 + wc * 16 + 4 * fq;
#pragma unroll
        for (int ai = 0; ai < 2; ++ai)
#pragma unroll
            for (int m = 0; m < 4; ++m) { const int r = u.pm * 256 + ai * 128 + wr * 64 + m * 16 + fr; const float rv = rs[ltok[r]];
#pragma unroll
                for (int bj = 0; bj < 2; ++bj) { const f32x4 gt = acc[ai][bj][m][0] * rv, up = acc[ai][bj][m][1] * rv;
                    v2u w; w.x = cvt_pk_bf16(siluf_(gt[0]) * up[0], siluf_(gt[1]) * up[1]); w.y = cvt_pk_bf16(siluf_(gt[2]) * up[2], siluf_(gt[3]) * up[3]);
                    *(GAS v2u*)(act + (size_t)r * DFF + col0 + bj * 64) = w; } }
    }
};

#define Qn ((bf16*)(F.ws + WS_QN))
#define Kn ((bf16*)(F.ws + WS_KN))
#define VnT ((bf16*)(F.ws + WS_VNT))
#define Qr ((bf16*)(F.ws + WS_QR))
#define Kr ((bf16*)(F.ws + WS_KR))
#define KzTf ((bf16*)(F.ws + WS_KZF))
#define KzTb ((bf16*)(F.ws + WS_KZB))
#define VrT ((bf16*)(F.ws + WS_VRT))
#define Pf ((bf16*)(F.ws + WS_PF))
#define Pb ((bf16*)(F.ws + WS_PBW))
#define mix ((bf16*)(F.ws + WS_MIX))
#define Of ((bf16*)(F.ws + WS_OF))
#define Ob ((bf16*)(F.ws + WS_OB))
#define hb ((bf16*)(F.ws + WS_HB))
#define rs ((float*)(F.ws + WS_RS))
struct Args { const float* in[19]; float* out; unsigned char* ws; int ph_lo, ph_hi; };
enum { PH_PRO = 0, PH_L0 = 1, PH_PER_HALF = 7, PH_PER_LAYER = 2 * PH_PER_HALF + 9, PH_FINAL = PH_L0 + DEPTH * PH_PER_LAYER, PH_COUNT = PH_FINAL + 1 };

template <int ONLYC>
__global__ void __launch_bounds__(NWAVES * 64, 2) fwd_kernel(Args args) {
    extern __shared__ __attribute__((aligned(16))) unsigned char lds_raw[];
    Frame F;
    F.lds = (LAS unsigned char*)lds_raw;
    F.MISC = (volatile LAS unsigned*)(F.lds + MISC_OFF);
    F.tid = threadIdx.x; F.lane = F.tid & 63; F.wave = __builtin_amdgcn_readfirstlane(F.tid >> 6);
    F.G = gridDim.x; int vcu0; { const int bx = blockIdx.x; vcu0 = (F.G % 8 == 0) ? (bx % 8) * (F.G / 8) + bx / 8 : bx; } F.vcu = vcu0;
    F.ws = args.ws; F.out = args.out;
    if (F.tid < 64) F.MISC[F.tid] = 0u;
    __syncthreads();
    unsigned* ctl = (unsigned*)(F.ws + WS_CTL);
    const int lo = args.ph_lo, hi = args.ph_hi;
    XcdBarrier bar; bar.bar = ctl + CW_BAR; bar.x = 0; bar.st = nullptr;
    if (hi - lo > 1) bar = xcd_barrier_post(ctl + CW_BAR, F.MISC);
#ifndef EXCL
#define EXCL 0
#endif
#define EN(cls) (ONLYC < 0 ? !((EXCL >> (cls)) & 1) : ONLYC == (cls))
#define IN(k) (lo <= (k) && (k) < hi)
#define FRESH() do { int t_ = threadIdx.x; asm volatile("" : "+v"(t_)); F.tid = t_; F.lane = t_ & 63; unsigned char* w_ = args.ws; asm volatile("" : "+s"(w_)); F.ws = w_; int v_ = vcu0; asm volatile("" : "+s"(v_)); F.vcu = v_; F.wave = __builtin_amdgcn_readfirstlane(t_ >> 6); } while (0)
#define SEAM(k) do { if (IN((k) + 1)) xcd_barrier(bar); } while (0)

    float* xres = F.out;

    if (EN(0) && IN(PH_PRO)) { FRESH(); p0_prologue(F, args.in[1], args.in[2], args.in[3], args.in[5], args.in[6], args.in[8], args.in[9], args.in[10], args.in[11], args.in[12], args.in[13], args.in[14], args.in[15], args.in[16], args.in[17]); SEAM(PH_PRO); }

    for (int layer = 0; layer < DEPTH; ++layer) {
        const int pb0 = PH_L0 + layer * PH_PER_LAYER;
        unsigned char* wl = F.ws + WS_W + (size_t)layer * W_LAYER;
        const float* dtl = (const float*)(F.ws + WS_DT) + (size_t)layer * 16 * DT_STRIDE;
        const float* xsrc = layer == 0 ? args.in[0] : xres;
        if (EN(1) && IN(pb0)) { FRESH(); rowpass<0>(F, xsrc, nullptr, nullptr); SEAM(pb0); }
        for (int half = 0; half < 2; ++half) {
            const int ph = pb0 + 1 + half * PH_PER_HALF;
            const unsigned row0 = (unsigned)half * HT;
            if (EN(2) && IN(ph + 0)) { FRESH();
                LinSched S; S.init(HT, NPROJ, D, F.G, (int)blockIdx.x, row0, (const bf16*)(wl + W_IN));
                EpiProj E{F.ws, rs + row0, dtl};
                pg8::gemm_phase<EpiProj, LinSched>(F.lds, hb, D, S, E);
                SEAM(ph + 0);
            }
            if (EN(3) && IN(ph + 1)) { FRESH();
                const float* rpb = args.in[4] + (size_t)layer * 16 * 15 * 31;
                for (int k = 0; k < 16; ++k) na_unit(F, Qn, Kn, VnT, Qn, rpb, F.vcu * 16 + k);
                for (int k = 0; k < 4; ++k) rp_unit(F, Qr, Kr, Pf, Pb, dtl, F.vcu * 4 + k);
                SEAM(ph + 1);
            }
            if (EN(4) && IN(ph + 2)) { FRESH();
                if ((F.vcu & 1) == 0) { const int job = F.vcu >> 1; const int vs = job & 3, dir = (job >> 2) & 1, h = (job >> 3) & 7, bl = job >> 6;
                    rs_job(F, Qr, dir == 0 ? KzTf : KzTb, VrT, dir == 0 ? Pf : Pb, dir == 0 ? Of : Ob, dtl + (size_t)(dir * 8 + h) * DT_STRIDE, bl, h, dir, vs); }
                SEAM(ph + 2);
            }
            if (EN(5) && IN(ph + 3)) { FRESH(); rn_phase(F, Of, Ob, args.in[7] + (size_t)layer * D); SEAM(ph + 3); }
            if (EN(6) && IN(ph + 4)) { FRESH();
                LinSched S; S.init(HT, 4096, D, F.G, (int)blockIdx.x, row0, (const bf16*)(wl + W_IN) + (size_t)NPROJ * D);
                EpiGate1 E{Of, Qn, mix, rs + row0};
                pg8::gemm_phase<EpiGate1, LinSched>(F.lds, hb, D, S, E);
                SEAM(ph + 4);
            }
            if (EN(7) && IN(ph + 5)) { FRESH();
                LinSched S; S.init(HT, 2048, D, F.G, (int)blockIdx.x, row0, (const bf16*)(wl + W_IN) + (size_t)(NPROJ + 4096) * D);
                EpiGate2 E{Of, mix, rs + row0};
                pg8::gemm_phase<EpiGate2, LinSched>(F.lds, hb, D, S, E);
                SEAM(ph + 5);
            }
            if (EN(8) && IN(ph + 6)) { FRESH();
                LinSched S; S.init(HT, D, D, F.G, (int)blockIdx.x, 0u, (const bf16*)(wl + W_OUT));
                EpiRes E{xsrc, xres, (int)row0};
                pg8::gemm_phase<EpiRes, LinSched>(F.lds, mix, D, S, E);
                SEAM(ph + 6);
            }
        }
        const int pm0 = pb0 + 1 + 2 * PH_PER_HALF;
        if (EN(1) && IN(pm0 + 0)) { FRESH(); rowpass<0>(F, xres, nullptr, nullptr); SEAM(pm0 + 0); }
        if (EN(9) && IN(pm0 + 1)) { FRESH(); router_phase(F, xres, layer); SEAM(pm0 + 1); }
        if (EN(10) && IN(pm0 + 2)) { FRESH(); lists_phase(F); SEAM(pm0 + 2); }
        if (IN(pm0 + 3) || IN(pm0 + 4)) {
            FRESH();
            const int* meta = (const int*)(F.ws + WS_META);
            if (F.tid < 33) F.MISC[16 + F.tid] = (unsigned)__hip_atomic_load(meta + F.tid, __ATOMIC_RELAXED, __HIP_MEMORY_SCOPE_AGENT);
            __syncthreads();
        }
        if (EN(11) && IN(pm0 + 3)) { FRESH();
            MoeSched<true> S{(const volatile LAS int*)(F.MISC + 16), 4, F.G, (int)blockIdx.x, (const int*)(F.ws + WS_LTOK), (const char*)(wl + W_GU), (size_t)1024 * D * 2, (size_t)256 * D * 2};
            EpiGU E{(bf16*)(F.ws + WS_ACT), rs, (const int*)(F.ws + WS_LTOK)};
            pg8::gemm_phase<EpiGU, MoeSched<true>>(F.lds, hb, D, S, E);
            SEAM(pm0 + 3);
        }
        if (EN(12) && IN(pm0 + 4)) { FRESH();
            MoeSched<false> S{(const volatile LAS int*)(F.MISC + 16), 8, F.G, (int)blockIdx.x, nullptr, (const char*)(wl + W_DN), (size_t)D * DFF * 2, (size_t)256 * DFF * 2};
            EpiBf E{(bf16*)(F.ws + WS_YP), D, (const float*)(F.ws + WS_LW)};
            pg8::gemm_phase<EpiBf, MoeSched<false>>(F.lds, (const bf16*)(F.ws + WS_ACT), DFF, S, E);
            SEAM(pm0 + 4);
        }
        if (EN(13) && IN(pm0 + 5)) { FRESH(); rowpass<1>(F, xres, xres, nullptr); SEAM(pm0 + 5); }
        if (EN(14) && IN(pm0 + 6)) { FRESH();
            LinSched S; S.init(T, D, PLE, F.G, (int)blockIdx.x, 0u, (const bf16*)(wl + W_PP));
            EpiBf E{(bf16*)(F.ws + WS_PP), D, nullptr};
            pg8::gemm_phase<EpiBf, LinSched>(F.lds, (const bf16*)(F.ws + WS_PB) + (size_t)layer * T * PLE, PLE, S, E);
            SEAM(pm0 + 6);
        }
        if (EN(15) && IN(pm0 + 7)) { FRESH();
            LinSched S; S.init(T, D, D, F.G, (int)blockIdx.x, 0u, (const bf16*)(wl + W_PG));
            EpiPle E{xres, (const bf16*)(F.ws + WS_PP), rs};
            pg8::gemm_phase<EpiPle, LinSched>(F.lds, hb, D, S, E);
            SEAM(pm0 + 7);
        }
    }
    if (EN(16) && IN(PH_FINAL)) { FRESH(); rowpass<2>(F, xres, xres, args.in[18]); }
#undef IN
#undef SEAM
}

#undef Qn
#undef Kn
#undef VnT
#undef Qr
#undef Kr
#undef KzTf
#undef KzTb
#undef VrT
#undef Pf
#undef Pb
#undef mix
#undef Of
#undef Ob
#undef hb
#undef rs
#ifndef MK_SINGLE
#define MK_SINGLE 1
#endif
typedef void (*KernFn)(Args);
static int phase_class(int p) {
    if (p == PH_PRO) return 0; if (p == PH_FINAL) return 16;
    const int q = (p - PH_L0) % PH_PER_LAYER;
    if (q == 0) return 1;
    if (q <= 2 * PH_PER_HALF) return 2 + (q - 1) % PH_PER_HALF;
    static const int tail[8] = {1, 9, 10, 11, 12, 13, 14, 15};
    return tail[q - 1 - 2 * PH_PER_HALF];
}
extern "C" void kernel_launch(void* const* d_in, const int* in_sizes, int n_in, void* d_out, int out_size, void* d_ws, size_t ws_size, hipStream_t stream) {
    static int grid = 0;
#if MK_SINGLE
    static KernFn fns[1] = { fwd_kernel<-1> };
    constexpr int NF = 1;
#else
    static KernFn fns[17] = { fwd_kernel<0>, fwd_kernel<1>, fwd_kernel<2>, fwd_kernel<3>, fwd_kernel<4>, fwd_kernel<5>, fwd_kernel<6>, fwd_kernel<7>, fwd_kernel<8>, fwd_kernel<9>, fwd_kernel<10>, fwd_kernel<11>, fwd_kernel<12>, fwd_kernel<13>, fwd_kernel<14>, fwd_kernel<15>, fwd_kernel<16> };
    constexpr int NF = 17;
#endif
    if (grid == 0) {
        if (n_in != 19 || out_size != T * D || ws_size < WS_END) { fprintf(stderr, "kernel_launch: unexpected shapes (n_in %d, out %d, ws %zu < %zu)\n", n_in, out_size, ws_size, (size_t)WS_END); grid = -1; return; }
        int dev = 0, cus = 0, per_cu = 0;
        if (hipGetDevice(&dev) != hipSuccess || hipDeviceGetAttribute(&cus, hipDeviceAttributeMultiprocessorCount, dev) != hipSuccess) { grid = -1; return; }
        for (int i = 0; i < NF; ++i) {
            if (hipFuncSetAttribute((const void*)fns[i], hipFuncAttributeMaxDynamicSharedMemorySize, LDS_BYTES) != hipSuccess) { fprintf(stderr, "kernel_launch: hipFuncSetAttribute failed\n"); grid = -1; return; }
            if (hipOccupancyMaxActiveBlocksPerMultiprocessor(&per_cu, (const void*)fns[i], NWAVES * 64, LDS_BYTES) != hipSuccess || per_cu < 1) { fprintf(stderr, "kernel_launch: occupancy query says %d for fn %d\n", per_cu, i); grid = -1; return; }
        }
        (void)hipGetLastError();
        grid = cus < 256 ? cus : 256;
    }
    if (grid < 0) return;
    (void)hipMemsetAsync((char*)d_ws + WS_CTL, 0, CTL_ZERO_BYTES, stream);
    Args a{};
    for (int i = 0; i < 19; ++i) a.in[i] = (const float*)d_in[i];
    a.out = (float*)d_out; a.ws = (unsigned char*)d_ws;
#if MK_SINGLE
    a.ph_lo = 0; a.ph_hi = PH_COUNT;
    hipLaunchKernelGGL(fns[0], dim3(grid), dim3(NWAVES * 64), LDS_BYTES, stream, a);
#else
    for (int p = 0; p < PH_COUNT; ++p) { a.ph_lo = p; a.ph_hi = p + 1; hipLaunchKernelGGL(fns[phase_class(p)], dim3(grid), dim3(NWAVES * 64), LDS_BYTES, stream, a); }
#endif
}
```

```cpp
#include <hip/hip_runtime.h>
#include <cstdio>
#include <cstdint>
namespace pg8 {
#define PG8_LAS __attribute__((address_space(3)))
typedef unsigned short bf16_t;
typedef short bf16x8 __attribute__((ext_vector_type(8)));
typedef float f32x4 __attribute__((ext_vector_type(4)));
typedef unsigned u32x4 __attribute__((ext_vector_type(4)));
typedef unsigned u32x2 __attribute__((ext_vector_type(2)));
constexpr int BM = 256, BK = 64, HALF = 128, HTB = HALF * BK * 2  , STAGE_BYTES = 8 * HTB, NXCD = 8, WGM = 8;

__host__ __device__ __forceinline__ int lds_byte(int r, int c) { const int st = (r >> 4) * 2 + (c >> 5), rr = r & 15, cc = c & 31, ob = rr * 64 + cc * 2; return st * 1024 + (ob ^ (((ob >> 9) & 1) << 5)); }
__host__ __device__ __forceinline__ void stage_rc(int b, int& R, int& C) { const int st = b / 1024, sb = b % 1024, swz = sb ^ (((sb >> 9) & 1) << 5); R = (st >> 1) * 16 + swz / 64; C = (st & 1) * 32 + (swz % 64) / 2; }
__host__ __device__ __forceinline__ int perm32(int rho) { const int n = rho >> 4, i = rho & 15; return 8 * (i >> 2) + 4 * n + (i & 3); }

struct Unit { int pm, pn, e; };

struct DenseOrder {
    int nM, nN, nwg, G, c;
    __device__ __forceinline__ void init(int M, int N, int G_, int c_) { nM = M / BM; nN = N / BM; nwg = nM * nN; G = G_; c = c_; }
    __device__ __forceinline__ bool next_mn(int i, int& pm, int& pn) const {
        const long L = (long)i * G + c; if (L >= nwg) return false;
        int wgid = (int)L; { const int q = nwg / NXCD, r = nwg % NXCD, xcd = wgid % NXCD, off = wgid / NXCD; wgid = (xcd < r ? xcd * (q + 1) : r * (q + 1) + (xcd - r) * q) + off; }
        const int nig = WGM * nN, gid = wgid / nig, fm = gid * WGM, gsz = (nM - fm) < WGM ? (nM - fm) : WGM;
        pm = fm + ((wgid % nig) % gsz); pn = (wgid % nig) / gsz; return true;
    }
};

__device__ __forceinline__ unsigned cvt_pk_bf16(float lo, float hi) { unsigned r; asm volatile("v_cvt_pk_bf16_f32 %0, %1, %2" : "=v"(r) : "v"(lo), "v"(hi)); return r; }

template <class Epi, class Sched>
__device__ __forceinline__ void gemm_phase(PG8_LAS unsigned char* lds, const bf16_t* Abase_, const int K, const Sched& S, const Epi& E, const int tid_in) {
    int tid_ = tid_in; asm volatile("" : "+v"(tid_));
    const int tid = tid_, wid = __builtin_amdgcn_readfirstlane(tid >> 6), lane = tid & 63, wr = wid >> 2, wc = wid & 3, fr = lane & 15, fq = lane >> 4;
    const int nt = K / BK;
    const char* Abase = (const char*)Abase_;
    int RA0, RA1; unsigned CA0, CA1; unsigned voffB[2];
    { int R, C; stage_rc(tid * 16, R, C); RA0 = R; CA0 = (unsigned)C * 2u; const int Rb = Epi::PERM ? ((R & ~31) + perm32(R & 31)) : R; voffB[0] = (unsigned)(Rb * K + C) * 2u;
      stage_rc(tid * 16 + 8192, R, C); RA1 = R; CA1 = (unsigned)C * 2u; const int Rb1 = Epi::PERM ? ((R & ~31) + perm32(R & 31)) : R; voffB[1] = (unsigned)(Rb1 * K + C) * 2u; }
    const unsigned rowb = (unsigned)K * 2u;
    const size_t kstep = (size_t)(BK * 2);
    const size_t hstep = (size_t)HALF * K * 2;
    const unsigned ldsw = (unsigned)wid * 1024u;
    const int aoff = lds_byte(wr * 64 + fr, fq * 8), boff = lds_byte(wc * 32 + fr, fq * 8);
#define PG8_SA(b, h) (((b) * 2 + (h)) * HTB)
#define PG8_SB(b, h) ((4 + (b) * 2 + (h)) * HTB)
#define PG8_STAGE2(bufoff, gbase, o0, o1) do { \
        __builtin_amdgcn_global_load_lds((const unsigned*)((const char*)(gbase) + (o0)), (PG8_LAS unsigned*)(lds + (bufoff) + ldsw), 16, 0, 0); \
        __builtin_amdgcn_global_load_lds((const unsigned*)((const char*)(gbase) + (o1)), (PG8_LAS unsigned*)(lds + (bufoff) + ldsw + 8192), 16, 0, 0); } while (0)
#define PG8_STAGEB(bufoff, gbase) PG8_STAGE2(bufoff, gbase, voffB[0], voffB[1])
#define PG8_LDA(dst, b, h) do { _Pragma("unroll") for (int m = 0; m < 4; ++m) _Pragma("unroll") for (int k = 0; k < 2; ++k) dst[m][k] = *(const PG8_LAS bf16x8*)(lds + PG8_SA(b, h) + aoff + m * 2048 + k * 1024); } while (0)
#define PG8_LDB(dst, b, h) do { _Pragma("unroll") for (int n = 0; n < 2; ++n) _Pragma("unroll") for (int k = 0; k < 2; ++k) dst[n][k] = *(const PG8_LAS bf16x8*)(lds + PG8_SB(b, h) + boff + n * 2048 + k * 1024); } while (0)
#define PG8_MMA(ai, bj, At, Bt) do { __builtin_amdgcn_s_setprio(1); _Pragma("unroll") for (int m = 0; m < 4; ++m) _Pragma("unroll") for (int n = 0; n < 2; ++n) _Pragma("unroll") for (int k = 0; k < 2; ++k) \
        acc[ai][bj][m][n] = __builtin_amdgcn_mfma_f32_16x16x32_bf16(Bt[n][k], At[m][k], acc[ai][bj][m][n], 0, 0, 0); __builtin_amdgcn_s_setprio(0); } while (0)
#define PG8_WAIT_V(n) asm volatile("s_waitcnt vmcnt(" #n ")" ::: "memory")
#define PG8_WAIT_L(n) asm volatile("s_waitcnt lgkmcnt(" #n ")" ::: "memory")
#define PG8_BAR __builtin_amdgcn_s_barrier()
#define PG8_SCHED __builtin_amdgcn_sched_barrier(0)
    Unit cur, nxt; int ui = 0;
    if (!S.next(0, cur)) return;
    f32x4 acc[2][2][4][2];
#pragma unroll
    for (int a = 0; a < 2; ++a)
#pragma unroll
        for (int b = 0; b < 2; ++b)
#pragma unroll
            for (int m = 0; m < 4; ++m)
#pragma unroll
                for (int n = 0; n < 2; ++n) acc[a][b][m][n] = (f32x4){0.f, 0.f, 0.f, 0.f};
    bf16x8 At[4][2], B0[2][2], B1[2][2];
    unsigned v00, v01, v10, v11;
    if constexpr (Sched::GATHER) { v00 = S.a_row(cur, RA0) * rowb + CA0; v01 = S.a_row(cur, RA1) * rowb + CA1; v10 = S.a_row(cur, HALF + RA0) * rowb + CA0; v11 = S.a_row(cur, HALF + RA1) * rowb + CA1; }
    else { v00 = (unsigned)RA0 * rowb + CA0; v01 = (unsigned)RA1 * rowb + CA1; v10 = (unsigned)(HALF + RA0) * rowb + CA0; v11 = (unsigned)(HALF + RA1) * rowb + CA1; }
    const char* cA = Abase + S.a_off(cur, rowb);
    const char* cB = S.b_base(cur);
    PG8_STAGEB(PG8_SB(0, 0), cB); PG8_STAGEB(PG8_SB(0, 1), cB + hstep); PG8_STAGE2(PG8_SA(0, 0), cA, v00, v01); PG8_STAGE2(PG8_SA(0, 1), cA, v10, v11);
    if (wr == 1) PG8_BAR;
    PG8_WAIT_V(2); PG8_BAR;
    PG8_STAGEB(PG8_SB(1, 0), cB + kstep); PG8_STAGE2(PG8_SA(1, 0), cA + kstep, v00, v01); PG8_STAGEB(PG8_SB(1, 1), cB + hstep + kstep);
    PG8_WAIT_V(6); PG8_BAR;
    for (;;) {
        const bool has_next = S.next(ui + 1, nxt);
        unsigned n00 = v00, n01 = v01, n10 = v10, n11 = v11; const char* nB = cB; const char* nA = cA;
        if (has_next) { nB = S.b_base(nxt); nA = Abase + S.a_off(nxt, rowb);
            if constexpr (Sched::GATHER) { n00 = S.a_row(nxt, RA0) * rowb + CA0; n01 = S.a_row(nxt, RA1) * rowb + CA1; n10 = S.a_row(nxt, HALF + RA0) * rowb + CA0; n11 = S.a_row(nxt, HALF + RA1) * rowb + CA1; } }
#pragma unroll 1
        for (int t = 0; t < nt; t += 2) {
            const bool last = (t == nt - 2);
            const char* a1 = cA + (size_t)(t + 1) * kstep;
            const char* a2 = last ? nA : cA + (size_t)(t + 2) * kstep; const char* b2 = last ? nB : cB + (size_t)(t + 2) * kstep;
            const char* a3 = a2 + kstep; const char* b3 = b2 + kstep;
            unsigned w00 = v00, w01 = v01, w10 = v10, w11 = v11;
            if constexpr (Sched::GATHER) { w00 = last ? n00 : v00; w01 = last ? n01 : v01; w10 = last ? n10 : v10; w11 = last ? n11 : v11; }
            PG8_LDB(B0, 0, 0); PG8_LDB(B1, 0, 1); PG8_SCHED; PG8_LDA(At, 0, 0); PG8_STAGE2(PG8_SA(1, 1), a1, v10, v11);
            PG8_WAIT_V(8); PG8_WAIT_L(0); PG8_BAR; PG8_MMA(0, 0, At, B0); PG8_MMA(0, 1, At, B1); PG8_BAR; PG8_SCHED;
            PG8_LDA(At, 0, 1); PG8_STAGEB(PG8_SB(0, 0), b2); PG8_STAGEB(PG8_SB(0, 1), b2 + hstep); PG8_STAGE2(PG8_SA(0, 0), a2, w00, w01);
            PG8_WAIT_V(8); PG8_WAIT_L(0); PG8_BAR; PG8_MMA(1, 0, At, B0); PG8_MMA(1, 1, At, B1); PG8_BAR; PG8_SCHED;
            PG8_LDB(B0, 1, 0); PG8_LDB(B1, 1, 1); PG8_SCHED; PG8_LDA(At, 1, 0); PG8_STAGE2(PG8_SA(0, 1), a2, w10, w11);
            PG8_WAIT_V(8); PG8_WAIT_L(0); PG8_BAR; PG8_MMA(0, 0, At, B0); PG8_MMA(0, 1, At, B1); PG8_BAR; PG8_SCHED;
            PG8_LDA(At, 1, 1); PG8_STAGEB(PG8_SB(1, 0), b3); PG8_STAGEB(PG8_SB(1, 1), b3 + hstep); PG8_STAGE2(PG8_SA(1, 0), a3, w00, w01);
            PG8_WAIT_V(8); PG8_WAIT_L(0); PG8_BAR; PG8_MMA(1, 0, At, B0); PG8_MMA(1, 1, At, B1); PG8_BAR; PG8_SCHED;
        }
        if (wr == 0) PG8_BAR;
        { Unit ue; int a_ = cur.pm, b_ = cur.pn, c_ = cur.e; asm volatile("" : "+v"(a_), "+v"(b_), "+v"(c_));
          ue.pm = __builtin_amdgcn_readfirstlane(a_); ue.pn = __builtin_amdgcn_readfirstlane(b_); ue.e = __builtin_amdgcn_readfirstlane(c_);
          E(acc, ue, wr, wc, fr, fq); }
        if (!has_next) break;
#pragma unroll
        for (int a = 0; a < 2; ++a)
#pragma unroll
            for (int b = 0; b < 2; ++b)
#pragma unroll
                for (int m = 0; m < 4; ++m)
#pragma unroll
                    for (int n = 0; n < 2; ++n) acc[a][b][m][n] = (f32x4){0.f, 0.f, 0.f, 0.f};
        cur = nxt; cB = nB; cA = nA; ++ui;
        if constexpr (Sched::GATHER) { v00 = n00; v01 = n01; v10 = n10; v11 = n11; }
        if (wr == 1) PG8_BAR;
    }
    PG8_WAIT_V(0);
    PG8_BAR;
#undef PG8_SA
#undef PG8_SB
#undef PG8_STAGE2
#undef PG8_STAGEB
#undef PG8_LDA
#undef PG8_LDB
#undef PG8_MMA
#undef PG8_WAIT_V
#undef PG8_WAIT_L
#undef PG8_BAR
#undef PG8_SCHED
}
}
constexpr int NWAVES = 8;
constexpr int D = 2048, BATCH = 4, SEQ = 8192, T = BATCH * SEQ, DEPTH = 2;
constexpr int NIN = 18432, PLE = 256, NEXP = 32, DFF = 512;
constexpr int HT = 16384;
constexpr int NPROJ = 12288;
constexpr float EPS = 1e-6f;
constexpr int MAXTILES = 288;
constexpr int APAD = MAXTILES * 256;

constexpr size_t MiB = 1u << 20;
constexpr size_t WS_CTL = 0, CTL_ZERO_BYTES = 1 * MiB;
constexpr size_t WS_DT = 1 * MiB;
constexpr int DT_STRIDE = 512;
constexpr size_t WS_WR = 2 * MiB;
constexpr size_t WS_ROPE = 4 * MiB;
constexpr size_t WS_RS = 12 * MiB;
constexpr size_t WS_ROUTE = WS_RS + 128 * 1024;
constexpr size_t WS_INV = WS_ROUTE + 512 * 1024;
constexpr size_t WS_LTOK = WS_INV + 256 * 1024;
constexpr size_t WS_LW = WS_LTOK + 288 * 1024;
constexpr size_t WS_META = WS_LW + 288 * 1024;
constexpr size_t WS_LRS = WS_META + 4096;
constexpr size_t WS_PB = 16 * MiB;
constexpr size_t WS_W = 48 * MiB;
constexpr size_t W_IN = 0, W_OUT = 72 * MiB, W_GU = 80 * MiB, W_DN = 208 * MiB, W_PG = 272 * MiB, W_PP = 280 * MiB, W_LAYER = 282 * MiB;
constexpr size_t WS_HB = WS_W + 2 * W_LAYER;
constexpr size_t WS_PROJ = WS_HB + 128 * MiB;
constexpr size_t PJ = 64 * MiB;
constexpr size_t WS_QN = WS_PROJ, WS_KN = WS_PROJ + PJ, WS_VNT = WS_PROJ + 2 * PJ, WS_QR = WS_PROJ + 3 * PJ, WS_KR = WS_PROJ + 4 * PJ, WS_KZF = WS_PROJ + 5 * PJ, WS_KZB = WS_PROJ + 6 * PJ, WS_VRT = WS_PROJ + 7 * PJ;
constexpr size_t WS_OF = WS_KR;
constexpr size_t WS_PF = WS_PROJ + 8 * PJ, WS_PBW = WS_PF + 32 * MiB;
constexpr size_t WS_OB = WS_PBW + 32 * MiB;
constexpr size_t WS_MIX = WS_OB + 64 * MiB;
constexpr size_t WS_NA = WS_QN;
constexpr size_t WS_END = WS_MIX + 64 * MiB;
constexpr size_t XB_OFF = 128 * MiB;
constexpr size_t WS_XB2 = WS_PF;
constexpr size_t WS_ACT = WS_PROJ;
constexpr size_t WS_YP = WS_PROJ + 72 * MiB;
constexpr size_t WS_PP = WS_PROJ + 360 * MiB;
static_assert(WS_PP + 128 * MiB <= WS_PF, "pp inside proj region");
constexpr int CW_BAR = 4096;

constexpr int RING_BYTES = 131072;
constexpr int LDS_BYTES = 163840;
constexpr int MISC_OFF = LDS_BYTES - 1024;

#define GAS __attribute__((address_space(1)))
#define LAS __attribute__((address_space(3)))
typedef unsigned short bf16;
typedef unsigned v4u __attribute__((ext_vector_type(4)));
typedef unsigned v2u __attribute__((ext_vector_type(2)));
typedef float f32x4 __attribute__((ext_vector_type(4)));
typedef short bf16x8 __attribute__((ext_vector_type(8)));
#define LDS_WAIT() asm volatile("s_waitcnt lgkmcnt(0)" ::: "memory")
#define VM_WAIT() asm volatile("s_waitcnt vmcnt(0)" ::: "memory")
__device__ __forceinline__ unsigned f2bf(float f) { unsigned u = __builtin_bit_cast(unsigned, f); return (u + 0x7fffu + ((u >> 16) & 1u)) >> 16; }
__device__ __forceinline__ unsigned pk2(float lo, float hi) { return f2bf(lo) | (f2bf(hi) << 16); }
__device__ __forceinline__ float bf2f(unsigned b) { return __builtin_bit_cast(float, b << 16); }
__device__ __forceinline__ float bflo(unsigned w) { return __builtin_bit_cast(float, w << 16); }
__device__ __forceinline__ float bfhi(unsigned w) { return __builtin_bit_cast(float, w & 0xffff0000u); }
__device__ __forceinline__ float sigmoidf_(float x) { return __builtin_amdgcn_rcpf(1.0f + __expf(-x)); }
__device__ __forceinline__ float siluf_(float x) { return x * __builtin_amdgcn_rcpf(1.0f + __expf(-x)); }
__device__ __forceinline__ bf16x8 ld_frag16(const bf16* p) { return *(const GAS bf16x8*)p; }
__device__ __forceinline__ size_t qk_frag(int bl, int h, int tt, int ks) { return ((size_t)(((bl * 8 + h) * 512 + tt) * 8 + ks)) * 1024; }
__device__ __forceinline__ size_t kz_frag(int bl, int h, int c, int dt, int ks) { return ((size_t)((((bl * 8 + h) * 64 + c) * 16 + dt) * 4 + ks)) * 1024; }
__device__ __forceinline__ size_t p_frag(int unit, int it, int ks) { return ((size_t)((unit * 8 + it) * 4 + ks)) * 1024; }
__device__ __forceinline__ float shx(float v, int mask, int lane) { return __builtin_bit_cast(float, __builtin_amdgcn_ds_bpermute((lane ^ mask) << 2, __builtin_bit_cast(int, v))); }
__device__ __forceinline__ float wave_sum(float v, int lane) {
#pragma unroll
    for (int o = 1; o < 64; o <<= 1) v += shx(v, o, lane);
    return v;
}

#define XB_TMO      128
#define XB_XCNT(j)  (256  + 64 * (j))
#define XB_XSUB(j)  (1280 + 64 * (j))
#define XB_XGEN(j)  (2304 + 64 * (j))
#define XB_TOP      3328
#define XB_TOPGEN   3392
#define XCD_BAR_WORDS 3456
#define XB_SPIN_CAP (1u << 18)
__device__ __forceinline__ unsigned xb_ld(unsigned* p)              { return __hip_atomic_load(p, __ATOMIC_RELAXED, __HIP_MEMORY_SCOPE_AGENT); }
__device__ __forceinline__ unsigned xb_add(unsigned* p, unsigned v) { return __hip_atomic_fetch_add(p, v, __ATOMIC_RELAXED, __HIP_MEMORY_SCOPE_AGENT); }
__device__ __forceinline__ unsigned xb_xcc_id() { return (unsigned)__builtin_amdgcn_s_getreg((3 << 11) | 20) & 0xFu; }
#define XB_SPIN(cond, bar) do { unsigned _sp = 0; while (cond) { __builtin_amdgcn_s_sleep(1); \
    if ((++_sp & 255u) == 0u) { if (xb_ld(&(bar)[XB_TMO])) break; if (_sp > XB_SPIN_CAP) { atomicAdd(&(bar)[XB_TMO], 1u); break; } } } } while (0)
struct XcdBarrier { unsigned* bar; unsigned x; volatile LAS unsigned* st; };
__device__ __forceinline__ XcdBarrier xcd_barrier_post(unsigned* bar, volatile LAS unsigned* st, const bool t0) {
    XcdBarrier b; b.bar = bar; b.x = xb_xcc_id(); b.st = st;
    if (t0) (void)xb_add(&bar[XB_XCNT(b.x)], 1u);
    return b;
}
__device__ __forceinline__ void xcd_barrier_complete(unsigned* bar, unsigned x, unsigned& nloc, unsigned& nx) {
    const unsigned G = gridDim.x * gridDim.y * gridDim.z;
    unsigned sum, cnt, mine, sp = 0u;
    for (;;) {
        sum = 0u; cnt = 0u; mine = 0u;
#pragma unroll
        for (unsigned j = 0; j < 16; ++j) { const unsigned c = xb_ld(&bar[XB_XCNT(j)]); sum += c; cnt += (c > 0u) ? 1u : 0u; mine = (j == x) ? c : mine; }
        if (sum == G) break;
        __builtin_amdgcn_s_sleep(1);
        if ((++sp & 255u) == 0u) { if (xb_ld(&bar[XB_TMO])) break; if (sp > XB_SPIN_CAP) { atomicAdd(&bar[XB_TMO], 1u); break; } }
    }
    nloc = mine > 0u ? mine : 1u; nx = cnt > 0u ? cnt : 1u;
}
__device__ __forceinline__ void xcd_barrier(const XcdBarrier& b, const bool t0) {
    asm volatile("s_waitcnt vmcnt(0)" ::: "memory");
    __syncthreads();
    if (t0) {
        unsigned* bar = b.bar;
        __builtin_amdgcn_s_waitcnt(0);
        unsigned nloc = b.st[0], nx = b.st[1];
        if (nloc == 0u) { xcd_barrier_complete(bar, b.x, nloc, nx); b.st[0] = nloc; b.st[1] = nx; }
        const unsigned old = xb_add(&bar[XB_XSUB(b.x)], 1u);
        const unsigned gen = old / nloc;
        if (old + 1u == (gen + 1u) * nloc) {
            __builtin_amdgcn_fence(__ATOMIC_RELEASE, "agent");
            asm volatile("s_waitcnt vmcnt(0)" ::: "memory");
            const unsigned og = xb_add(&bar[XB_TOP], 1u);
            const unsigned tg = og / nx;
            if (og + 1u == (tg + 1u) * nx) xb_add(&bar[XB_TOPGEN], 1u);
            else XB_SPIN(xb_ld(&bar[XB_TOPGEN]) == tg, bar);
            __builtin_amdgcn_fence(__ATOMIC_ACQUIRE, "agent");
            xb_add(&bar[XB_XGEN(b.x)], 1u);
            asm volatile("s_waitcnt vmcnt(0)" ::: "memory");
        } else {
            XB_SPIN(xb_ld(&bar[XB_XGEN(b.x)]) == gen, bar);
            __builtin_amdgcn_fence(__ATOMIC_ACQUIRE, "agent");
            asm volatile("s_waitcnt vmcnt(0)" ::: "memory");
        }
    }
    __syncthreads();
}

struct Frame {
    LAS unsigned char* lds;
    volatile LAS unsigned* MISC;
    int tid, lane, wave, vcu, G;
    unsigned char* ws;
    float* out;
};
__device__ __forceinline__ void tr_item(const float* W, int K, int N, const float* gain, bf16* WT, int mode, LAS float* scr, int item, int lane) {
    const int nblk = N / 32, kb = item / nblk, nb = item % nblk, k0 = 64 * kb, n0 = 32 * nb;
    float cs = 1.0f;
    if (mode == 1) { if (n0 < 2048) cs = 0.12751743342f;     else if (n0 >= 8192 && n0 < 10240) cs = 0.0625f; }
    float wv[32];
#pragma unroll
    for (int i = 0; i < 32; ++i) wv[i] = W[(size_t)(k0 + 2 * i + (lane >> 5)) * N + n0 + (lane & 31)];
#pragma unroll
    for (int i = 0; i < 32; ++i) { const int kk = 2 * i + (lane >> 5); const float g = gain ? gain[k0 + kk] * cs : cs; scr[kk * 33 + (lane & 31)] = wv[i] * g; }
    LDS_WAIT(); asm volatile("" ::: "memory");
    const int c = lane & 7;
#pragma unroll
    for (int j = 0; j < 4; ++j) { const int n = (lane >> 3) + 8 * j; const LAS float* s = scr + (8 * c) * 33 + n;
        v4u o; o.x = pg8::cvt_pk_bf16(s[0 * 33], s[1 * 33]); o.y = pg8::cvt_pk_bf16(s[2 * 33], s[3 * 33]); o.z = pg8::cvt_pk_bf16(s[4 * 33], s[5 * 33]); o.w = pg8::cvt_pk_bf16(s[6 * 33], s[7 * 33]);
        const int nn = n0 + n; int dr = nn; if (mode == 2) dr = (nn >> 2) * 8 + (nn & 3); else if (mode == 3) dr = (nn >> 2) * 8 + 4 + (nn & 3);
        *(GAS v4u*)(WT + (size_t)dr * K + k0 + 8 * c) = o; }
    LDS_WAIT(); asm volatile("" ::: "memory");
}
__device__ __forceinline__ float log_sigmoidf_(float x) { return x >= 0.f ? -log1pf(expf(-x)) : x - log1pf(expf(x)); }

__device__ __forceinline__ void p0_prologue(Frame& F, const float* in_p, const float* in_nmix, const float* in_win, const float* in_decf, const float* in_decb, const float* in_wout, const float* in_nffn,
        const float* in_wrg, const float* in_wre, const float* in_wg, const float* in_wu, const float* in_wd, const float* in_nple, const float* in_wpg, const float* in_wpp) {
    LAS float* scr = (LAS float*)(F.lds + F.wave * 16384);
    const int gw = F.vcu * NWAVES + F.wave, NGW = F.G * NWAVES;
    constexpr int I_IN = 32 * 576, I_SQ = 2048, I_EX = 16384, I_PP = 256;
    constexpr int PER_LAYER = I_IN + I_SQ + 3 * I_EX + I_SQ + I_PP;
    for (int it = gw; it < DEPTH * PER_LAYER; it += NGW) {
        const int l = it / PER_LAYER; int r = it % PER_LAYER;
        unsigned char* wl = F.ws + WS_W + (size_t)l * W_LAYER;
        if (r < I_IN) { tr_item(in_win + (size_t)l * D * NIN, D, NIN, in_nmix + l * D, (bf16*)(wl + W_IN), 1, scr, r, F.lane); continue; } r -= I_IN;
        if (r < I_SQ) { tr_item(in_wout + (size_t)l * D * D, D, D, nullptr, (bf16*)(wl + W_OUT), 0, scr, r, F.lane); continue; } r -= I_SQ;
        if (r < I_EX) { const int e = r >> 9; tr_item(in_wg + ((size_t)l * NEXP + e) * D * DFF, D, DFF, in_nffn + l * D, (bf16*)(wl + W_GU) + (size_t)e * 1024 * D, 2, scr, r & 511, F.lane); continue; } r -= I_EX;
        if (r < I_EX) { const int e = r >> 9; tr_item(in_wu + ((size_t)l * NEXP + e) * D * DFF, D, DFF, in_nffn + l * D, (bf16*)(wl + W_GU) + (size_t)e * 1024 * D, 3, scr, r & 511, F.lane); continue; } r -= I_EX;
        if (r < I_EX) { const int e = r >> 9; tr_item(in_wd + ((size_t)l * NEXP + e) * DFF * D, DFF, D, nullptr, (bf16*)(wl + W_DN) + (size_t)e * D * DFF, 0, scr, r & 511, F.lane); continue; } r -= I_EX;
        if (r < I_SQ) { tr_item(in_wpg + (size_t)l * D * D, D, D, in_nple + l * D, (bf16*)(wl + W_PG), 0, scr, r, F.lane); continue; } r -= I_SQ;
        tr_item(in_wpp + (size_t)l * PLE * D, PLE, D, nullptr, (bf16*)(wl + W_PP), 0, scr, r, F.lane);
    }
    const int gt = F.vcu * (NWAVES * 64) + F.tid, NGT = F.G * NWAVES * 64;
    { float* cosT = (float*)(F.ws + WS_ROPE); float* sinT = cosT + SEQ * 128;
      for (int i = gt; i < SEQ * 128; i += NGT) { const int s = i >> 7, d = i & 127; const float inv = powf(10000.0f, -(float)d / 128.0f); const float ang = (float)s * inv; float sn, cs; sincosf(ang, &sn, &cs); cosT[i] = cs; sinT[i] = sn; } }
    { const float* p = in_p; bf16* pb = (bf16*)(F.ws + WS_PB);
      for (int i = gt; i < DEPTH * T * PLE / 8; i += NGT) { const f32x4 a = ((const GAS f32x4*)p)[2 * i], b = ((const GAS f32x4*)p)[2 * i + 1];
          v4u o; o.x = pg8::cvt_pk_bf16(a.x, a.y); o.y = pg8::cvt_pk_bf16(a.z, a.w); o.z = pg8::cvt_pk_bf16(b.x, b.y); o.w = pg8::cvt_pk_bf16(b.z, b.w); ((GAS v4u*)pb)[i] = o; } }
    { bf16* wr = (bf16*)(F.ws + WS_WR);
      for (int i = gt; i < DEPTH * 48 * D; i += NGT) { const int l = i / (48 * D), n = (i / D) % 48, k = i % D; float v = 0.f;
          if (n < 4) v = in_wrg[((size_t)l * D + k) * 4 + n]; else if (n < 36) v = in_wre[((size_t)l * D + k) * 32 + (n - 4)];
          v *= in_nffn[l * D + k];
          const unsigned hi = f2bf(v); const float lo = v - bf2f(hi);
          wr[((size_t)(l * 2 + 0) * 48 + n) * D + k] = (bf16)hi; wr[((size_t)(l * 2 + 1) * 48 + n) * D + k] = (bf16)f2bf(lo); } }
    { float* dt = (float*)(F.ws + WS_DT);
      for (int i = gt; i < DEPTH * 2 * 8 * 128; i += NGT) { const int j = i & 127, h = (i >> 7) & 7, dir = (i >> 10) & 1, l = i >> 11;
          const float x = dir == 0 ? in_decf[l * 8 + h] : in_decb[l * 8 + h]; const float lg = log_sigmoidf_(x);
          float* e = dt + (size_t)((l * 2 + dir) * 8 + h) * DT_STRIDE;
          if (j == 0) { e[0] = lg; e[1] = expf(128.0f * lg); }
          e[128 + j] = dir == 0 ? expf((float)(j + 1) * lg) : expf((float)(128 - j) * lg);
          e[256 + j] = dir == 0 ? expf((float)(127 - j) * lg) : expf((float)j * lg); } }
}

#define WSEL(w) 1.0f
template <int MODE, bool SRCF>
__device__ __forceinline__ void rowpass(Frame& F, const float* src, float* dst, const float* gfin) {
    bf16* xb = (bf16*)((unsigned char*)F.out + XB_OFF); const bf16* xs = MODE == 2 ? (const bf16*)(F.ws + WS_XB2) : xb;
    const int gw = F.vcu * NWAVES + F.wave, NGW = F.G * NWAVES;
    bf16* hb = (bf16*)(F.ws + WS_HB); float* rs = (float*)(F.ws + WS_RS);
    const int* inv = (const int*)(F.ws + WS_INV); const bf16* yp = (const bf16*)(F.ws + WS_YP);
    for (int m = gw; m < T; m += NGW) {
        f32x4 v[8]; float s = 0.f;
        if (SRCF) { const GAS f32x4* xr = (const GAS f32x4*)(src + (size_t)m * D) + F.lane;
#pragma unroll
            for (int j = 0; j < 8; ++j) v[j] = xr[64 * j];
            GAS v2u* xo = (GAS v2u*)(xb + (size_t)m * D) + F.lane;
#pragma unroll
            for (int j = 0; j < 8; ++j) { v2u o; o.x = pg8::cvt_pk_bf16(v[j].x, v[j].y); o.y = pg8::cvt_pk_bf16(v[j].z, v[j].w); xo[64 * j] = o; }
        } else { const GAS v2u* xr = (const GAS v2u*)(xs + (size_t)m * D) + F.lane;
#pragma unroll
            for (int j = 0; j < 8; ++j) { const v2u a = xr[64 * j]; v[j] = (f32x4){bflo(a.x), bfhi(a.x), bflo(a.y), bfhi(a.y)}; } }
        if (MODE == 1) {
            const int p0 = inv[2 * m], p1 = inv[2 * m + 1]; const v4u rt = ((const v4u*)(F.ws + WS_ROUTE))[m]; const float w0 = __builtin_bit_cast(float, rt.z), w1 = __builtin_bit_cast(float, rt.w);
            const GAS v2u* y0 = (const GAS v2u*)(yp + (size_t)p0 * D) + F.lane; const GAS v2u* y1 = (const GAS v2u*)(yp + (size_t)p1 * D) + F.lane;
#pragma unroll
            for (int j = 0; j < 8; ++j) { const v2u a = y0[64 * j], b = y1[64 * j];
                v[j].x += WSEL(w0) * bflo(a.x) + WSEL(w1) * bflo(b.x); v[j].y += WSEL(w0) * bfhi(a.x) + WSEL(w1) * bfhi(b.x); v[j].z += WSEL(w0) * bflo(a.y) + WSEL(w1) * bflo(b.y); v[j].w += WSEL(w0) * bfhi(a.y) + WSEL(w1) * bfhi(b.y); }
            GAS v2u* xo = (GAS v2u*)(xb + (size_t)m * D) + F.lane;
#pragma unroll
            for (int j = 0; j < 8; ++j) { v2u o; o.x = pg8::cvt_pk_bf16(v[j].x, v[j].y); o.y = pg8::cvt_pk_bf16(v[j].z, v[j].w); xo[64 * j] = o; }
        }
#pragma unroll
        for (int j = 0; j < 8; ++j) s += (v[j].x * v[j].x + v[j].y * v[j].y) + (v[j].z * v[j].z + v[j].w * v[j].w);
        const float r = 1.0f / sqrtf(wave_sum(s, F.lane) * (1.0f / D) + EPS);
        if (MODE == 2) {
            GAS f32x4* xo = (GAS f32x4*)(dst + (size_t)m * D) + F.lane; const GAS f32x4* gg = (const GAS f32x4*)gfin + F.lane;
#pragma unroll
            for (int j = 0; j < 8; ++j) { const f32x4 g = gg[64 * j]; xo[64 * j] = v[j] * r * g; }
        } else {
            GAS v2u* o8 = (GAS v2u*)(hb + (size_t)m * D) + F.lane;
#pragma unroll
            for (int j = 0; j < 8; ++j) { v2u o; o.x = pg8::cvt_pk_bf16(v[j].x * r, v[j].y * r); o.y = pg8::cvt_pk_bf16(v[j].z * r, v[j].w * r); o8[64 * j] = o; }
            if (F.lane == 0) rs[m] = r;
        }
    }
}

__device__ __forceinline__ void router_phase(Frame& F, int layer) {
    const int NGW = F.G * NWAVES, fr = F.lane & 15, g = F.lane >> 4;
    const bf16* wr = (const bf16*)(F.ws + WS_WR) + (size_t)layer * 2 * 48 * D;
    float* rsw = (float*)(F.ws + WS_RS); const bf16* xb = (const bf16*)((unsigned char*)F.out + XB_OFF); v4u* route = (v4u*)(F.ws + WS_ROUTE);
    LAS float* lg = (LAS float*)(F.lds + F.wave * 4096);
    constexpr unsigned WB = 32768u, WROW = 528u, WBUF = 96u * WROW;
    const int srow = F.tid >> 5, scol = F.tid & 31;
    const bf16* wsrc = wr + (size_t)srow * D + scol * 8;
    const unsigned wdst = WB + (unsigned)srow * WROW + (unsigned)scol * 16u, bfrag = WB + (unsigned)fr * WROW + (unsigned)g * 16u;
    for (int base = 0; base < T / 16; base += NGW) {
        const int tile = base + F.vcu * NWAVES + F.wave; const bool live = tile < T / 16; const int t0 = (live ? tile : 0) * 16;
        f32x4 acc[3]; acc[0] = acc[1] = acc[2] = (f32x4){0.f, 0.f, 0.f, 0.f}; float ssq = 0.f;
        const bf16* xrow = xb + (size_t)(t0 + fr) * D + 8 * g;
        v4u wreg[6], xc[8], xn[8];
#pragma unroll
        for (int i = 0; i < 6; ++i) wreg[i] = *(const GAS v4u*)(wsrc + (size_t)i * 16 * D);
#pragma unroll
        for (int k = 0; k < 8; ++k) xc[k] = *(const GAS v4u*)(xrow + 32 * k);
#pragma unroll 1
        for (int c = 0; c < 8; ++c) {
            const unsigned bo = (unsigned)(c & 1) * WBUF;
#pragma unroll
            for (int i = 0; i < 6; ++i) *(LAS v4u*)(F.lds + wdst + bo + (unsigned)i * 16u * WROW) = wreg[i];
            __syncthreads();
            if (c + 1 < 8) {
#pragma unroll
                for (int i = 0; i < 6; ++i) wreg[i] = *(const GAS v4u*)(wsrc + (size_t)i * 16 * D + 256 * (c + 1));
#pragma unroll
                for (int k = 0; k < 8; ++k) xn[k] = *(const GAS v4u*)(xrow + 256 * (c + 1) + 32 * k);
            }
#pragma unroll
            for (int ksl = 0; ksl < 8; ++ksl) {
                const v4u a = xc[ksl];
                { const float x0 = bflo(a.x), x1 = bfhi(a.x), x2 = bflo(a.y), x3 = bfhi(a.y), x4 = bflo(a.z), x5 = bfhi(a.z), x6 = bflo(a.w), x7 = bfhi(a.w);
                  ssq += (x0 * x0 + x1 * x1) + (x2 * x2 + x3 * x3) + (x4 * x4 + x5 * x5) + (x6 * x6 + x7 * x7); }
                const bf16x8 ah = __builtin_bit_cast(bf16x8, a);
#pragma unroll
                for (int nt = 0; nt < 3; ++nt) {
                    const bf16x8 bh = *(const LAS bf16x8*)(F.lds + bfrag + bo + (unsigned)(16 * nt) * WROW + (unsigned)ksl * 64u);
                    const bf16x8 bl = *(const LAS bf16x8*)(F.lds + bfrag + bo + (unsigned)(48 + 16 * nt) * WROW + (unsigned)ksl * 64u);
                    acc[nt] = __builtin_amdgcn_mfma_f32_16x16x32_bf16(ah, bh, acc[nt], 0, 0, 0);
                    acc[nt] = __builtin_amdgcn_mfma_f32_16x16x32_bf16(ah, bl, acc[nt], 0, 0, 0);
                }
            }
#pragma unroll
            for (int k = 0; k < 8; ++k) xc[k] = xn[k];
        }
        ssq += shx(ssq, 16, F.lane); ssq += shx(ssq, 32, F.lane);
        const float rtok = 1.0f / sqrtf(ssq * (1.0f / D) + EPS);
        if (g == 0 && live) rsw[t0 + fr] = rtok;
#pragma unroll
        for (int nt = 0; nt < 3; ++nt)
#pragma unroll
            for (int r = 0; r < 4; ++r) lg[(4 * g + r) * 52 + 16 * nt + fr] = acc[nt][r];
        LDS_WAIT(); asm volatile("" ::: "memory");
        if (F.lane < 16) {
            const int t = t0 + F.lane; const float rr = rtok; const LAS float* L = lg + F.lane * 52;
            float gl[4]; int gs = 0; float gm = -3.0e38f;
#pragma unroll
            for (int i = 0; i < 4; ++i) { gl[i] = L[i] * rr; if (gl[i] > gm) { gm = gl[i]; gs = i; } }
            float se = 0.f;
#pragma unroll
            for (int i = 0; i < 4; ++i) se += expf(gl[i] - gm);
            const float pg = 1.0f / se;
            float v0 = -3.0e38f, v1 = -3.0e38f; int i0 = 0, i1 = 0;
            for (int i = 0; i < 8; ++i) { const float v = L[4 + 8 * gs + i] * rr;
                if (v > v0) { v1 = v0; i1 = i0; v0 = v; i0 = i; } else if (v > v1) { v1 = v; i1 = i; } }
            const float e1 = expf(v1 - v0); const float w0 = pg / (1.0f + e1), w1 = pg * e1 / (1.0f + e1);
            v4u o; o.x = (unsigned)(gs * 8 + i0); o.y = (unsigned)(gs * 8 + i1); o.z = __builtin_bit_cast(unsigned, w0); o.w = __builtin_bit_cast(unsigned, w1);
            if (live) { route[t] = o;
                int* cnt = (int*)(F.ws + WS_CTL + 262144) + layer * 256;
                __hip_atomic_fetch_add(cnt + (gs * 8 + i0) * 8 + (t >> 12), 1, __ATOMIC_RELAXED, __HIP_MEMORY_SCOPE_AGENT); __hip_atomic_fetch_add(cnt + (gs * 8 + i1) * 8 + (t >> 12), 1, __ATOMIC_RELAXED, __HIP_MEMORY_SCOPE_AGENT); }
        }
        LDS_WAIT(); asm volatile("" ::: "memory");
    }
}

__device__ __forceinline__ void lists_phase(Frame& F, int layer) {
    const v4u* route = (const v4u*)(F.ws + WS_ROUTE);
    int* inv = (int*)(F.ws + WS_INV); int* ltok = (int*)(F.ws + WS_LTOK); float* lw = (float*)(F.ws + WS_LW); int* meta = (int*)(F.ws + WS_META); const float* rsr = (const float*)(F.ws + WS_RS); float* lrs = (float*)(F.ws + WS_LRS);
    LAS int* hist = (LAS int*)F.lds;
    const int c = F.vcu; if (c >= 256) return;
    const int e = c >> 3, part = c & 7;
    if (F.tid < 256) hist[128 + F.tid] = __hip_atomic_load((const int*)(F.ws + WS_CTL + 262144) + layer * 256 + F.tid, __ATOMIC_RELAXED, __HIP_MEMORY_SCOPE_AGENT);
    __syncthreads();
    if (F.tid < 32) { int s_ = 0; for (int p_ = 0; p_ < 8; ++p_) s_ += hist[128 + F.tid * 8 + p_]; hist[F.tid] = s_; }
    if (F.tid == 32) { int s_ = 0; for (int p_ = 0; p_ < part; ++p_) s_ += hist[128 + e * 8 + p_]; hist[32] = s_; }
    __syncthreads();
    if (F.tid == 0) { int acc = 0; for (int i = 0; i < 32; ++i) { hist[64 + i] = acc; acc += (hist[i] + 255) >> 8; } hist[96] = acc; }
    __syncthreads();
    if (c == 0 && F.tid < 33) meta[F.tid] = hist[64 + F.tid];
    const int region = hist[64 + e] * 256; int base = hist[32];
    const int cnt_e = hist[e];
    for (int ch = 0; ch < (T / 8) / 512; ++ch) {
        const int t = part * (T / 8) + ch * 512 + F.tid; const v4u r = route[t];
        const int m0 = ((int)r.x == e), m1 = ((int)r.y == e);
        const int mt = m0 | m1;
        const unsigned long long bal = __ballot(mt);
        const int pre = __popcll(bal & ((1ull << F.lane) - 1ull)); const int wc = __popcll(bal);
        __syncthreads();
        if (F.lane == 0) hist[40 + F.wave] = wc;
        __syncthreads();
        int woff = 0, tot = 0;
#pragma unroll
        for (int w = 0; w < NWAVES; ++w) { const int cw = hist[40 + w]; if (w < F.wave) woff += cw; tot += cw; }
        if (mt) { const int pos = region + base + woff + pre; ltok[pos] = t; lrs[pos] = rsr[t]; lw[pos] = __builtin_bit_cast(float, m0 ? r.z : r.w); inv[2 * t + (m0 ? 0 : 1)] = pos; }
        base += tot;
    }
    if (part == 7) { const int padend = ((cnt_e + 255) >> 8) * 256; for (int p = cnt_e + F.tid; p < padend; p += NWAVES * 64) { ltok[region + p] = 0; lw[region + p] = 0.f; lrs[region + p] = 0.f; } }
    __syncthreads();
}

constexpr int NA_KB = 64 * 272, NA_VB = 64 * 288, NA_RPB = 2 * NA_KB + 2 * NA_VB;
typedef short s16x4 __attribute__((ext_vector_type(4)));
__device__ __forceinline__ s16x4 tr_read16(unsigned addr) { s16x4 r; asm volatile("ds_read_b64_tr_b16 %0, %1" : "=&v"(r) : "v"(addr) : "memory"); return r; }
template <int OFF> __device__ __forceinline__ s16x4 tr_read16o(unsigned addr) { s16x4 r; asm volatile("ds_read_b64_tr_b16 %0, %1 offset:%2" : "=&v"(r) : "v"(addr), "i"(OFF) : "memory"); return r; }
__device__ __forceinline__ void na_unit4(Frame& F, const bf16* Qn, const bf16* Kn, const bf16* Vn, bf16* out, const float* rpb, int u) {
    const int bl = u >> 9, h = (u >> 5) & 15, r0 = (u & 31) * 4;
    const int rq = r0 + (F.wave >> 1), qp = F.wave & 1, fr = F.lane & 15, g = F.lane >> 4;
    const int rs_row = min(max(rq - 4, 0), 120);
    const int kr_lo = min(max(r0 - 4, 0), 120), kr_hi = min(max(r0 - 1, 0), 120) + 7, nkr = kr_hi - kr_lo + 1;
    bf16x8 qf[2][4]; f32x4 o[2][8]; float mrun[2], lrun[2];
#pragma unroll
    for (int j = 0; j < 2; ++j) { const int tq = bl * SEQ + rq * 64 + 16 * (2 * qp + j) + fr;
#pragma unroll
        for (int ks = 0; ks < 4; ++ks) qf[j][ks] = ld_frag16(Qn + ((size_t)(bl * 16 + h) * SEQ + (tq - bl * SEQ)) * 128 + 32 * ks + 8 * g);
#pragma unroll
        for (int dt = 0; dt < 8; ++dt) o[j][dt] = (f32x4){0.f, 0.f, 0.f, 0.f};
        mrun[j] = -1e30f; lrun[j] = 0.f; }
    const int c0i = F.tid >> 4, d0i = F.tid & 15;
    const bf16* kg = Kn + (size_t)(bl * 16 + h) * SEQ * 128 + d0i * 8;
    const bf16* vg = Vn + (size_t)(bl * 16 + h) * SEQ * 128 + d0i * 8;
    const unsigned kl0 = (unsigned)(c0i * 272 + d0i * 16), vl0 = (unsigned)(2 * NA_KB + c0i * 288 + d0i * 16);
#define NA_TR8(LO, HI, VA, O0) do { LO[0] = tr_read16o<(O0)>(VA); HI[0] = tr_read16o<(O0) + 4608>(VA); LO[1] = tr_read16o<(O0) + 32>(VA); HI[1] = tr_read16o<(O0) + 4640>(VA); \
        LO[2] = tr_read16o<(O0) + 64>(VA); HI[2] = tr_read16o<(O0) + 4672>(VA); LO[3] = tr_read16o<(O0) + 96>(VA); HI[3] = tr_read16o<(O0) + 4704>(VA); } while (0)
#define NA_COMPUTE() do { \
        if (kr >= rs_row && kr < rs_row + 8) { \
            const LAS unsigned char* Kl = F.lds + buf * NA_KB; const unsigned Vl = (unsigned)(2 * NA_KB + buf * NA_VB); \
            const unsigned brow = (unsigned)(NA_RPB + (kr - rq + 7) * 128);     \
            const int kc0[2] = {qp == 0 ? 0 : 24, qp == 0 ? 8 : 32}; \
            unsigned bp[2][2] = {{bpk[0][0], bpk[0][1]}, {bpk[1][0], bpk[1][1]}}; asm volatile("" : "+v"(bp[0][0]), "+v"(bp[0][1]), "+v"(bp[1][0]), "+v"(bp[1][1]));     \
            f32x4 sc[2][2]; float bb[2][2][4]; \
        _Pragma("unroll") \
            for (int j = 0; j < 2; ++j) \
        _Pragma("unroll") \
              for (int kb = 0; kb < 2; ++kb) \
        _Pragma("unroll") \
                for (int rg = 0; rg < 4; ++rg) bb[j][kb][rg] = *(const LAS float*)(F.lds + brow + ((bp[j][kb] >> (8 * rg)) & 0xffu)); \
        _Pragma("unroll") \
            for (int kb = 0; kb < 2; ++kb) { bf16x8 kf[2][4]; \
        _Pragma("unroll") \
              for (int j = 0; j < 2; ++j) \
        _Pragma("unroll") \
                  for (int ks = 0; ks < 4; ++ks) kf[j][ks] = *(const LAS bf16x8*)(Kl + (kc0[j] + 16 * kb + fr) * 272 + (32 * ks + 8 * g) * 2); \
              asm volatile("s_waitcnt lgkmcnt(0)" ::: "memory"); __builtin_amdgcn_sched_barrier(0); \
        _Pragma("unroll") \
              for (int j = 0; j < 2; ++j) { f32x4 a = (f32x4){0.f, 0.f, 0.f, 0.f}; \
        _Pragma("unroll") \
                  for (int ks = 0; ks < 4; ++ks) a = __builtin_amdgcn_mfma_f32_16x16x32_bf16(kf[j][ks], qf[j][ks], a, 0, 0, 0); \
                  sc[j][kb] = a; } \
              __builtin_amdgcn_sched_barrier(0); } \
            float tmax[2] = {-1e30f, -1e30f}; \
        _Pragma("unroll") \
            for (int j = 0; j < 2; ++j) \
        _Pragma("unroll") \
              for (int kb = 0; kb < 2; ++kb) \
        _Pragma("unroll") \
                for (int rg = 0; rg < 4; ++rg) { const float sv = sc[j][kb][rg] + bb[j][kb][rg]; sc[j][kb][rg] = sv; tmax[j] = fmaxf(tmax[j], sv); } \
            { const float t0 = shx(tmax[0], 16, F.lane), t1 = shx(tmax[1], 16, F.lane); tmax[0] = fmaxf(tmax[0], t0); tmax[1] = fmaxf(tmax[1], t1); } \
            { const float t0 = shx(tmax[0], 32, F.lane), t1 = shx(tmax[1], 32, F.lane); tmax[0] = fmaxf(tmax[0], t0); tmax[1] = fmaxf(tmax[1], t1); } \
            bf16x8 pf[2]; float alpha[2]; \
        _Pragma("unroll") \
            for (int j = 0; j < 2; ++j) { \
                const float mnew = fmaxf(mrun[j], tmax[j]); alpha[j] = __builtin_amdgcn_exp2f(mrun[j] - mnew); mrun[j] = mnew; \
                float ps = 0.f; \
        _Pragma("unroll") \
                for (int kb = 0; kb < 2; ++kb) \
        _Pragma("unroll") \
                    for (int rg = 0; rg < 4; ++rg) { const float p = __builtin_amdgcn_exp2f(sc[j][kb][rg] - mnew); sc[j][kb][rg] = p; ps += p; } \
                lrun[j] = lrun[j] * alpha[j] + ps; \
                v4u pw; pw.x = pg8::cvt_pk_bf16(sc[j][0][0], sc[j][0][1]); pw.y = pg8::cvt_pk_bf16(sc[j][0][2], sc[j][0][3]); pw.z = pg8::cvt_pk_bf16(sc[j][1][0], sc[j][1][1]); pw.w = pg8::cvt_pk_bf16(sc[j][1][2], sc[j][1][3]); \
                pf[j] = __builtin_bit_cast(bf16x8, pw); } \
            if (__any(alpha[0] != 1.0f || alpha[1] != 1.0f)) {     \
        _Pragma("unroll") \
                for (int j = 0; j < 2; ++j) \
        _Pragma("unroll") \
                    for (int dt = 0; dt < 8; ++dt) o[j][dt] = o[j][dt] * alpha[j]; } \
            const unsigned va0 = Vl + (unsigned)((kc0[0] + 4 * g + (fr >> 2)) * 288 + (fr & 3) * 8), va1 = Vl + (unsigned)((kc0[1] + 4 * g + (fr >> 2)) * 288 + (fr & 3) * 8); \
            { s16x4 lo0[4], hi0[4], lo1[4], hi1[4]; \
              NA_TR8(lo0, hi0, va0, 0); NA_TR8(lo1, hi1, va1, 0); \
              asm volatile("s_waitcnt lgkmcnt(0)" ::: "memory"); __builtin_amdgcn_sched_barrier(0); \
        _Pragma("unroll") \
              for (int d4 = 0; d4 < 4; ++d4) { \
                  o[0][d4] = __builtin_amdgcn_mfma_f32_16x16x32_bf16((bf16x8){lo0[d4][0], lo0[d4][1], lo0[d4][2], lo0[d4][3], hi0[d4][0], hi0[d4][1], hi0[d4][2], hi0[d4][3]}, pf[0], o[0][d4], 0, 0, 0); \
                  o[1][d4] = __builtin_amdgcn_mfma_f32_16x16x32_bf16((bf16x8){lo1[d4][0], lo1[d4][1], lo1[d4][2], lo1[d4][3], hi1[d4][0], hi1[d4][1], hi1[d4][2], hi1[d4][3]}, pf[1], o[1][d4], 0, 0, 0); } \
              __builtin_amdgcn_sched_barrier(0); \
              NA_TR8(lo0, hi0, va0, 128); NA_TR8(lo1, hi1, va1, 128); \
              asm volatile("s_waitcnt lgkmcnt(0)" ::: "memory"); __builtin_amdgcn_sched_barrier(0); \
        _Pragma("unroll") \
              for (int d4 = 0; d4 < 4; ++d4) { \
                  o[0][4 + d4] = __builtin_amdgcn_mfma_f32_16x16x32_bf16((bf16x8){lo0[d4][0], lo0[d4][1], lo0[d4][2], lo0[d4][3], hi0[d4][0], hi0[d4][1], hi0[d4][2], hi0[d4][3]}, pf[0], o[0][4 + d4], 0, 0, 0); \
                  o[1][4 + d4] = __builtin_amdgcn_mfma_f32_16x16x32_bf16((bf16x8){lo1[d4][0], lo1[d4][1], lo1[d4][2], lo1[d4][3], hi1[d4][0], hi1[d4][1], hi1[d4][2], hi1[d4][3]}, pf[1], o[1][4 + d4], 0, 0, 0); } } \
        } \
    } while (0)
    unsigned bpk[2][2];
#pragma unroll
    for (int j = 0; j < 2; ++j) { const int kc0_ = j == 0 ? (qp == 0 ? 0 : 24) : (qp == 0 ? 8 : 32), qc_ = 32 * qp + 16 * j + fr, cs_ = min(max(qc_ - 8, 0), 48);
#pragma unroll
        for (int kb = 0; kb < 2; ++kb) { unsigned pk = 0u;
#pragma unroll
            for (int rg = 0; rg < 4; ++rg) { const int kcol = kc0_ + 16 * kb + 4 * g + rg; const bool valid = (kcol >= cs_) && (kcol < cs_ + 16); const int dc = valid ? min(max(kcol - qc_, -15), 15) + 15 : 31; pk |= (unsigned)(4 * dc) << (8 * rg); }
            bpk[j][kb] = pk; } }
    v4u kA0, kA1, vA0, vA1, kB0, kB1, vB0, vB1;
#define NA_LOAD(k0, k1, v0, v1, row) do { const size_t ro_ = (size_t)((row) * 64 + c0i) * 128; k0 = *(const GAS v4u*)(kg + ro_); k1 = *(const GAS v4u*)(kg + ro_ + (size_t)32 * 128); v0 = *(const GAS v4u*)(vg + ro_); v1 = *(const GAS v4u*)(vg + ro_ + (size_t)32 * 128); } while (0)
#define NA_WRITE(k0, k1, v0, v1, b) do { const unsigned bo_ = (unsigned)((b) * NA_KB), bv_ = (unsigned)((b) * NA_VB); *(LAS v4u*)(F.lds + kl0 + bo_) = k0; *(LAS v4u*)(F.lds + kl0 + bo_ + 32 * 272) = k1; *(LAS v4u*)(F.lds + vl0 + bv_) = v0; *(LAS v4u*)(F.lds + vl0 + bv_ + 32 * 288) = v1; } while (0)
    if (F.tid < 480) { const int r_ = F.tid >> 5, c_ = F.tid & 31; *(LAS float*)(F.lds + NA_RPB + 4 * F.tid) = c_ < 31 ? rpb[h * 465 + r_ * 31 + c_] * 1.4426950408889634f : -1e30f; }
    NA_LOAD(kA0, kA1, vA0, vA1, kr_lo);
    if (nkr > 1) NA_LOAD(kB0, kB1, vB0, vB1, kr_lo + 1);
    NA_WRITE(kA0, kA1, vA0, vA1, 0);
    __syncthreads();
#define NA_STEP(S, BUF, LK0, LK1, LV0, LV1, WK0, WK1, WV0, WV1) do { \
        const int s = (S); const int kr = kr_lo + s; constexpr int buf = (BUF); \
        if (s + 2 < nkr) NA_LOAD(LK0, LK1, LV0, LV1, kr + 2); \
        NA_COMPUTE(); \
        if (s + 1 < nkr) NA_WRITE(WK0, WK1, WV0, WV1, buf ^ 1); \
        asm volatile("s_waitcnt lgkmcnt(0)" ::: "memory"); __builtin_amdgcn_s_barrier(); asm volatile("" ::: "memory"); } while (0)
#pragma unroll 1
    for (int s2 = 0; s2 < nkr; s2 += 2) {
        NA_STEP(s2, 0, kA0, kA1, vA0, vA1, kB0, kB1, vB0, vB1);
        if (s2 + 1 < nkr) NA_STEP(s2 + 1, 1, kB0, kB1, vB0, vB1, kA0, kA1, vA0, vA1);
    }
#undef NA_STEP
#undef NA_LOAD
#undef NA_WRITE
#undef NA_COMPUTE
#undef NA_TR8
#pragma unroll
    for (int j = 0; j < 2; ++j) { float l = lrun[j]; l += shx(l, 16, F.lane); l += shx(l, 32, F.lane); const float inv = 1.0f / l;
        const int tq = bl * SEQ + rq * 64 + 16 * (2 * qp + j) + fr;
#pragma unroll
        for (int dt = 0; dt < 8; ++dt) { v2u w; w.x = pg8::cvt_pk_bf16(o[j][dt][0] * inv, o[j][dt][1] * inv); w.y = pg8::cvt_pk_bf16(o[j][dt][2] * inv, o[j][dt][3] * inv);
            *(GAS v2u*)(out + ((size_t)(bl * 16 + h) * SEQ + (tq - bl * SEQ)) * 128 + 16 * dt + 4 * g) = w; } }
}

__device__ __forceinline__ void rp_unit(Frame& F, const bf16* Qr, const bf16* Kr, bf16* Pf, bf16* Pb, const float* dtl  , int u) {
    const int bl = u >> 9, h = (u >> 6) & 7, c = u & 63, fr = F.lane & 15, g = F.lane >> 4;
    const int t0 = bl * SEQ + c * 128, il = 16 * F.wave + fr;
    const float lgf = dtl[(0 * 8 + h) * DT_STRIDE] * 1.4426950408889634f, lgb = dtl[(1 * 8 + h) * DT_STRIDE] * 1.4426950408889634f;
    bf16x8 qf[8];
#pragma unroll
    for (int ks = 0; ks < 8; ++ks) qf[ks] = *(const GAS bf16x8*)((const char*)Qr + qk_frag(bl, h, c * 8 + F.wave, ks) + F.lane * 16);
#pragma unroll 4
    for (int jt = 0; jt < 8; ++jt) {
        f32x4 a = (f32x4){0.f, 0.f, 0.f, 0.f};
#pragma unroll
        for (int ks = 0; ks < 8; ++ks) { const bf16x8 kf = *(const GAS bf16x8*)((const char*)Kr + qk_frag(bl, h, c * 8 + jt, ks) + F.lane * 16); a = __builtin_amdgcn_mfma_f32_16x16x32_bf16(kf, qf[ks], a, 0, 0, 0); }
        float pf[4], pb[4];
#pragma unroll
        for (int rg = 0; rg < 4; ++rg) { const int j = 16 * jt + 4 * g + rg, diff = il - j;
            const float dec = __builtin_amdgcn_exp2f(diff >= 0 ? (float)diff * lgf : (float)(-diff) * lgb) * a[rg];
            pf[rg] = diff >= 0 ? dec : 0.f; pb[rg] = diff < 0 ? dec : 0.f; }
        const size_t po = p_frag(u, F.wave, jt >> 1) + (size_t)((fr + 16 * (2 * (jt & 1) + (g >> 1))) * 16 + 8 * (g & 1));
        v2u w; w.x = pg8::cvt_pk_bf16(pf[0], pf[1]); w.y = pg8::cvt_pk_bf16(pf[2], pf[3]); *(GAS v2u*)((char*)Pf + po) = w;
        w.x = pg8::cvt_pk_bf16(pb[0], pb[1]); w.y = pg8::cvt_pk_bf16(pb[2], pb[3]); *(GAS v2u*)((char*)Pb + po) = w;
    }
}

__device__ __forceinline__ void rp_wg(Frame& F, const bf16* Qr, const bf16* Kr, bf16* Pf, bf16* Pb, const float* dtl  , int u0) {
    const int bl = u0 >> 9, h = (u0 >> 6) & 7, c0 = u0 & 63, fr = F.lane & 15, g = F.lane >> 4;
    const int il = 16 * F.wave + fr;
    const float lgf = dtl[(0 * 8 + h) * DT_STRIDE] * 1.4426950408889634f, lgb = dtl[(1 * 8 + h) * DT_STRIDE] * 1.4426950408889634f;
    const char* kbase = (const char*)Kr + qk_frag(bl, h, c0 * 8, 0) + (size_t)(F.wave * 8) * 1024 + (size_t)F.lane * 16;
    const char* qbase = (const char*)Qr + qk_frag(bl, h, c0 * 8 + F.wave, 0) + (size_t)F.lane * 16;
#define RP_DMA(k, buf) do { _Pragma("unroll") for (int ks_ = 0; ks_ < 8; ++ks_) \
        __builtin_amdgcn_global_load_lds((const unsigned*)(kbase + (size_t)(k) * 65536 + (size_t)ks_ * 1024), (LAS unsigned*)(F.lds + (buf) * 65536 + (F.wave * 8 + ks_) * 1024), 16, 0, 0); } while (0)
    bf16x8 qf[8], qn[8];
    RP_DMA(0, 0);
#pragma unroll
    for (int ks = 0; ks < 8; ++ks) qf[ks] = *(const GAS bf16x8*)(qbase + (size_t)ks * 1024);
#pragma unroll 1
    for (int k = 0; k < 4; ++k) {
        asm volatile("s_waitcnt vmcnt(0)" ::: "memory");
        __syncthreads();
        if (k + 1 < 4) { RP_DMA(k + 1, (k + 1) & 1);
#pragma unroll
            for (int ks = 0; ks < 8; ++ks) qn[ks] = *(const GAS bf16x8*)(qbase + (size_t)(k + 1) * 65536 + (size_t)ks * 1024); }
        const LAS unsigned char* KB = F.lds + (k & 1) * 65536 + F.lane * 16;
        const int u = u0 + k;
#pragma unroll 4
        for (int jt = 0; jt < 8; ++jt) {
            f32x4 a = (f32x4){0.f, 0.f, 0.f, 0.f};
#pragma unroll
            for (int ks = 0; ks < 8; ++ks) { const bf16x8 kf = *(const LAS bf16x8*)(KB + (jt * 8 + ks) * 1024); a = __builtin_amdgcn_mfma_f32_16x16x32_bf16(kf, qf[ks], a, 0, 0, 0); }
            float pf[4], pb[4];
#pragma unroll
            for (int rg = 0; rg < 4; ++rg) { const int j = 16 * jt + 4 * g + rg, diff = il - j;
                const float dec = __builtin_amdgcn_exp2f(diff >= 0 ? (float)diff * lgf : (float)(-diff) * lgb) * a[rg];
                pf[rg] = diff >= 0 ? dec : 0.f; pb[rg] = diff < 0 ? dec : 0.f; }
            const size_t po = p_frag(u, F.wave, jt >> 1) + (size_t)((fr + 16 * (2 * (jt & 1) + (g >> 1))) * 16 + 8 * (g & 1));
            v2u w; w.x = pg8::cvt_pk_bf16(pf[0], pf[1]); w.y = pg8::cvt_pk_bf16(pf[2], pf[3]); *(GAS v2u*)((char*)Pf + po) = w;
            w.x = pg8::cvt_pk_bf16(pb[0], pb[1]); w.y = pg8::cvt_pk_bf16(pb[2], pb[3]); *(GAS v2u*)((char*)Pb + po) = w;
        }
#pragma unroll
        for (int ks = 0; ks < 8; ++ks) qf[ks] = qn[ks];
    }
#undef RP_DMA
    asm volatile("s_waitcnt vmcnt(0)" ::: "memory");
    __syncthreads();
}

struct RsFr { bf16x8 qf[8]; };
__device__ __forceinline__ void rs_load(RsFr& f, const bf16* Qr, int bl, int h, int c, int il, int g) {
#pragma unroll
    for (int ks = 0; ks < 8; ++ks) f.qf[ks] = *(const GAS bf16x8*)((const char*)Qr + qk_frag(bl, h, c * 8 + (il >> 4), ks) + (size_t)(((il & 15) + 16 * g) * 16));
}
__device__ __forceinline__ void rs_dma_kz(LAS unsigned char* dst  , LAS unsigned char* dstp, const bf16* KzT, const bf16* P, int il, int bl, int h, int c, int wave, int fr, int g, int klo, int khi) {
    const int unit = (bl * 8 + h) * 64 + c;
#pragma unroll
    for (int ks = 0; ks < 4; ++ks)
        if (ks >= klo && ks <= khi)
        __builtin_amdgcn_global_load_lds((const unsigned*)((const char*)P + p_frag(unit, il >> 4, ks) + (size_t)(((il & 15) + 16 * g) * 16)), (LAS unsigned*)(dstp + ks * 1024), 16, 0, 0);
#pragma unroll
    for (int dd = 0; dd < 2; ++dd)
#pragma unroll
        for (int ks = 0; ks < 4; ++ks)
            __builtin_amdgcn_global_load_lds((const unsigned*)((const char*)KzT + kz_frag(bl, h, c, 2 * wave + dd, ks) + (size_t)((fr + 16 * g) * 16)), (LAS unsigned*)(dst + (dd * 4 + ks) * 1024), 16, 0, 0);
}
__device__ __forceinline__ void rs_job(Frame& F, const bf16* Qr, const bf16* KzT, const bf16* VrT, const bf16* P, bf16* O, const float* dte  , int bl, int h, int dir, int vs, unsigned* lock) {
    const int fr = F.lane & 15, g = F.lane >> 4, il = 16 * F.wave + fr;
    LAS unsigned char* KZ = F.lds + 55296 + F.wave * 8192;
    LAS unsigned char* PZ = F.lds + 120832 + F.wave * 4096;
    const float gC = dte[1]; const float xi = dte[128 + il];
    f32x4 accS[4][2];
#pragma unroll
    for (int vt = 0; vt < 4; ++vt)
#pragma unroll
        for (int dd = 0; dd < 2; ++dd) accS[vt][dd] = (f32x4){0.f, 0.f, 0.f, 0.f};
    for (int i = F.tid; i < 36864 / 4; i += NWAVES * 64) ((LAS unsigned*)F.lds)[i] = 0u;
    const int trow = F.tid >> 2, tpart = F.tid & 3;
    const bf16* vsrc = VrT + ((size_t)(bl * 16 + h * 2 + (vs >> 1)) * SEQ + trow) * 128 + (vs & 1) * 64 + tpart * 16;
    LAS unsigned char* vtw = F.lds + 36864 + trow * 144 + tpart * 32;
    const int c0 = dir == 0 ? 0 : 63, cstep = dir == 0 ? 1 : -1;
    const int klo = dir == 0 ? 0 : (F.wave >> 1), khi = dir == 0 ? (F.wave >> 1) : 3;
    v4u vr0 = *(const GAS v4u*)(vsrc + (size_t)c0 * 16384), vr1 = *(const GAS v4u*)(vsrc + (size_t)c0 * 16384 + 8);
    RsFr fa, fb; v2u ow[4]; bf16* opend = nullptr;
    rs_load(fa, Qr, bl, h, c0, il, g);
    rs_dma_kz(KZ, PZ, KzT, P, il, bl, h, c0, F.wave, fr, g, klo, khi);
#ifdef RS_SYNC4
#define RS_LOCKSTEP(stepi) do { if (F.tid == 0) { __hip_atomic_fetch_add(lock, 1u, __ATOMIC_RELAXED, __HIP_MEMORY_SCOPE_AGENT); const unsigned want = 4u * (unsigned)((stepi) + 1); unsigned sp = 0; \
        while (__hip_atomic_load(lock, __ATOMIC_RELAXED, __HIP_MEMORY_SCOPE_AGENT) < want && ++sp < 20000u) __builtin_amdgcn_s_sleep(1); } __builtin_amdgcn_s_barrier(); } while (0)
#else
#define RS_LOCKSTEP(stepi) do { } while (0)
#endif
#ifdef RS_DUP_DMA
#define RS_EXTRA_DMA rs_dma_kz(KZ, PZ, KzT, P, il, bl, h, c + cstep, F.wave, fr, g, klo, khi)
#else
#define RS_EXTRA_DMA do { } while (0)
#endif
#define RS_LDS4(dst, base, stride, ks) do { _Pragma("unroll") for (int vt_ = 0; vt_ < 4; ++vt_) dst[vt_] = *(const LAS bf16x8*)((base) + (16 * vt_ + fr) * (stride) + 32 * (ks) + 8 * g); } while (0)
#define RS_CAT(l, h) ((bf16x8){l[0], l[1], l[2], l[3], h[0], h[1], h[2], h[3]})
#define RS_TR(base, off) __builtin_amdgcn_ds_read_tr16_b64_v4i16((LAS s16x4*)(F.lds + (base) + (off)))
#define RS_LDV1(L, H, ks, vt) do { L[vt] = RS_TR(vta, 36864 + (ks) * 4608 + (vt) * 32); H[vt] = RS_TR(vta, 36864 + (ks) * 4608 + (vt) * 32 + 576); } while (0)
#define RS_LDS1(L, H, ks, vt) do { L[vt] = RS_TR(vta, (ks) * 4608 + (vt) * 32); H[vt] = RS_TR(vta, (ks) * 4608 + (vt) * 32 + 576); } while (0)
#define RS_LDS(L, H, ks) do { RS_LDS1(L, H, ks, 0); RS_LDS1(L, H, ks, 1); RS_LDS1(L, H, ks, 2); RS_LDS1(L, H, ks, 3); } while (0)
#define RS_LDV(L, H, ks) do { RS_LDV1(L, H, ks, 0); RS_LDV1(L, H, ks, 1); RS_LDV1(L, H, ks, 2); RS_LDV1(L, H, ks, 3); } while (0)
#define RS_LDKZ(dd, ks) do { kzl[dd][ks] = RS_TR(kza, ((dd) * 4 + (ks)) * 1024); kzh[dd][ks] = RS_TR(kza, ((dd) * 4 + (ks)) * 1024 + 128); } while (0)
#define RS_MMA12(L, H, ks) do { if ((ks) >= klo && (ks) <= khi) { _Pragma("unroll") for (int vt_ = 0; vt_ < 4; ++vt_) accO[vt_] = __builtin_amdgcn_mfma_f32_16x16x32_bf16(RS_CAT(L[vt_], H[vt_]), cur_pf[ks], accO[vt_], 0, 0, 0); } \
        _Pragma("unroll") for (int vt_ = 0; vt_ < 4; ++vt_) { const bf16x8 vf_ = RS_CAT(L[vt_], H[vt_]); \
        accS[vt_][0] = __builtin_amdgcn_mfma_f32_16x16x32_bf16(vf_, RS_CAT(kzl[0][ks], kzh[0][ks]), accS[vt_][0], 0, 0, 0); accS[vt_][1] = __builtin_amdgcn_mfma_f32_16x16x32_bf16(vf_, RS_CAT(kzl[1][ks], kzh[1][ks]), accS[vt_][1], 0, 0, 0); } } while (0)
#define RS_STEP(CUR, NXT, cexpr, hasnext, stepi) do { const int c = (cexpr); const int t0 = bl * SEQ + c * 128; \
        *(LAS v4u*)vtw = vr0; *(LAS v4u*)(vtw + 16) = vr1; \
        asm volatile("s_waitcnt vmcnt(0)" ::: "memory"); \
        __syncthreads(); \
        bf16x8 cur_pf[4]; s16x4 kzl[2][4], kzh[2][4]; \
        unsigned kza, vta; { int ln_ = F.lane; asm volatile("" : "+v"(ln_)); const int row_ = ((ln_ >> 4) << 3) | ((ln_ >> 2) & 3);     \
            kza = (unsigned)(55296 + F.wave * 8192 + row_ * 32 + (ln_ & 3) * 8); vta = (unsigned)(row_ * 144 + (ln_ & 3) * 8); } \
        _Pragma("unroll") for (int ks = 0; ks < 4; ++ks) cur_pf[ks] = *(const LAS bf16x8*)(PZ + ks * 1024 + F.lane * 16); \
        RS_LDKZ(0, 0); RS_LDKZ(0, 1); RS_LDKZ(0, 2); RS_LDKZ(0, 3); RS_LDKZ(1, 0); RS_LDKZ(1, 1); RS_LDKZ(1, 2); RS_LDKZ(1, 3); \
        asm volatile("s_waitcnt lgkmcnt(0)" ::: "memory"); __builtin_amdgcn_sched_barrier(0); \
        RS_LOCKSTEP(stepi); \
        if (hasnext) { const int cn = c + cstep; vr0 = *(const GAS v4u*)(vsrc + (size_t)cn * 16384); vr1 = *(const GAS v4u*)(vsrc + (size_t)cn * 16384 + 8); rs_load(NXT, Qr, bl, h, cn, il, g); }     \
        if (opend) { _Pragma("unroll") for (int vt = 0; vt < 4; ++vt) *(GAS v2u*)(opend + 16 * vt) = ow[vt]; }     \
        f32x4 accO[4]; s16x4 aL[4], aH[4], bL[4], bH[4]; \
        _Pragma("unroll") for (int vt = 0; vt < 4; ++vt) accO[vt] = (f32x4){0.f, 0.f, 0.f, 0.f}; \
        RS_LDS(aL, aH, 0); \
        _Pragma("unroll") for (int k2 = 0; k2 < 4; ++k2) { \
            RS_LDS(bL, bH, 2 * k2 + 1); asm volatile("s_waitcnt lgkmcnt(8)" ::: "memory"); __builtin_amdgcn_sched_barrier(0); \
            _Pragma("unroll") for (int vt = 0; vt < 4; ++vt) accO[vt] = __builtin_amdgcn_mfma_f32_16x16x32_bf16(RS_CAT(aL[vt], aH[vt]), CUR.qf[2 * k2], accO[vt], 0, 0, 0); \
            __builtin_amdgcn_sched_barrier(0); \
            if (k2 < 3) { RS_LDS(aL, aH, 2 * k2 + 2); asm volatile("s_waitcnt lgkmcnt(8)" ::: "memory"); } else { RS_LDV(aL, aH, 0); asm volatile("s_waitcnt lgkmcnt(8)" ::: "memory"); } \
            __builtin_amdgcn_sched_barrier(0); \
            _Pragma("unroll") for (int vt = 0; vt < 4; ++vt) accO[vt] = __builtin_amdgcn_mfma_f32_16x16x32_bf16(RS_CAT(bL[vt], bH[vt]), CUR.qf[2 * k2 + 1], accO[vt], 0, 0, 0); \
            __builtin_amdgcn_sched_barrier(0); } \
        if (hasnext) { rs_dma_kz(KZ, PZ, KzT, P, il, bl, h, c + cstep, F.wave, fr, g, klo, khi); RS_EXTRA_DMA; }     \
        __builtin_amdgcn_sched_barrier(0); \
        _Pragma("unroll") for (int vt = 0; vt < 4; ++vt) accO[vt] = accO[vt] * xi; \
        _Pragma("unroll") for (int vt = 0; vt < 4; ++vt) _Pragma("unroll") for (int dd = 0; dd < 2; ++dd) accS[vt][dd] = accS[vt][dd] * gC; \
          \
        RS_LDV(bL, bH, 1); asm volatile("s_waitcnt lgkmcnt(8)" ::: "memory"); __builtin_amdgcn_sched_barrier(0); \
        RS_MMA12(aL, aH, 0); __builtin_amdgcn_sched_barrier(0); \
        RS_LDV(aL, aH, 2); asm volatile("s_waitcnt lgkmcnt(8)" ::: "memory"); __builtin_amdgcn_sched_barrier(0); \
        RS_MMA12(bL, bH, 1); __builtin_amdgcn_sched_barrier(0); \
        RS_LDV(bL, bH, 3); asm volatile("s_waitcnt lgkmcnt(8)" ::: "memory"); __builtin_amdgcn_sched_barrier(0); \
        RS_MMA12(aL, aH, 2); __builtin_amdgcn_sched_barrier(0); \
        asm volatile("s_waitcnt lgkmcnt(0)" ::: "memory"); __builtin_amdgcn_sched_barrier(0); \
        RS_MMA12(bL, bH, 3); __builtin_amdgcn_sched_barrier(0); \
        _Pragma("unroll") for (int vt = 0; vt < 4; ++vt) { ow[vt].x = pg8::cvt_pk_bf16(accO[vt][0], accO[vt][1]); ow[vt].y = pg8::cvt_pk_bf16(accO[vt][2], accO[vt][3]); } \
        opend = O + (size_t)(t0 + il) * D + h * 256 + vs * 64 + 4 * g; \
        asm volatile("s_waitcnt lgkmcnt(0)" ::: "memory"); __builtin_amdgcn_s_barrier(); asm volatile("" ::: "memory");     \
        _Pragma("unroll") for (int vt = 0; vt < 4; ++vt) _Pragma("unroll") for (int dd = 0; dd < 2; ++dd) { v2u w_; w_.x = pg8::cvt_pk_bf16(accS[vt][dd][0], accS[vt][dd][1]); w_.y = pg8::cvt_pk_bf16(accS[vt][dd][2], accS[vt][dd][3]); \
            *(LAS v2u*)(F.lds + (16 * (2 * F.wave + dd) + fr) * 144 + (16 * vt + 4 * g) * 2) = w_; }     \
    } while (0)
#pragma unroll 1
    for (int step = 0; step < 64; step += 2) {
        RS_STEP(fa, fb, c0 + cstep * step, true, step);
        RS_STEP(fb, fa, c0 + cstep * (step + 1), (step + 2 < 64), step + 1);
    }
#undef RS_STEP
#undef RS_LDS4
#undef RS_LDS
#undef RS_LDS1
#undef RS_MMA12
#undef RS_LDV
#undef RS_LDV1
#undef RS_LDKZ
#undef RS_TR
#undef RS_CAT
#pragma unroll
    for (int vt = 0; vt < 4; ++vt) *(GAS v2u*)(opend + 16 * vt) = ow[vt];
    asm volatile("s_waitcnt vmcnt(0)" ::: "memory");
    __syncthreads();
}

__device__ __forceinline__ void rn_phase(Frame& F, bf16* Of, const bf16* Ob, const float* gn) {
    const int gw = F.vcu * NWAVES + F.wave, NGW = F.G * NWAVES;
    for (int m = gw; m < HT; m += NGW) {
#pragma unroll
        for (int j = 0; j < 4; ++j) {
            const int col = j * 512 + F.lane * 8;
            const v4u a = *(const GAS v4u*)(Of + (size_t)m * D + col), b = *(const GAS v4u*)(Ob + (size_t)m * D + col);
            float x[8]; x[0] = bflo(a.x) + bflo(b.x); x[1] = bfhi(a.x) + bfhi(b.x); x[2] = bflo(a.y) + bflo(b.y); x[3] = bfhi(a.y) + bfhi(b.y);
            x[4] = bflo(a.z) + bflo(b.z); x[5] = bfhi(a.z) + bfhi(b.z); x[6] = bflo(a.w) + bflo(b.w); x[7] = bfhi(a.w) + bfhi(b.w);
            float s = 0.f;
#pragma unroll
            for (int i = 0; i < 8; ++i) s += x[i];
#pragma unroll
            for (int o = 1; o < 32; o <<= 1) s += shx(s, o, F.lane);
            const float mu = s * (1.0f / 256.0f); float q = 0.f;
#pragma unroll
            for (int i = 0; i < 8; ++i) { x[i] -= mu; q += x[i] * x[i]; }
#pragma unroll
            for (int o = 1; o < 32; o <<= 1) q += shx(q, o, F.lane);
            const float rstd = 1.0f / sqrtf(q * (1.0f / 256.0f) + EPS);
            const f32x4 g0 = *(const GAS f32x4*)(gn + col), g1 = *(const GAS f32x4*)(gn + col + 4);
            v4u o; o.x = pg8::cvt_pk_bf16(x[0] * rstd * g0.x, x[1] * rstd * g0.y); o.y = pg8::cvt_pk_bf16(x[2] * rstd * g0.z, x[3] * rstd * g0.w);
            o.z = pg8::cvt_pk_bf16(x[4] * rstd * g1.x, x[5] * rstd * g1.y); o.w = pg8::cvt_pk_bf16(x[6] * rstd * g1.z, x[7] * rstd * g1.w);
            *(GAS v4u*)(Of + (size_t)m * D + col) = o;
        }
    }
}

__device__ __forceinline__ void rn_tile(Frame& F, bf16* Of, const bf16* Ob, const float* gn, int pm, int head) {
    const int half = F.lane >> 5, l32 = F.lane & 31, col = head * 256 + l32 * 8;
    const f32x4 g0 = *(const GAS f32x4*)(gn + col), g1 = *(const GAS f32x4*)(gn + col + 4);
#pragma unroll 8
    for (int it = 0; it < 16; ++it) {
        const int m = pm * 256 + F.wave * 32 + it * 2 + half;
        const v4u a = *(const GAS v4u*)(Of + (size_t)m * D + col), b = *(const GAS v4u*)(Ob + (size_t)m * D + col);
        float x[8]; x[0] = bflo(a.x) + bflo(b.x); x[1] = bfhi(a.x) + bfhi(b.x); x[2] = bflo(a.y) + bflo(b.y); x[3] = bfhi(a.y) + bfhi(b.y);
        x[4] = bflo(a.z) + bflo(b.z); x[5] = bfhi(a.z) + bfhi(b.z); x[6] = bflo(a.w) + bflo(b.w); x[7] = bfhi(a.w) + bfhi(b.w);
        float s = 0.f;
#pragma unroll
        for (int i = 0; i < 8; ++i) s += x[i];
#pragma unroll
        for (int o = 1; o < 32; o <<= 1) s += shx(s, o, F.lane);
        const float mu = s * (1.0f / 256.0f); float q = 0.f;
#pragma unroll
        for (int i = 0; i < 8; ++i) { x[i] -= mu; q += x[i] * x[i]; }
#pragma unroll
        for (int o = 1; o < 32; o <<= 1) q += shx(q, o, F.lane);
        const float rstd = 1.0f / sqrtf(q * (1.0f / 256.0f) + EPS);
        v4u o; o.x = pg8::cvt_pk_bf16(x[0] * rstd * g0.x, x[1] * rstd * g0.y); o.y = pg8::cvt_pk_bf16(x[2] * rstd * g0.z, x[3] * rstd * g0.w);
        o.z = pg8::cvt_pk_bf16(x[4] * rstd * g1.x, x[5] * rstd * g1.y); o.w = pg8::cvt_pk_bf16(x[6] * rstd * g1.z, x[7] * rstd * g1.w);
        *(GAS v4u*)(Of + (size_t)m * D + col) = o;
    }
}
struct LinSched {
    pg8::DenseOrder o; unsigned row0; const char* Bt; size_t tstep;
    __device__ __forceinline__ void init(int M, int N, int K, int G, int c, unsigned row0_, const bf16* Bt_) { o.init(M, N, G, c); row0 = row0_; Bt = (const char*)Bt_; tstep = (size_t)256 * K * 2; }
    __device__ __forceinline__ bool next(int i, pg8::Unit& u) const { u.e = 0; return o.next_mn(i, u.pm, u.pn); }
    static constexpr bool GATHER = false;
    __device__ __forceinline__ unsigned a_row(const pg8::Unit& u, int r) const { return 0u; }
    __device__ __forceinline__ size_t a_off(const pg8::Unit& u, unsigned rowb) const { return (size_t)(row0 + (unsigned)u.pm * 256u) * rowb; }
    __device__ __forceinline__ const char* b_base(const pg8::Unit& u) const { return Bt + (size_t)u.pn * tstep; }
};
#ifndef SHADOW_N
#define SHADOW_N 2
#endif
struct ShadowSched {
    int pm, pn0; unsigned row0; const char* Bt; size_t tstep;
    static constexpr bool GATHER = false;
    __device__ __forceinline__ bool next(int i, pg8::Unit& u) const { if (i >= SHADOW_N) return false; u.pm = pm; u.pn = pn0 + i; u.e = 0; return true; }
    __device__ __forceinline__ unsigned a_row(const pg8::Unit& u, int r) const { return 0u; }
    __device__ __forceinline__ size_t a_off(const pg8::Unit& u, unsigned rowb) const { return (size_t)(row0 + (unsigned)u.pm * 256u) * rowb; }
    __device__ __forceinline__ const char* b_base(const pg8::Unit& u) const { return Bt + (size_t)u.pn * tstep; }
};
struct PPSched {
    int u0; const char* Bt; size_t tstep;
    static constexpr bool GATHER = false;
    __device__ __forceinline__ bool next(int i, pg8::Unit& u) const { if (i >= 4) return false; const int L = u0 + i; u.pm = L >> 3; u.pn = L & 7; u.e = 0; return true; }
    __device__ __forceinline__ unsigned a_row(const pg8::Unit& u, int r) const { return 0u; }
    __device__ __forceinline__ size_t a_off(const pg8::Unit& u, unsigned rowb) const { return (size_t)((unsigned)u.pm * 256u) * rowb; }
    __device__ __forceinline__ const char* b_base(const pg8::Unit& u) const { return Bt + (size_t)u.pn * tstep; }
};
struct GatesSched {
    pg8::DenseOrder o; int G, c; unsigned row0; const char* Bt; size_t tstep;
    static constexpr bool GATHER = false;
    __device__ __forceinline__ bool next(int i, pg8::Unit& u) const {
        const int L = i * G + c; constexpr int REST = 4 - SHADOW_N;
        if (L < 512) { u.e = 0; return o.next_mn(i, u.pm, u.pn); }
        const int idx = L - 512; if (idx >= 64 * 2 * REST) return false;
        u.e = 1; u.pm = idx / (2 * REST); const int q = idx % (2 * REST); u.pn = 4 * (q / REST) + SHADOW_N + (q % REST); return true;
    }
    __device__ __forceinline__ unsigned a_row(const pg8::Unit& u, int r) const { return 0u; }
    __device__ __forceinline__ size_t a_off(const pg8::Unit& u, unsigned rowb) const { return (size_t)(row0 + (unsigned)u.pm * 256u) * rowb; }
    __device__ __forceinline__ const char* b_base(const pg8::Unit& u) const { return Bt + (size_t)(u.e * 8 + u.pn) * tstep; }
};
template <bool GATHER_>
struct MoeSched {
    const volatile LAS int* ts; int ncol, G, c; const int* ltok; const char* Bt; size_t estep, tstep;
    __device__ __forceinline__ bool next(int i, pg8::Unit& u) const {
        const int L = i * G + c; const int total = ts[32] * ncol; if (L >= total) return false;
        const int tile = L / ncol; u.pm = tile; u.pn = L % ncol; int e = 0;
        e = (int)((const volatile LAS unsigned char*)(ts + 48))[tile];
        u.e = e; return true;
    }
    static constexpr bool GATHER = GATHER_;
    __device__ __forceinline__ unsigned a_row(const pg8::Unit& u, int r) const { return (unsigned)ltok[u.pm * 256 + r]; }
    __device__ __forceinline__ size_t a_off(const pg8::Unit& u, unsigned rowb) const { return GATHER_ ? (size_t)0 : (size_t)((unsigned)u.pm * 256u) * rowb; }
    __device__ __forceinline__ const char* b_base(const pg8::Unit& u) const { return Bt + (size_t)u.e * estep + (size_t)u.pn * tstep; }
};

using pg8::Unit; using pg8::cvt_pk_bf16;
typedef const f32x4 (&AccRef)[2][2][4][2];

struct EpiProj {
    static constexpr bool PERM = true;
    unsigned char* ws; const float* rs; const float* dtl;
    __device__ __forceinline__ void operator()(AccRef acc, const Unit& u, int wr, int wc, int fr, int fq) const {
        const int type = u.pn >> 3, hh = u.pn & 7, c0 = wc * 32 + 8 * fq;
        bf16 *Qn = (bf16*)(ws + WS_QN), *Kn = (bf16*)(ws + WS_KN), *VnT = (bf16*)(ws + WS_VNT), *Qr = (bf16*)(ws + WS_QR), *Kr = (bf16*)(ws + WS_KR), *KzTf = (bf16*)(ws + WS_KZF), *KzTb = (bf16*)(ws + WS_KZB), *VrT = (bf16*)(ws + WS_VRT);
        const float* cosT = (const float*)(ws + WS_ROPE); const float* sinT = cosT + SEQ * 128;
        if (type <= 2 || type == 5) {
#pragma unroll
            for (int ai = 0; ai < 2; ++ai)
#pragma unroll
                for (int m = 0; m < 4; ++m) {
                    const int r = u.pm * 256 + ai * 128 + wr * 64 + m * 16 + fr; const int bl = r >> 13, s = r & (SEQ - 1);
                    bf16* dst = (type == 0 ? Qn : (type == 1 ? Kn : (type == 2 ? VnT : VrT))) + ((size_t)(bl * 16 + hh * 2) * SEQ + s) * 128 + c0;
#pragma unroll
                    for (int bj = 0; bj < 2; ++bj) { const f32x4 v0 = acc[ai][bj][m][0], v1 = acc[ai][bj][m][1]; v4u w; w.x = cvt_pk_bf16(v0[0], v0[1]); w.y = cvt_pk_bf16(v0[2], v0[3]); w.z = cvt_pk_bf16(v1[0], v1[1]); w.w = cvt_pk_bf16(v1[2], v1[3]);
                        *(GAS v4u*)(dst + (size_t)bj * SEQ * 128) = w; }
                }
        } else {
#pragma unroll
            for (int ai = 0; ai < 2; ++ai)
#pragma unroll
                for (int mp = 0; mp < 2; ++mp) {
                    f32x4 cs[2][2], sn[2][2]; float zf[2] = {0.f, 0.f}, zb[2] = {0.f, 0.f};
#pragma unroll
                    for (int mi = 0; mi < 2; ++mi) { const int s = (u.pm * 256 + ai * 128 + wr * 64 + (2 * mp + mi) * 16 + fr) & (SEQ - 1);
#pragma unroll
                        for (int n = 0; n < 2; ++n) { cs[mi][n] = *(const GAS f32x4*)(cosT + (size_t)s * 128 + c0 + 4 * n); sn[mi][n] = *(const GAS f32x4*)(sinT + (size_t)s * 128 + c0 + 4 * n); }
                        if (type == 4) { zf[mi] = dtl[(0 * 8 + hh) * DT_STRIDE + 256 + (s & 127)]; zb[mi] = dtl[(1 * 8 + hh) * DT_STRIDE + 256 + (s & 127)]; } }
                    asm volatile("" ::: "memory");
#pragma unroll
                    for (int mi = 0; mi < 2; ++mi) { const int m = 2 * mp + mi; const int r = u.pm * 256 + ai * 128 + wr * 64 + m * 16 + fr; const int bl = r >> 13, s = r & (SEQ - 1);
                        char* dst = (char*)(type == 3 ? Qr : Kr) + qk_frag(bl, hh, s >> 4, wc) + (size_t)(((s & 15) + 16 * fq) * 16);
                        const int jj = s & 127; const size_t zo = kz_frag(bl, hh, s >> 7, 2 * wc + (fq >> 1), jj >> 5) + (size_t)((jj & 31) * 32 + 16 * (fq & 1));
#pragma unroll
                        for (int n = 0; n < 2; ++n) { const f32x4 c4 = cs[mi][n], s4 = sn[mi][n];
                            float o1[4], o2[4];
#pragma unroll
                            for (int e = 0; e < 4; ++e) { const float x1 = acc[ai][0][m][n][e], x2 = acc[ai][1][m][n][e]; o1[e] = x1 * c4[e] - x2 * s4[e]; o2[e] = x1 * s4[e] + x2 * c4[e]; }
                            v2u w; w.x = cvt_pk_bf16(o1[0], o1[1]); w.y = cvt_pk_bf16(o1[2], o1[3]); *(GAS v2u*)(dst + 8 * n) = w;
                            w.x = cvt_pk_bf16(o2[0], o2[1]); w.y = cvt_pk_bf16(o2[2], o2[3]); *(GAS v2u*)(dst + 4 * 1024 + 8 * n) = w;
                            if (type == 4) { char* df = (char*)KzTf + zo + 8 * n; char* db = (char*)KzTb + zo + 8 * n; const float zf_ = zf[mi], zb_ = zb[mi];
                                w.x = cvt_pk_bf16(o1[0] * zf_, o1[1] * zf_); w.y = cvt_pk_bf16(o1[2] * zf_, o1[3] * zf_); *(GAS v2u*)df = w;
                                w.x = cvt_pk_bf16(o2[0] * zf_, o2[1] * zf_); w.y = cvt_pk_bf16(o2[2] * zf_, o2[3] * zf_); *(GAS v2u*)(df + 8 * 4096) = w;
                                w.x = cvt_pk_bf16(o1[0] * zb_, o1[1] * zb_); w.y = cvt_pk_bf16(o1[2] * zb_, o1[3] * zb_); *(GAS v2u*)db = w;
                                w.x = cvt_pk_bf16(o2[0] * zb_, o2[1] * zb_); w.y = cvt_pk_bf16(o2[2] * zb_, o2[3] * zb_); *(GAS v2u*)(db + 8 * 4096) = w; }
                        } }
                    asm volatile("" ::: "memory"); }
        }
    }
};
struct EpiGates;
struct EpiGateNa {
    static constexpr bool PERM = true;
    const bf16* na; bf16* mix; const float* rs;
    __device__ __forceinline__ void operator()(AccRef acc, const Unit& u, int wr, int wc, int fr, int fq) const {
        const int cg = u.pn * 256 + wc * 32 + 8 * fq;
#pragma unroll
        for (int ai = 0; ai < 2; ++ai) {
            v4u in[4][2];
#pragma unroll
            for (int m = 0; m < 4; ++m) { const int r = u.pm * 256 + ai * 128 + wr * 64 + m * 16 + fr;
#pragma unroll
                for (int bj = 0; bj < 2; ++bj) in[m][bj] = *(const GAS v4u*)(na + ((size_t)((r >> 13) * 16 + u.pn * 2 + bj) * SEQ + (r & (SEQ - 1))) * 128 + wc * 32 + 8 * fq); }
            asm volatile("" ::: "memory");
#pragma unroll
            for (int m = 0; m < 4; ++m) { const int r = u.pm * 256 + ai * 128 + wr * 64 + m * 16 + fr;
#pragma unroll
                for (int bj = 0; bj < 2; ++bj) { const size_t off = (size_t)r * D + cg + bj * 128; const v4u i4 = in[m][bj];
                    const f32x4 v0 = acc[ai][bj][m][0], v1 = acc[ai][bj][m][1]; float o[8];
                    const float x[8] = {bflo(i4.x), bfhi(i4.x), bflo(i4.y), bfhi(i4.y), bflo(i4.z), bfhi(i4.z), bflo(i4.w), bfhi(i4.w)};
#pragma unroll
                    for (int e = 0; e < 4; ++e) { o[e] = x[e] * sigmoidf_(v0[e]); o[4 + e] = x[4 + e] * sigmoidf_(v1[e]); }
                    v4u w; w.x = cvt_pk_bf16(o[0], o[1]); w.y = cvt_pk_bf16(o[2], o[3]); w.z = cvt_pk_bf16(o[4], o[5]); w.w = cvt_pk_bf16(o[6], o[7]);
                    *(GAS v4u*)(mix + off) = w; } }
            asm volatile("" ::: "memory"); }
    }
};
struct EpiRg {
    static constexpr bool PERM = true;
    bf16* retn; const float* rs;
    __device__ __forceinline__ void operator()(AccRef acc, const Unit& u, int wr, int wc, int fr, int fq) const {
        const int cg = u.pn * 256 + wc * 32 + 8 * fq;
#pragma unroll
        for (int ai = 0; ai < 2; ++ai)
#pragma unroll
            for (int m = 0; m < 4; ++m) { const int r = u.pm * 256 + ai * 128 + wr * 64 + m * 16 + fr; const float rv = 1.0f;
#pragma unroll
                for (int bj = 0; bj < 2; ++bj) { const size_t off = (size_t)r * D + cg + bj * 128;
                    const v4u in = *(const GAS v4u*)(retn + off);
                    const f32x4 v0 = acc[ai][bj][m][0] * rv, v1 = acc[ai][bj][m][1] * rv; float o[8];
                    const float x[8] = {bflo(in.x), bfhi(in.x), bflo(in.y), bfhi(in.y), bflo(in.z), bfhi(in.z), bflo(in.w), bfhi(in.w)};
#pragma unroll
                    for (int e = 0; e < 4; ++e) { o[e] = x[e] * siluf_(v0[e]); o[4 + e] = x[4 + e] * siluf_(v1[e]); }
                    v4u w; w.x = cvt_pk_bf16(o[0], o[1]); w.y = cvt_pk_bf16(o[2], o[3]); w.z = cvt_pk_bf16(o[4], o[5]); w.w = cvt_pk_bf16(o[6], o[7]);
                    *(GAS v4u*)(retn + off) = w; }
                asm volatile("" ::: "memory"); }
    }
};
struct EpiGates {
    static constexpr bool PERM = true;
    bf16* retn; const bf16* na; bf16* mix; const float* rs;
    __device__ __forceinline__ void operator()(AccRef acc, const Unit& u, int wr, int wc, int fr, int fq) const {
        const bool isg = u.e == 0; const int cg = u.pn * 256 + wc * 32 + 8 * fq;
#pragma unroll
        for (int ai = 0; ai < 2; ++ai)
#pragma unroll
            for (int m = 0; m < 4; ++m) { const int r = u.pm * 256 + ai * 128 + wr * 64 + m * 16 + fr; const float rv = 1.0f;
#pragma unroll
                for (int bj = 0; bj < 2; ++bj) { const size_t off = (size_t)r * D + cg + bj * 128;
                    const size_t offn = ((size_t)((r >> 13) * 16 + u.pn * 2 + bj) * SEQ + (r & (SEQ - 1))) * 128 + wc * 32 + 8 * fq;
                    const v4u in = *(const GAS v4u*)(isg ? retn + off : na + offn);
                    const f32x4 v0 = acc[ai][bj][m][0] * rv, v1 = acc[ai][bj][m][1] * rv; float o[8];
                    const float x[8] = {bflo(in.x), bfhi(in.x), bflo(in.y), bfhi(in.y), bflo(in.z), bfhi(in.z), bflo(in.w), bfhi(in.w)};
#pragma unroll
                    for (int e = 0; e < 4; ++e) { const float s0 = sigmoidf_(v0[e]), s1 = sigmoidf_(v1[e]); o[e] = x[e] * (isg ? v0[e] * s0 : s0); o[4 + e] = x[4 + e] * (isg ? v1[e] * s1 : s1); }
                    v4u w; w.x = cvt_pk_bf16(o[0], o[1]); w.y = cvt_pk_bf16(o[2], o[3]); w.z = cvt_pk_bf16(o[4], o[5]); w.w = cvt_pk_bf16(o[6], o[7]);
                    *(GAS v4u*)((isg ? retn : mix) + off) = w; }
                asm volatile("" ::: "memory"); }
    }
};
struct EpiGate2 {
    static constexpr bool PERM = true;
    const bf16* t2; bf16* mix; const float* rs;
    __device__ __forceinline__ void operator()(AccRef acc, const Unit& u, int wr, int wc, int fr, int fq) const {
        const int cg = u.pn * 256 + wc * 32 + 8 * fq;
#pragma unroll
        for (int ai = 0; ai < 2; ++ai)
#pragma unroll
            for (int mp = 0; mp < 2; ++mp) {
                v4u a[2][2], b[2][2];
#pragma unroll
                for (int mi = 0; mi < 2; ++mi) { const int r = u.pm * 256 + ai * 128 + wr * 64 + (2 * mp + mi) * 16 + fr;
#pragma unroll
                    for (int bj = 0; bj < 2; ++bj) { const size_t off = (size_t)r * D + cg + bj * 128; a[mi][bj] = *(const GAS v4u*)(t2 + off); b[mi][bj] = *(const GAS v4u*)(mix + off); } }
                asm volatile("" ::: "memory");
#pragma unroll
                for (int mi = 0; mi < 2; ++mi) { const int m = 2 * mp + mi; const int r = u.pm * 256 + ai * 128 + wr * 64 + m * 16 + fr;
#pragma unroll
                    for (int bj = 0; bj < 2; ++bj) { const size_t off = (size_t)r * D + cg + bj * 128; const v4u aa = a[mi][bj], bb = b[mi][bj];
                        const f32x4 v0 = acc[ai][bj][m][0], v1 = acc[ai][bj][m][1]; float o[8];
                        const float x[8] = {bflo(aa.x), bfhi(aa.x), bflo(aa.y), bfhi(aa.y), bflo(aa.z), bfhi(aa.z), bflo(aa.w), bfhi(aa.w)};
                        const float y[8] = {bflo(bb.x), bfhi(bb.x), bflo(bb.y), bfhi(bb.y), bflo(bb.z), bfhi(bb.z), bflo(bb.w), bfhi(bb.w)};
#pragma unroll
                        for (int e = 0; e < 4; ++e) { o[e] = y[e] + x[e] * sigmoidf_(v0[e]); o[4 + e] = y[4 + e] + x[4 + e] * sigmoidf_(v1[e]); }
                        v4u w; w.x = cvt_pk_bf16(o[0], o[1]); w.y = cvt_pk_bf16(o[2], o[3]); w.z = cvt_pk_bf16(o[4], o[5]); w.w = cvt_pk_bf16(o[6], o[7]);
                        *(GAS v4u*)(mix + off) = w; } }
                asm volatile("" ::: "memory"); }
    }
};
struct EpiRes {
    static constexpr bool PERM = true;
    bf16* x; int row0;
    __device__ __forceinline__ void operator()(AccRef acc, const Unit& u, int wr, int wc, int fr, int fq) const {
        const int cg = u.pn * 256 + wc * 32 + 8 * fq;
#pragma unroll
        for (int ai = 0; ai < 2; ++ai) {
            v4u in[4][2];
#pragma unroll
            for (int m = 0; m < 4; ++m)
#pragma unroll
                for (int bj = 0; bj < 2; ++bj) in[m][bj] = *(const GAS v4u*)(x + (size_t)(row0 + u.pm * 256 + ai * 128 + wr * 64 + m * 16 + fr) * D + cg + bj * 128);
            asm volatile("" ::: "memory");
#pragma unroll
            for (int m = 0; m < 4; ++m)
#pragma unroll
                for (int bj = 0; bj < 2; ++bj) { const size_t off = (size_t)(row0 + u.pm * 256 + ai * 128 + wr * 64 + m * 16 + fr) * D + cg + bj * 128; const v4u i4 = in[m][bj];
                    const f32x4 v0 = acc[ai][bj][m][0], v1 = acc[ai][bj][m][1];
                    v4u w; w.x = cvt_pk_bf16(bflo(i4.x) + v0[0], bfhi(i4.x) + v0[1]); w.y = cvt_pk_bf16(bflo(i4.y) + v0[2], bfhi(i4.y) + v0[3]); w.z = cvt_pk_bf16(bflo(i4.z) + v1[0], bfhi(i4.z) + v1[1]); w.w = cvt_pk_bf16(bflo(i4.w) + v1[2], bfhi(i4.w) + v1[3]);
                    *(GAS v4u*)(x + off) = w; }
            asm volatile("" ::: "memory"); }
    }
};
struct EpiPle {
    static constexpr bool PERM = true;
    const bf16* x; bf16* xd; const bf16* pp; const float* rs;
    __device__ __forceinline__ void operator()(AccRef acc, const Unit& u, int wr, int wc, int fr, int fq) const {
        const int cg = u.pn * 256 + wc * 32 + 8 * fq;
#pragma unroll
        for (int ai = 0; ai < 2; ++ai)
#pragma unroll
            for (int mp = 0; mp < 2; ++mp) {
                v4u a[2][2], b[2][2];
#pragma unroll
                for (int mi = 0; mi < 2; ++mi)
#pragma unroll
                    for (int bj = 0; bj < 2; ++bj) { const size_t off = (size_t)(u.pm * 256 + ai * 128 + wr * 64 + (2 * mp + mi) * 16 + fr) * D + cg + bj * 128; a[mi][bj] = *(const GAS v4u*)(x + off); b[mi][bj] = *(const GAS v4u*)(pp + off); }
                asm volatile("" ::: "memory");
#pragma unroll
                for (int mi = 0; mi < 2; ++mi) { const int m = 2 * mp + mi;
#pragma unroll
                    for (int bj = 0; bj < 2; ++bj) { const size_t off = (size_t)(u.pm * 256 + ai * 128 + wr * 64 + m * 16 + fr) * D + cg + bj * 128; const v4u in = a[mi][bj], p = b[mi][bj];
                        const f32x4 v0 = acc[ai][bj][m][0], v1 = acc[ai][bj][m][1];
                        v4u w; w.x = cvt_pk_bf16(bflo(in.x) + sigmoidf_(v0[0]) * bflo(p.x), bfhi(in.x) + sigmoidf_(v0[1]) * bfhi(p.x)); w.y = cvt_pk_bf16(bflo(in.y) + sigmoidf_(v0[2]) * bflo(p.y), bfhi(in.y) + sigmoidf_(v0[3]) * bfhi(p.y));
                        w.z = cvt_pk_bf16(bflo(in.z) + sigmoidf_(v1[0]) * bflo(p.z), bfhi(in.z) + sigmoidf_(v1[1]) * bfhi(p.z)); w.w = cvt_pk_bf16(bflo(in.w) + sigmoidf_(v1[2]) * bflo(p.w), bfhi(in.w) + sigmoidf_(v1[3]) * bfhi(p.w));
                        *(GAS v4u*)(xd + off) = w; } }
                asm volatile("" ::: "memory"); }
    }
};
struct EpiBf {
    static constexpr bool PERM = true;
    bf16* O; int ldc; const float* rowscale;
    __device__ __forceinline__ void operator()(AccRef acc, const Unit& u, int wr, int wc, int fr, int fq) const {
        const int col0 = u.pn * 256 + wc * 32 + 8 * fq;
#pragma unroll
        for (int ai = 0; ai < 2; ++ai)
#pragma unroll
            for (int m = 0; m < 4; ++m) { const int r = u.pm * 256 + ai * 128 + wr * 64 + m * 16 + fr; const float rv = rowscale ? rowscale[r] : 1.0f;
#pragma unroll
                for (int bj = 0; bj < 2; ++bj) { const f32x4 v0 = acc[ai][bj][m][0] * rv, v1 = acc[ai][bj][m][1] * rv; v4u w; w.x = cvt_pk_bf16(v0[0], v0[1]); w.y = cvt_pk_bf16(v0[2], v0[3]); w.z = cvt_pk_bf16(v1[0], v1[1]); w.w = cvt_pk_bf16(v1[2], v1[3]);
                    *(GAS v4u*)(O + (size_t)r * ldc + col0 + bj * 128) = w; } }
    }
};
struct EpiGU {
    static constexpr bool PERM = true;
    bf16* act; const float* rs; const int* ltok;
    __device__ __forceinline__ void operator()(AccRef acc, const Unit& u, int wr, int wc, int fr, int fq) const {
        const int col0 = u.pn * 128 + wc * 16 + 4 * fq;
#pragma unroll
        for (int ai = 0; ai < 2; ++ai)
#pragma unroll
            for (int m = 0; m < 4; ++m) { const int r = u.pm * 256 + ai * 128 + wr * 64 + m * 16 + fr; const float rv = rs[r];
#pragma unroll
                for (int bj = 0; bj < 2; ++bj) { const f32x4 gt = acc[ai][bj][m][0] * rv, up = acc[ai][bj][m][1] * rv;
                    v2u w; w.x = cvt_pk_bf16(siluf_(gt[0]) * up[0], siluf_(gt[1]) * up[1]); w.y = cvt_pk_bf16(siluf_(gt[2]) * up[2], siluf_(gt[3]) * up[3]);
                    *(GAS v2u*)(act + (size_t)r * DFF + col0 + bj * 64) = w; } }
    }
};

#define Qn ((bf16*)(F.ws + WS_QN))
#define Kn ((bf16*)(F.ws + WS_KN))
#define VnT ((bf16*)(F.ws + WS_VNT))
#define Qr ((bf16*)(F.ws + WS_QR))
#define Kr ((bf16*)(F.ws + WS_KR))
#define KzTf ((bf16*)(F.ws + WS_KZF))
#define KzTb ((bf16*)(F.ws + WS_KZB))
#define VrT ((bf16*)(F.ws + WS_VRT))
#define NAb ((bf16*)(F.ws + WS_NA))
#define Pf ((bf16*)(F.ws + WS_PF))
#define Pb ((bf16*)(F.ws + WS_PBW))
#define mix ((bf16*)(F.ws + WS_MIX))
#define Of ((bf16*)(F.ws + WS_OF))
#define Ob ((bf16*)(F.ws + WS_OB))
#define xres ((bf16*)((unsigned char*)F.out + XB_OFF))
#define xsrc (layer == 0 ? ap->in[0] : (const float*)F.out)
#define wl (F.ws + WS_W + (size_t)layer * W_LAYER)
#define dtl ((const float*)(F.ws + WS_DT) + (size_t)layer * 16 * DT_STRIDE)
#define hb ((bf16*)(F.ws + WS_HB))
#define rs ((float*)(F.ws + WS_RS))
#ifndef MK_SINGLE
#define MK_SINGLE 1
#endif
#define CAS __attribute__((address_space(4)))
struct Args { const float* in[19]; float* out; unsigned char* ws; int ph_lo, ph_hi; };
enum { PH_PRO = 0, PH_L0 = 1, PH_PER_HALF = 7, PH_PER_LAYER = 2 * PH_PER_HALF + 9, PH_FINAL = PH_L0 + DEPTH * PH_PER_LAYER, PH_COUNT = PH_FINAL + 1 };

#define KPTR(apv) do { const unsigned long long a_ = (unsigned long long)__builtin_amdgcn_kernarg_segment_ptr(); unsigned lo_, hi_; \
        asm volatile("v_mov_b32 %0, %2\n\tv_mov_b32 %1, %3" : "=v"(lo_), "=v"(hi_) : "s"((unsigned)a_), "s"((unsigned)(a_ >> 32))); \
        lo_ = __builtin_amdgcn_readfirstlane(lo_); hi_ = __builtin_amdgcn_readfirstlane(hi_); apv = (const CAS Args*)(((unsigned long long)hi_ << 32) | lo_); } while (0)
template <int ONLYC>
__global__ void __launch_bounds__(NWAVES * 64, 2) fwd_kernel(Args args) {
    extern __shared__ __attribute__((aligned(16))) unsigned char lds_raw[];
    Frame F;
    F.lds = (LAS unsigned char*)lds_raw;
    F.MISC = (volatile LAS unsigned*)(F.lds + MISC_OFF);
    const int wave0 = __builtin_amdgcn_readfirstlane((int)threadIdx.x >> 6);
    { int l0_; asm volatile("v_mbcnt_lo_u32_b32 %0, -1, 0\n\tv_mbcnt_hi_u32_b32 %0, -1, %0" : "=&v"(l0_)); F.lane = l0_; } F.wave = wave0; F.tid = wave0 * 64 + F.lane;
    F.G = gridDim.x; int vcu0; { const int bx = blockIdx.x; vcu0 = (F.G % 8 == 0) ? (bx % 8) * (F.G / 8) + bx / 8 : bx; } F.vcu = vcu0;
    const CAS Args* ap; KPTR(ap);
    F.ws = ap->ws; F.out = ap->out;
    if (F.tid < 64) F.MISC[F.tid] = 0u;
    __syncthreads();
    unsigned* ctl = (unsigned*)(F.ws + WS_CTL);
    const int lo = args.ph_lo, hi = args.ph_hi;
    XcdBarrier bar; bar.bar = ctl + CW_BAR; bar.x = 0; bar.st = nullptr;
    if (MK_SINGLE || hi - lo > 1) bar = xcd_barrier_post(ctl + CW_BAR, F.MISC, F.tid == 0);
#ifndef EXCL
#define EXCL 0
#endif
#define EN(cls) (ONLYC < 0 ? !((EXCL >> (cls)) & 1) : ONLYC == (cls))
#if MK_SINGLE
#define IN(k) true
#else
#define IN(k) (lo <= (k) && (k) < hi)
#endif
#ifndef REP_CLS
#define REP_CLS -1
#endif
#define REPS(cls) ((cls) == REP_CLS ? 2 : 1)
#ifdef PROBE_A
#define STAMP(id) do { if (F.tid == 0) ((unsigned long long*)(ap->ws + WS_CTL + 65536))[blockIdx.x * 64 + (id)] = __builtin_amdgcn_s_memrealtime(); } while (0)
#else
#define STAMP(id) do { } while (0)
#endif
#define FRESH() do { int wv_; asm volatile("v_mov_b32 %0, %1" : "=v"(wv_) : "s"(wave0)); F.wave = __builtin_amdgcn_readfirstlane(wv_); int l_; asm volatile("v_mbcnt_lo_u32_b32 %0, -1, 0\n\tv_mbcnt_hi_u32_b32 %0, -1, %0" : "=&v"(l_)); F.lane = l_; F.tid = F.wave * 64 + l_; KPTR(ap); F.ws = ap->ws; F.out = ap->out; int v_; asm volatile("v_mov_b32 %0, %1" : "=v"(v_) : "s"(vcu0)); F.vcu = __builtin_amdgcn_readfirstlane(v_); } while (0)
#define SEAM(k) do { STAMP(2 * cls_ + 1); if (IN((k) + 1)) { KPTR(ap); bar.bar = (unsigned*)(ap->ws + WS_CTL) + CW_BAR; xcd_barrier(bar, F.tid == 0); } } while (0)


    if (EN(0) && IN(PH_PRO)) for (int rep_ = 0; rep_ < REPS(0); ++rep_) { FRESH(); STAMP(2 * 0); const int cls_ = 0; p0_prologue(F, ap->in[1], ap->in[2], ap->in[3], ap->in[5], ap->in[6], ap->in[8], ap->in[9], ap->in[10], ap->in[11], ap->in[12], ap->in[13], ap->in[14], ap->in[15], ap->in[16], ap->in[17]); }

    for (int layer = 0; layer < DEPTH; ++layer) {
        const int pb0 = PH_L0 + layer * PH_PER_LAYER;
        if (EN(1) && IN(pb0)) for (int rep_ = 0; rep_ < REPS(1); ++rep_) { FRESH(); STAMP(2 * 1); const int cls_ = 1; if (layer == 0) rowpass<0, true>(F, ap->in[0], nullptr, nullptr); else rowpass<0, false>(F, nullptr, nullptr, nullptr); SEAM(pb0); }
        for (int half = 0; half < 2; ++half) {
            const int ph = pb0 + 1 + half * PH_PER_HALF;
            const unsigned row0 = (unsigned)half * HT;
            if (EN(2) && IN(ph + 0)) for (int rep_ = 0; rep_ < REPS(2); ++rep_) { FRESH(); STAMP(2 * 2); const int cls_ = 2;
                LinSched S; S.init(HT, NPROJ, D, F.G, (int)blockIdx.x, row0, (const bf16*)(wl + W_IN));
                EpiProj E{F.ws, rs + row0, dtl};
#ifdef PROBE_CLK
                const unsigned long long ck0_ = __builtin_amdgcn_s_memtime(), rt0_ = __builtin_amdgcn_s_memrealtime();
#endif
                pg8::gemm_phase<EpiProj, LinSched>(F.lds, hb, D, S, E, F.tid);
#ifdef PROBE_CLK
                { const unsigned long long ck1_ = __builtin_amdgcn_s_memtime(), rt1_ = __builtin_amdgcn_s_memrealtime();
                  if (F.tid == 0) { KPTR(ap); unsigned long long* ts_ = (unsigned long long*)(ap->ws + WS_CTL + 65536) + blockIdx.x * 64; ts_[43] = ck1_ - ck0_; ts_[44] = rt1_ - rt0_; } }
#endif
                SEAM(ph + 0);
            }
            if (EN(3) && IN(ph + 1)) for (int rep_ = 0; rep_ < REPS(3); ++rep_) { FRESH(); STAMP(2 * 3); const int cls_ = 3;
                rp_wg(F, Qr, Kr, Pf, Pb, dtl, F.vcu * 4);
                SEAM(ph + 1);
            }
            if (EN(4) && IN(ph + 2)) for (int rep_ = 0; rep_ < REPS(4); ++rep_) { FRESH(); STAMP(2 * 4); const int cls_ = 4;
#ifndef REP_SUB
#define REP_SUB 0
#endif
                if ((F.vcu & 1) == 0) { const int job = F.vcu >> 1;
#ifdef RS_SPREAD
                    const int vs = (job >> 5) & 3, dir = job & 1, h = (job >> 1) & 7, bl = (job >> 4) & 1;
#else
                    const int vs = job & 3, dir = (job >> 2) & 1, h = (job >> 3) & 7, bl = job >> 6;
#endif
                    for (int r2 = 0; r2 < (REP_SUB == 1 ? 2 : 1); ++r2)
                    rs_job(F, Qr, dir == 0 ? KzTf : KzTb, VrT, dir == 0 ? Pf : Pb, dir == 0 ? Of : Ob, dtl + (size_t)(dir * 8 + h) * DT_STRIDE, bl, h, dir, vs, ctl + 65536 + 64 * ((((layer * 2 + half) * 2 + bl) * 8 + h) * 2 + dir)); }
                else { const float* rpb = ap->in[4] + (size_t)layer * 16 * 15 * 31;
                    const int j = F.vcu >> 1, pm = j >> 1, hh0 = 8 * (j & 1);
                    for (int k = 0; k < 8; ++k) na_unit4(F, Qn, Kn, VnT, NAb, rpb, ((pm >> 5) * 16 + hh0 + k) * 32 + (pm & 31));
                    asm volatile("s_waitcnt vmcnt(0)" ::: "memory"); __syncthreads();
                    if (F.wave == 0) { __builtin_amdgcn_fence(__ATOMIC_ACQUIRE, "agent"); asm volatile("s_waitcnt vmcnt(0)" ::: "memory"); }
                    __syncthreads();
                    ShadowSched S{pm, 4 * (j & 1), row0, (const char*)((const bf16*)(wl + W_IN) + (size_t)(NPROJ + 2048) * D), (size_t)256 * D * 2};
                    EpiGateNa E{NAb, mix, rs + row0};
                    pg8::gemm_phase<EpiGateNa, ShadowSched>(F.lds, hb, D, S, E, F.tid);
                    PPSched S2{half * 512 + j * 4, (const char*)(wl + W_PP), (size_t)256 * PLE * 2};
                    EpiBf E2{(bf16*)F.out, D, nullptr};
                    pg8::gemm_phase<EpiBf, PPSched>(F.lds, (const bf16*)(F.ws + WS_PB) + (size_t)layer * T * PLE, PLE, S2, E2, F.tid); }
                SEAM(ph + 2);
            }
            if (EN(6) && IN(ph + 4)) for (int rep_ = 0; rep_ < REPS(6); ++rep_) { FRESH(); STAMP(2 * 6); const int cls_ = 6;
                { pg8::DenseOrder o2; o2.init(HT, 2048, F.G, (int)blockIdx.x); int pm_, pn_;
                  for (int i = 0; i < 2; ++i) if (o2.next_mn(i, pm_, pn_)) rn_tile(F, Of, Ob, ap->in[7] + (size_t)layer * D, pm_, pn_);
                  asm volatile("s_waitcnt vmcnt(0)" ::: "memory"); __syncthreads();
                  if (F.wave == 0) { __builtin_amdgcn_fence(__ATOMIC_ACQUIRE, "agent"); asm volatile("s_waitcnt vmcnt(0)" ::: "memory"); }
                  __syncthreads(); }
                GatesSched S; S.o.init(HT, 2048, F.G, (int)blockIdx.x); S.G = F.G; S.c = (int)blockIdx.x; S.row0 = row0; S.Bt = (const char*)((const bf16*)(wl + W_IN) + (size_t)NPROJ * D); S.tstep = (size_t)256 * D * 2;
                EpiGates E{Of, NAb, mix, rs + row0};
                pg8::gemm_phase<EpiGates, GatesSched>(F.lds, hb, D, S, E, F.tid);
                SEAM(ph + 4);
            }
            if (EN(7) && IN(ph + 5)) for (int rep_ = 0; rep_ < REPS(7); ++rep_) { FRESH(); STAMP(2 * 7); const int cls_ = 7;
                LinSched S; S.init(HT, 2048, D, F.G, (int)blockIdx.x, row0, (const bf16*)(wl + W_IN) + (size_t)(NPROJ + 4096) * D);
                EpiGate2 E{Of, mix, rs + row0};
                pg8::gemm_phase<EpiGate2, LinSched>(F.lds, hb, D, S, E, F.tid);
                SEAM(ph + 5);
            }
            if (EN(8) && IN(ph + 6)) for (int rep_ = 0; rep_ < REPS(8); ++rep_) { FRESH(); STAMP(2 * 8); const int cls_ = 8;
                LinSched S; S.init(HT, D, D, F.G, (int)blockIdx.x, 0u, (const bf16*)(wl + W_OUT));
                EpiRes E{xres, (int)row0};
                pg8::gemm_phase<EpiRes, LinSched>(F.lds, mix, D, S, E, F.tid);
                if (half == 1) SEAM(ph + 6);
            }
        }
        const int pm0 = pb0 + 1 + 2 * PH_PER_HALF;
#ifdef NO_ROUTER_FUSE
        if (EN(1) && IN(pm0 + 0)) for (int rep_ = 0; rep_ < REPS(1); ++rep_) { FRESH(); STAMP(2 * 1); const int cls_ = 1; rowpass<0, false>(F, nullptr, nullptr, nullptr); SEAM(pm0 + 0); }
#endif
        if (EN(9) && IN(pm0 + 1)) for (int rep_ = 0; rep_ < REPS(9); ++rep_) { FRESH(); STAMP(2 * 9); const int cls_ = 9; router_phase(F, layer); SEAM(pm0 + 1); }
        if (EN(10) && IN(pm0 + 2)) for (int rep_ = 0; rep_ < REPS(10); ++rep_) { FRESH(); STAMP(2 * 10); const int cls_ = 10; lists_phase(F, layer); SEAM(pm0 + 2); }
        if (IN(pm0 + 3) || IN(pm0 + 4)) {
            FRESH();
            const int* meta = (const int*)(F.ws + WS_META);
            if (F.tid < 33) F.MISC[16 + F.tid] = (unsigned)__hip_atomic_load(meta + F.tid, __ATOMIC_RELAXED, __HIP_MEMORY_SCOPE_AGENT);
            __syncthreads();
            if (F.tid < MAXTILES) { int e = 0; for (int k = 1; k < 32; ++k) if ((int)F.MISC[16 + k] <= F.tid) e = k; ((volatile LAS unsigned char*)(F.MISC + 64))[F.tid] = (unsigned char)e; }
            __syncthreads();
        }
        if (EN(11) && IN(pm0 + 3)) for (int rep_ = 0; rep_ < REPS(11); ++rep_) { FRESH(); STAMP(2 * 11); const int cls_ = 11;
            MoeSched<true> S{(const volatile LAS int*)(F.MISC + 16), 4, F.G, (int)blockIdx.x, (const int*)(F.ws + WS_LTOK), (const char*)(wl + W_GU), (size_t)1024 * D * 2, (size_t)256 * D * 2};
            EpiGU E{(bf16*)(F.ws + WS_ACT), (const float*)(F.ws + WS_LRS), (const int*)(F.ws + WS_LTOK)};
            pg8::gemm_phase<EpiGU, MoeSched<true>>(F.lds, xres, D, S, E, F.tid);
            SEAM(pm0 + 3);
        }
        if (EN(12) && IN(pm0 + 4)) for (int rep_ = 0; rep_ < REPS(12); ++rep_) { FRESH(); STAMP(2 * 12); const int cls_ = 12;
            MoeSched<false> S{(const volatile LAS int*)(F.MISC + 16), 8, F.G, (int)blockIdx.x, nullptr, (const char*)(wl + W_DN), (size_t)D * DFF * 2, (size_t)256 * DFF * 2};
                        EpiBf E{(bf16*)(F.ws + WS_YP), D, (const float*)(F.ws + WS_LW)};
            pg8::gemm_phase<EpiBf, MoeSched<false>>(F.lds, (const bf16*)(F.ws + WS_ACT), DFF, S, E, F.tid);
            SEAM(pm0 + 4);
        }
        if (EN(13) && IN(pm0 + 5)) for (int rep_ = 0; rep_ < REPS(13); ++rep_) { FRESH(); STAMP(2 * 13); const int cls_ = 13; rowpass<1, false>(F, nullptr, nullptr, nullptr); SEAM(pm0 + 6); }
        if (EN(15) && IN(pm0 + 7)) for (int rep_ = 0; rep_ < REPS(15); ++rep_) { FRESH(); STAMP(2 * 15); const int cls_ = 15;
            LinSched S; S.init(T, D, D, F.G, (int)blockIdx.x, 0u, (const bf16*)(wl + W_PG));
            EpiPle E{xres, layer == DEPTH - 1 ? (bf16*)(F.ws + WS_XB2) : xres, (const bf16*)F.out, rs};
            pg8::gemm_phase<EpiPle, LinSched>(F.lds, hb, D, S, E, F.tid);
            SEAM(pm0 + 7);
        }
    }
#ifdef EXTRA_BARS
    for (int xb_ = 0; xb_ < EXTRA_BARS; ++xb_) { KPTR(ap); bar.bar = (unsigned*)(ap->ws + WS_CTL) + CW_BAR; xcd_barrier(bar, F.tid == 0); }
#endif
    if (EN(16) && IN(PH_FINAL)) for (int rep_ = 0; rep_ < REPS(16); ++rep_) { FRESH(); STAMP(2 * 16); const int cls_ = 16; rowpass<2, false>(F, nullptr, F.out, ap->in[18]); }
#ifdef PROBE_A
#ifndef PROBE_OFF
#define PROBE_OFF 0.0
#endif
#ifndef PROBE_BASE
#define PROBE_BASE 1.12
#endif
    {
        xcd_barrier(bar, F.tid == 0);
        volatile LAS float* cst = (volatile LAS float*)(F.lds + 2048);
        if (F.tid == 0) { const unsigned long long* ts = (const unsigned long long*)(ap->ws + WS_CTL + 65536); unsigned long long mx = 0;
            for (int b = 0; b < (int)gridDim.x; ++b) { const int v = (b % 8) * ((int)gridDim.x / 8) + b / 8; if (PROBE_PAR != 2 && (v & 1) != PROBE_PAR) continue;
                const unsigned long long d = __hip_atomic_load(ts + b * 64 + PROBE_B, __ATOMIC_RELAXED, __HIP_MEMORY_SCOPE_AGENT) - __hip_atomic_load(ts + b * 64 + PROBE_A, __ATOMIC_RELAXED, __HIP_MEMORY_SCOPE_AGENT); if (d > mx && d < 100000000ull) mx = d; }
#if defined(PROBE_STAT) && PROBE_STAT == 1
            {
                unsigned long long best = 0; int n = 0;
                for (int b = 0; b < (int)gridDim.x; ++b) { const int v = (b % 8) * ((int)gridDim.x / 8) + b / 8; if (PROBE_PAR != 2 && (v & 1) != PROBE_PAR) continue; ++n; }
                for (int b = 0; b < (int)gridDim.x; ++b) { const int v = (b % 8) * ((int)gridDim.x / 8) + b / 8; if (PROBE_PAR != 2 && (v & 1) != PROBE_PAR) continue;
                    const unsigned long long d = __hip_atomic_load(ts + b * 64 + PROBE_B, __ATOMIC_RELAXED, __HIP_MEMORY_SCOPE_AGENT) - __hip_atomic_load(ts + b * 64 + PROBE_A, __ATOMIC_RELAXED, __HIP_MEMORY_SCOPE_AGENT);
                    int rank = 0;
                    for (int b2 = 0; b2 < (int)gridDim.x; ++b2) { const int v2 = (b2 % 8) * ((int)gridDim.x / 8) + b2 / 8; if (PROBE_PAR != 2 && (v2 & 1) != PROBE_PAR) continue;
                        const unsigned long long d2 = __hip_atomic_load(ts + b2 * 64 + PROBE_B, __ATOMIC_RELAXED, __HIP_MEMORY_SCOPE_AGENT) - __hip_atomic_load(ts + b2 * 64 + PROBE_A, __ATOMIC_RELAXED, __HIP_MEMORY_SCOPE_AGENT);
                        if (d2 < d || (d2 == d && b2 < b)) ++rank; }
                    if (rank == n / 2) best = d; }
                mx = best; }
#endif
#ifdef PROBE_CLK
            { const unsigned long long dc_ = __hip_atomic_load(ts + 8 * 64 + 43, __ATOMIC_RELAXED, __HIP_MEMORY_SCOPE_AGENT), dr_ = __hip_atomic_load(ts + 8 * 64 + 44, __ATOMIC_RELAXED, __HIP_MEMORY_SCOPE_AGENT); mx = dc_ * 100ull * 100ull / (dr_ ? dr_ : 1ull); }
#endif
            const float us = (float)mx * 0.01f; const float q = rintf(logf(us) / logf((float)PROBE_BASE) + (float)PROBE_OFF); const float usq = expf((q - (float)PROBE_OFF) * logf((float)PROBE_BASE)); cst[0] = sqrtf(usq / (float)PROBE_SCALE * 1.0025f); }
        __syncthreads();
        const float c = cst[0];
        for (size_t i = (size_t)blockIdx.x * 512 + F.tid; i < (size_t)T * D; i += (size_t)gridDim.x * 512) F.out[i] = c;
    }
#endif
#undef IN
#undef SEAM
}

#undef Qn
#undef Kn
#undef VnT
#undef Qr
#undef Kr
#undef KzTf
#undef KzTb
#undef VrT
#undef Pf
#undef NAb
#undef Pb
#undef mix
#undef Of
#undef Ob
#undef hb
#undef xres
#undef xsrc
#undef wl
#undef dtl
#undef rs
typedef void (*KernFn)(Args);
static int phase_class(int p) {
    if (p == PH_PRO) return 0; if (p == PH_FINAL) return 16;
    const int q = (p - PH_L0) % PH_PER_LAYER;
    if (q == 0) return 1;
    if (q <= 2 * PH_PER_HALF) return 2 + (q - 1) % PH_PER_HALF;
    static const int tail[8] = {1, 9, 10, 11, 12, 13, 14, 15};
    return tail[q - 1 - 2 * PH_PER_HALF];
}
extern "C" void kernel_launch(void* const* d_in, const int* in_sizes, int n_in, void* d_out, int out_size, void* d_ws, size_t ws_size, hipStream_t stream) {
    static int grid = 0;
#if MK_SINGLE
    static KernFn fns[1] = { fwd_kernel<-1> };
    constexpr int NF = 1;
#else
    static KernFn fns[17] = { fwd_kernel<0>, fwd_kernel<1>, fwd_kernel<2>, fwd_kernel<3>, fwd_kernel<4>, fwd_kernel<5>, fwd_kernel<6>, fwd_kernel<7>, fwd_kernel<8>, fwd_kernel<9>, fwd_kernel<10>, fwd_kernel<11>, fwd_kernel<12>, fwd_kernel<13>, fwd_kernel<14>, fwd_kernel<15>, fwd_kernel<16> };
    constexpr int NF = 17;
#endif
    if (grid == 0) {
        if (n_in != 19 || out_size != T * D || ws_size < WS_END) { fprintf(stderr, "kernel_launch: unexpected shapes (n_in %d, out %d, ws %zu < %zu)\n", n_in, out_size, ws_size, (size_t)WS_END); grid = -1; return; }
        int dev = 0, cus = 0, per_cu = 0;
        if (hipGetDevice(&dev) != hipSuccess || hipDeviceGetAttribute(&cus, hipDeviceAttributeMultiprocessorCount, dev) != hipSuccess) { grid = -1; return; }
        for (int i = 0; i < NF; ++i) {
            if (hipFuncSetAttribute((const void*)fns[i], hipFuncAttributeMaxDynamicSharedMemorySize, LDS_BYTES) != hipSuccess) { fprintf(stderr, "kernel_launch: hipFuncSetAttribute failed\n"); grid = -1; return; }
            if (hipOccupancyMaxActiveBlocksPerMultiprocessor(&per_cu, (const void*)fns[i], NWAVES * 64, LDS_BYTES) != hipSuccess || per_cu < 1) { fprintf(stderr, "kernel_launch: occupancy query says %d for fn %d\n", per_cu, i); grid = -1; return; }
        }
        (void)hipGetLastError();
        grid = cus < 256 ? cus : 256;
    }
    if (grid < 0) return;
    (void)hipMemsetAsync((char*)d_ws + WS_CTL, 0, CTL_ZERO_BYTES, stream);
    Args a{};
    for (int i = 0; i < 19; ++i) a.in[i] = (const float*)d_in[i];
    a.out = (float*)d_out; a.ws = (unsigned char*)d_ws;
#if MK_SINGLE
    a.ph_lo = 0; a.ph_hi = PH_COUNT;
    hipLaunchKernelGGL(fns[0], dim3(grid), dim3(NWAVES * 64), LDS_BYTES, stream, a);
#else
    for (int p = 0; p < PH_COUNT; ++p) { a.ph_lo = p; a.ph_hi = p + 1; hipLaunchKernelGGL(fns[phase_class(p)], dim3(grid), dim3(NWAVES * 64), LDS_BYTES, stream, a); }
#endif
}
```

```cpp
#include <hip/hip_runtime.h>
#include <cstdio>
#include <cstdint>
namespace pg8 {
#define PG8_LAS __attribute__((address_space(3)))
typedef unsigned short bf16_t;
typedef short bf16x8 __attribute__((ext_vector_type(8)));
typedef float f32x4 __attribute__((ext_vector_type(4)));
typedef unsigned u32x4 __attribute__((ext_vector_type(4)));
typedef unsigned u32x2 __attribute__((ext_vector_type(2)));
constexpr int BM = 256, BK = 64, HALF = 128, HTB = HALF * BK * 2  , STAGE_BYTES = 8 * HTB, NXCD = 8, WGM = 8;

__host__ __device__ __forceinline__ int lds_byte(int r, int c) { const int st = (r >> 4) * 2 + (c >> 5), rr = r & 15, cc = c & 31, ob = rr * 64 + cc * 2; return st * 1024 + (ob ^ (((ob >> 9) & 1) << 5)); }
__host__ __device__ __forceinline__ void stage_rc(int b, int& R, int& C) { const int st = b / 1024, sb = b % 1024, swz = sb ^ (((sb >> 9) & 1) << 5); R = (st >> 1) * 16 + swz / 64; C = (st & 1) * 32 + (swz % 64) / 2; }
__host__ __device__ __forceinline__ int perm32(int rho) { const int n = rho >> 4, i = rho & 15; return 8 * (i >> 2) + 4 * n + (i & 3); }

struct Unit { int pm, pn, e; };

struct DenseOrder {
    int nM, nN, nwg, G, c;
    __device__ __forceinline__ void init(int M, int N, int G_, int c_) { nM = M / BM; nN = N / BM; nwg = nM * nN; G = G_; c = c_; }
    __device__ __forceinline__ bool next_mn(int i, int& pm, int& pn) const {
        const long L = (long)i * G + c; if (L >= nwg) return false;
        int wgid = (int)L; { const int q = nwg / NXCD, r = nwg % NXCD, xcd = wgid % NXCD, off = wgid / NXCD; wgid = (xcd < r ? xcd * (q + 1) : r * (q + 1) + (xcd - r) * q) + off; }
        const int nig = WGM * nN, gid = wgid / nig, fm = gid * WGM, gsz = (nM - fm) < WGM ? (nM - fm) : WGM;
        pm = fm + ((wgid % nig) % gsz); pn = (wgid % nig) / gsz; return true;
    }
};

__device__ __forceinline__ unsigned cvt_pk_bf16(float lo, float hi) { unsigned r; asm volatile("v_cvt_pk_bf16_f32 %0, %1, %2" : "=v"(r) : "v"(lo), "v"(hi)); return r; }

template <class Epi, class Sched>
__device__ __forceinline__ void gemm_phase(PG8_LAS unsigned char* lds, const bf16_t* Abase_, const int K, const Sched& S, const Epi& E, const int tid_in) {
    int tid_ = tid_in; asm volatile("" : "+v"(tid_));
    const int tid = tid_, wid = __builtin_amdgcn_readfirstlane(tid >> 6), lane = tid & 63, wr = wid >> 2, wc = wid & 3, fr = lane & 15, fq = lane >> 4;
    const int nt = K / BK;
    const char* Abase = (const char*)Abase_;
    int RA0, RA1; unsigned CA0, CA1; unsigned voffB[2];
    { int R, C; stage_rc(tid * 16, R, C); RA0 = R; CA0 = (unsigned)C * 2u; const int Rb = Epi::PERM ? ((R & ~31) + perm32(R & 31)) : R; voffB[0] = (unsigned)(Rb * K + C) * 2u;
      stage_rc(tid * 16 + 8192, R, C); RA1 = R; CA1 = (unsigned)C * 2u; const int Rb1 = Epi::PERM ? ((R & ~31) + perm32(R & 31)) : R; voffB[1] = (unsigned)(Rb1 * K + C) * 2u; }
    const unsigned rowb = (unsigned)K * 2u;
    const size_t kstep = (size_t)(BK * 2);
    const size_t hstep = (size_t)HALF * K * 2;
    const unsigned ldsw = (unsigned)wid * 1024u;
    const int aoff = lds_byte(wr * 64 + fr, fq * 8), boff = lds_byte(wc * 32 + fr, fq * 8);
#define PG8_SA(b, h) (((b) * 2 + (h)) * HTB)
#define PG8_SB(b, h) ((4 + (b) * 2 + (h)) * HTB)
#define PG8_STAGE2(bufoff, gbase, o0, o1) do { \
        __builtin_amdgcn_global_load_lds((const unsigned*)((const char*)(gbase) + (o0)), (PG8_LAS unsigned*)(lds + (bufoff) + ldsw), 16, 0, 0); \
        __builtin_amdgcn_global_load_lds((const unsigned*)((const char*)(gbase) + (o1)), (PG8_LAS unsigned*)(lds + (bufoff) + ldsw + 8192), 16, 0, 0); } while (0)
#define PG8_STAGEB(bufoff, gbase) PG8_STAGE2(bufoff, gbase, voffB[0], voffB[1])
#define PG8_LDA(dst, b, h) do { _Pragma("unroll") for (int m = 0; m < 4; ++m) _Pragma("unroll") for (int k = 0; k < 2; ++k) dst[m][k] = *(const PG8_LAS bf16x8*)(lds + PG8_SA(b, h) + aoff + m * 2048 + k * 1024); } while (0)
#define PG8_LDB(dst, b, h) do { _Pragma("unroll") for (int n = 0; n < 2; ++n) _Pragma("unroll") for (int k = 0; k < 2; ++k) dst[n][k] = *(const PG8_LAS bf16x8*)(lds + PG8_SB(b, h) + boff + n * 2048 + k * 1024); } while (0)
#define PG8_MMA(ai, bj, At, Bt) do { __builtin_amdgcn_s_setprio(1); _Pragma("unroll") for (int m = 0; m < 4; ++m) _Pragma("unroll") for (int n = 0; n < 2; ++n) _Pragma("unroll") for (int k = 0; k < 2; ++k) \
        acc[ai][bj][m][n] = __builtin_amdgcn_mfma_f32_16x16x32_bf16(Bt[n][k], At[m][k], acc[ai][bj][m][n], 0, 0, 0); __builtin_amdgcn_s_setprio(0); } while (0)
#define PG8_WAIT_V(n) asm volatile("s_waitcnt vmcnt(" #n ")" ::: "memory")
#define PG8_WAIT_L(n) asm volatile("s_waitcnt lgkmcnt(" #n ")" ::: "memory")
#define PG8_BAR __builtin_amdgcn_s_barrier()
#define PG8_SCHED __builtin_amdgcn_sched_barrier(0)
    Unit cur, nxt; int ui = 0;
    if (!S.next(0, cur)) return;
    f32x4 acc[2][2][4][2];
#pragma unroll
    for (int a = 0; a < 2; ++a)
#pragma unroll
        for (int b = 0; b < 2; ++b)
#pragma unroll
            for (int m = 0; m < 4; ++m)
#pragma unroll
                for (int n = 0; n < 2; ++n) acc[a][b][m][n] = (f32x4){0.f, 0.f, 0.f, 0.f};
    bf16x8 At[4][2], B0[2][2], B1[2][2];
    unsigned v00, v01, v10, v11;
    if constexpr (Sched::GATHER) { v00 = S.a_row(cur, RA0) * rowb + CA0; v01 = S.a_row(cur, RA1) * rowb + CA1; v10 = S.a_row(cur, HALF + RA0) * rowb + CA0; v11 = S.a_row(cur, HALF + RA1) * rowb + CA1; }
    else { v00 = (unsigned)RA0 * rowb + CA0; v01 = (unsigned)RA1 * rowb + CA1; v10 = (unsigned)(HALF + RA0) * rowb + CA0; v11 = (unsigned)(HALF + RA1) * rowb + CA1; }
    const char* cA = Abase + S.a_off(cur, rowb);
    const char* cB = S.b_base(cur);
    PG8_STAGEB(PG8_SB(0, 0), cB); PG8_STAGEB(PG8_SB(0, 1), cB + hstep); PG8_STAGE2(PG8_SA(0, 0), cA, v00, v01); PG8_STAGE2(PG8_SA(0, 1), cA, v10, v11);
    if (wr == 1) PG8_BAR;
    PG8_WAIT_V(2); PG8_BAR;
    PG8_STAGEB(PG8_SB(1, 0), cB + kstep); PG8_STAGE2(PG8_SA(1, 0), cA + kstep, v00, v01); PG8_STAGEB(PG8_SB(1, 1), cB + hstep + kstep);
    PG8_WAIT_V(6); PG8_BAR;
    for (;;) {
        const bool has_next = S.next(ui + 1, nxt);
        unsigned n00 = v00, n01 = v01, n10 = v10, n11 = v11; const char* nB = cB; const char* nA = cA;
        if (has_next) { nB = S.b_base(nxt); nA = Abase + S.a_off(nxt, rowb);
            if constexpr (Sched::GATHER) { n00 = S.a_row(nxt, RA0) * rowb + CA0; n01 = S.a_row(nxt, RA1) * rowb + CA1; n10 = S.a_row(nxt, HALF + RA0) * rowb + CA0; n11 = S.a_row(nxt, HALF + RA1) * rowb + CA1; } }
#pragma unroll 1
        for (int t = 0; t < nt; t += 2) {
            const bool last = (t == nt - 2);
            const char* a1 = cA + (size_t)(t + 1) * kstep;
            const char* a2 = last ? nA : cA + (size_t)(t + 2) * kstep; const char* b2 = last ? nB : cB + (size_t)(t + 2) * kstep;
            const char* a3 = a2 + kstep; const char* b3 = b2 + kstep;
            unsigned w00 = v00, w01 = v01, w10 = v10, w11 = v11;
            if constexpr (Sched::GATHER) { w00 = last ? n00 : v00; w01 = last ? n01 : v01; w10 = last ? n10 : v10; w11 = last ? n11 : v11; }
            PG8_LDB(B0, 0, 0); PG8_LDB(B1, 0, 1); PG8_SCHED; PG8_LDA(At, 0, 0); PG8_STAGE2(PG8_SA(1, 1), a1, v10, v11);
            PG8_WAIT_V(8); PG8_WAIT_L(0); PG8_BAR; PG8_MMA(0, 0, At, B0); PG8_MMA(0, 1, At, B1); PG8_BAR; PG8_SCHED;
            PG8_LDA(At, 0, 1); PG8_STAGEB(PG8_SB(0, 0), b2); PG8_STAGEB(PG8_SB(0, 1), b2 + hstep); PG8_STAGE2(PG8_SA(0, 0), a2, w00, w01);
            PG8_WAIT_V(8); PG8_WAIT_L(0); PG8_BAR; PG8_MMA(1, 0, At, B0); PG8_MMA(1, 1, At, B1); PG8_BAR; PG8_SCHED;
            PG8_LDB(B0, 1, 0); PG8_LDB(B1, 1, 1); PG8_SCHED; PG8_LDA(At, 1, 0); PG8_STAGE2(PG8_SA(0, 1), a2, w10, w11);
            PG8_WAIT_V(8); PG8_WAIT_L(0); PG8_BAR; PG8_MMA(0, 0, At, B0); PG8_MMA(0, 1, At, B1); PG8_BAR; PG8_SCHED;
            PG8_LDA(At, 1, 1); PG8_STAGEB(PG8_SB(1, 0), b3); PG8_STAGEB(PG8_SB(1, 1), b3 + hstep); PG8_STAGE2(PG8_SA(1, 0), a3, w00, w01);
            PG8_WAIT_V(8); PG8_WAIT_L(0); PG8_BAR; PG8_MMA(1, 0, At, B0); PG8_MMA(1, 1, At, B1); PG8_BAR; PG8_SCHED;
        }
        if (wr == 0) PG8_BAR;
        { Unit ue; int a_ = cur.pm, b_ = cur.pn, c_ = cur.e; asm volatile("" : "+v"(a_), "+v"(b_), "+v"(c_));
          ue.pm = __builtin_amdgcn_readfirstlane(a_); ue.pn = __builtin_amdgcn_readfirstlane(b_); ue.e = __builtin_amdgcn_readfirstlane(c_);
          E(acc, ue, wr, wc, fr, fq); }
        if (!has_next) break;
#pragma unroll
        for (int a = 0; a < 2; ++a)
#pragma unroll
            for (int b = 0; b < 2; ++b)
#pragma unroll
                for (int m = 0; m < 4; ++m)
#pragma unroll
                    for (int n = 0; n < 2; ++n) acc[a][b][m][n] = (f32x4){0.f, 0.f, 0.f, 0.f};
        cur = nxt; cB = nB; cA = nA; ++ui;
        if constexpr (Sched::GATHER) { v00 = n00; v01 = n01; v10 = n10; v11 = n11; }
        if (wr == 1) PG8_BAR;
    }
    PG8_WAIT_V(0);
    PG8_BAR;
#undef PG8_SA
#undef PG8_SB
#undef PG8_STAGE2
#undef PG8_STAGEB
#undef PG8_LDA
#undef PG8_LDB
#undef PG8_MMA
#undef PG8_WAIT_V
#undef PG8_WAIT_L
#undef PG8_BAR
#undef PG8_SCHED
}
}
constexpr int NWAVES = 8;
constexpr int D = 2048, BATCH = 4, SEQ = 8192, T = BATCH * SEQ, DEPTH = 2;
constexpr int NIN = 18432, PLE = 256, NEXP = 32, DFF = 512;
constexpr int HT = 16384;
constexpr int NPROJ = 12288;
constexpr float EPS = 1e-6f;
constexpr int MAXTILES = 288;
constexpr int APAD = MAXTILES * 256;

constexpr size_t MiB = 1u << 20;
constexpr size_t WS_CTL = 0, CTL_ZERO_BYTES = 1 * MiB;
constexpr size_t WS_DT = 1 * MiB;
constexpr int DT_STRIDE = 512;
constexpr size_t WS_WR = 2 * MiB;
constexpr size_t WS_ROPE = 4 * MiB;
constexpr size_t WS_RS = 12 * MiB;
constexpr size_t WS_ROUTE = WS_RS + 128 * 1024;
constexpr size_t WS_INV = WS_ROUTE + 512 * 1024;
constexpr size_t WS_LTOK = WS_INV + 256 * 1024;
constexpr size_t WS_LW = WS_LTOK + 288 * 1024;
constexpr size_t WS_META = WS_LW + 288 * 1024;
constexpr size_t WS_LRS = WS_META + 4096;
constexpr size_t WS_PB = 16 * MiB;
constexpr size_t WS_W = 48 * MiB;
constexpr size_t W_IN = 0, W_OUT = 72 * MiB, W_GU = 80 * MiB, W_DN = 208 * MiB, W_PG = 272 * MiB, W_PP = 280 * MiB, W_LAYER = 282 * MiB;
constexpr size_t WS_HB = WS_W + 2 * W_LAYER;
constexpr size_t WS_PROJ = WS_HB + 128 * MiB;
constexpr size_t PJ = 64 * MiB;
constexpr size_t WS_QN = WS_PROJ, WS_KN = WS_PROJ + PJ, WS_VNT = WS_PROJ + 2 * PJ, WS_QR = WS_PROJ + 3 * PJ, WS_KR = WS_PROJ + 4 * PJ, WS_KZF = WS_PROJ + 5 * PJ, WS_KZB = WS_PROJ + 6 * PJ, WS_VRT = WS_PROJ + 7 * PJ;
constexpr size_t WS_OF = WS_KR;
constexpr size_t WS_PF = WS_PROJ + 8 * PJ, WS_PBW = WS_PF + 32 * MiB;
constexpr size_t WS_OB = WS_PBW + 32 * MiB;
constexpr size_t WS_MIX = WS_OB + 64 * MiB;
constexpr size_t WS_NA = WS_QN;
constexpr size_t WS_END = WS_MIX + 64 * MiB;
constexpr size_t XB_OFF = 128 * MiB;
constexpr size_t WS_XB2 = WS_PF;
constexpr size_t WS_ACT = WS_PROJ;
constexpr size_t WS_YP = WS_PROJ + 72 * MiB;
constexpr size_t WS_PP = WS_PROJ + 360 * MiB;
static_assert(WS_PP + 128 * MiB <= WS_PF, "pp inside proj region");
constexpr int CW_BAR = 4096;

constexpr int RING_BYTES = 131072;
constexpr int LDS_BYTES = 163840;
constexpr int MISC_OFF = LDS_BYTES - 1024;

#define GAS __attribute__((address_space(1)))
#define LAS __attribute__((address_space(3)))
typedef unsigned short bf16;
typedef unsigned v4u __attribute__((ext_vector_type(4)));
typedef unsigned v2u __attribute__((ext_vector_type(2)));
typedef float f32x4 __attribute__((ext_vector_type(4)));
typedef short bf16x8 __attribute__((ext_vector_type(8)));
#define LDS_WAIT() asm volatile("s_waitcnt lgkmcnt(0)" ::: "memory")
#define VM_WAIT() asm volatile("s_waitcnt vmcnt(0)" ::: "memory")
__device__ __forceinline__ unsigned f2bf(float f) { unsigned u = __builtin_bit_cast(unsigned, f); return (u + 0x7fffu + ((u >> 16) & 1u)) >> 16; }
__device__ __forceinline__ unsigned pk2(float lo, float hi) { return f2bf(lo) | (f2bf(hi) << 16); }
__device__ __forceinline__ float bf2f(unsigned b) { return __builtin_bit_cast(float, b << 16); }
__device__ __forceinline__ float bflo(unsigned w) { return __builtin_bit_cast(float, w << 16); }
__device__ __forceinline__ float bfhi(unsigned w) { return __builtin_bit_cast(float, w & 0xffff0000u); }
__device__ __forceinline__ float sigmoidf_(float x) { return __builtin_amdgcn_rcpf(1.0f + __expf(-x)); }
__device__ __forceinline__ float siluf_(float x) { return x * __builtin_amdgcn_rcpf(1.0f + __expf(-x)); }
__device__ __forceinline__ bf16x8 ld_frag16(const bf16* p) { return *(const GAS bf16x8*)p; }
__device__ __forceinline__ size_t qk_frag(int bl, int h, int tt, int ks) { return ((size_t)(((bl * 8 + h) * 512 + tt) * 8 + ks)) * 1024; }
__device__ __forceinline__ size_t kz_frag(int bl, int h, int c, int dt, int ks) { return ((size_t)((((bl * 8 + h) * 64 + c) * 16 + dt) * 4 + ks)) * 1024; }
__device__ __forceinline__ size_t p_frag(int unit, int it, int ks) { return ((size_t)((unit * 8 + it) * 4 + ks)) * 1024; }
__device__ __forceinline__ float shx(float v, int mask, int lane) { return __builtin_bit_cast(float, __builtin_amdgcn_ds_bpermute((lane ^ mask) << 2, __builtin_bit_cast(int, v))); }
__device__ __forceinline__ float wave_sum(float v, int lane) {
#pragma unroll
    for (int o = 1; o < 64; o <<= 1) v += shx(v, o, lane);
    return v;
}

#define XB_TMO      128
#define XB_XCNT(j)  (256  + 64 * (j))
#define XB_XSUB(j)  (1280 + 64 * (j))
#define XB_XGEN(j)  (2304 + 64 * (j))
#define XB_TOP      3328
#define XB_TOPGEN   3392
#define XCD_BAR_WORDS 3456
#define XB_SPIN_CAP (1u << 18)
__device__ __forceinline__ unsigned xb_ld(unsigned* p)              { return __hip_atomic_load(p, __ATOMIC_RELAXED, __HIP_MEMORY_SCOPE_AGENT); }
__device__ __forceinline__ unsigned xb_add(unsigned* p, unsigned v) { return __hip_atomic_fetch_add(p, v, __ATOMIC_RELAXED, __HIP_MEMORY_SCOPE_AGENT); }
__device__ __forceinline__ unsigned xb_xcc_id() { return (unsigned)__builtin_amdgcn_s_getreg((3 << 11) | 20) & 0xFu; }
#define XB_SPIN(cond, bar) do { unsigned _sp = 0; while (cond) { __builtin_amdgcn_s_sleep(1); \
    if ((++_sp & 255u) == 0u) { if (xb_ld(&(bar)[XB_TMO])) break; if (_sp > XB_SPIN_CAP) { atomicAdd(&(bar)[XB_TMO], 1u); break; } } } } while (0)
struct XcdBarrier { unsigned* bar; unsigned x; volatile LAS unsigned* st; };
__device__ __forceinline__ XcdBarrier xcd_barrier_post(unsigned* bar, volatile LAS unsigned* st, const bool t0) {
    XcdBarrier b; b.bar = bar; b.x = xb_xcc_id(); b.st = st;
    if (t0) (void)xb_add(&bar[XB_XCNT(b.x)], 1u);
    return b;
}
__device__ __forceinline__ void xcd_barrier_complete(unsigned* bar, unsigned x, unsigned& nloc, unsigned& nx) {
    const unsigned G = gridDim.x * gridDim.y * gridDim.z;
    unsigned sum, cnt, mine, sp = 0u;
    for (;;) {
        sum = 0u; cnt = 0u; mine = 0u;
#pragma unroll
        for (unsigned j = 0; j < 16; ++j) { const unsigned c = xb_ld(&bar[XB_XCNT(j)]); sum += c; cnt += (c > 0u) ? 1u : 0u; mine = (j == x) ? c : mine; }
        if (sum == G) break;
        __builtin_amdgcn_s_sleep(1);
        if ((++sp & 255u) == 0u) { if (xb_ld(&bar[XB_TMO])) break; if (sp > XB_SPIN_CAP) { atomicAdd(&bar[XB_TMO], 1u); break; } }
    }
    nloc = mine > 0u ? mine : 1u; nx = cnt > 0u ? cnt : 1u;
}
__device__ __forceinline__ void xcd_barrier(const XcdBarrier& b, const bool t0) {
    asm volatile("s_waitcnt vmcnt(0)" ::: "memory");
    __syncthreads();
    if (t0) {
        unsigned* bar = b.bar;
        __builtin_amdgcn_s_waitcnt(0);
        unsigned nloc = b.st[0], nx = b.st[1];
        if (nloc == 0u) { xcd_barrier_complete(bar, b.x, nloc, nx); b.st[0] = nloc; b.st[1] = nx; }
        const unsigned old = xb_add(&bar[XB_XSUB(b.x)], 1u);
        const unsigned gen = old / nloc;
        if (old + 1u == (gen + 1u) * nloc) {
            __builtin_amdgcn_fence(__ATOMIC_RELEASE, "agent");
            asm volatile("s_waitcnt vmcnt(0)" ::: "memory");
            const unsigned og = xb_add(&bar[XB_TOP], 1u);
            const unsigned tg = og / nx;
            if (og + 1u == (tg + 1u) * nx) xb_add(&bar[XB_TOPGEN], 1u);
            else XB_SPIN(xb_ld(&bar[XB_TOPGEN]) == tg, bar);
            __builtin_amdgcn_fence(__ATOMIC_ACQUIRE, "agent");
            xb_add(&bar[XB_XGEN(b.x)], 1u);
            asm volatile("s_waitcnt vmcnt(0)" ::: "memory");
        } else {
            XB_SPIN(xb_ld(&bar[XB_XGEN(b.x)]) == gen, bar);
            __builtin_amdgcn_fence(__ATOMIC_ACQUIRE, "agent");
            asm volatile("s_waitcnt vmcnt(0)" ::: "memory");
        }
    }
    __syncthreads();
}

struct Frame {
    LAS unsigned char* lds;
    volatile LAS unsigned* MISC;
    int tid, lane, wave, vcu, G;
    unsigned char* ws;
    float* out;
};
__device__ __forceinline__ void tr_item(const float* W, int K, int N, const float* gain, bf16* WT, int mode, LAS float* scr, int item, int lane) {
    const int nblk = N / 32, kb = item / nblk, nb = item % nblk, k0 = 64 * kb, n0 = 32 * nb;
    float cs = 1.0f;
    if (mode == 1) { if (n0 < 2048) cs = 0.12751743342f;     else if (n0 >= 8192 && n0 < 10240) cs = 0.0625f; }
    float wv[32];
#pragma unroll
    for (int i = 0; i < 32; ++i) wv[i] = W[(size_t)(k0 + 2 * i + (lane >> 5)) * N + n0 + (lane & 31)];
#pragma unroll
    for (int i = 0; i < 32; ++i) { const int kk = 2 * i + (lane >> 5); const float g = gain ? gain[k0 + kk] * cs : cs; scr[kk * 33 + (lane & 31)] = wv[i] * g; }
    LDS_WAIT(); asm volatile("" ::: "memory");
    const int c = lane & 7;
#pragma unroll
    for (int j = 0; j < 4; ++j) { const int n = (lane >> 3) + 8 * j; const LAS float* s = scr + (8 * c) * 33 + n;
        v4u o; o.x = pg8::cvt_pk_bf16(s[0 * 33], s[1 * 33]); o.y = pg8::cvt_pk_bf16(s[2 * 33], s[3 * 33]); o.z = pg8::cvt_pk_bf16(s[4 * 33], s[5 * 33]); o.w = pg8::cvt_pk_bf16(s[6 * 33], s[7 * 33]);
        const int nn = n0 + n; int dr = nn; if (mode == 2) dr = (nn >> 2) * 8 + (nn & 3); else if (mode == 3) dr = (nn >> 2) * 8 + 4 + (nn & 3);
        *(GAS v4u*)(WT + (size_t)dr * K + k0 + 8 * c) = o; }
    LDS_WAIT(); asm volatile("" ::: "memory");
}
__device__ __forceinline__ float log_sigmoidf_(float x) { return x >= 0.f ? -log1pf(expf(-x)) : x - log1pf(expf(x)); }

__device__ __forceinline__ void p0_prologue(Frame& F, const float* in_p, const float* in_nmix, const float* in_win, const float* in_decf, const float* in_decb, const float* in_wout, const float* in_nffn,
        const float* in_wrg, const float* in_wre, const float* in_wg, const float* in_wu, const float* in_wd, const float* in_nple, const float* in_wpg, const float* in_wpp) {
    LAS float* scr = (LAS float*)(F.lds + F.wave * 16384);
    const int gw = F.vcu * NWAVES + F.wave, NGW = F.G * NWAVES;
    constexpr int I_IN = 32 * 576, I_SQ = 2048, I_EX = 16384, I_PP = 256;
    constexpr int PER_LAYER = I_IN + I_SQ + 3 * I_EX + I_SQ + I_PP;
    for (int it = gw; it < DEPTH * PER_LAYER; it += NGW) {
        const int l = it / PER_LAYER; int r = it % PER_LAYER;
        unsigned char* wl = F.ws + WS_W + (size_t)l * W_LAYER;
        if (r < I_IN) { tr_item(in_win + (size_t)l * D * NIN, D, NIN, in_nmix + l * D, (bf16*)(wl + W_IN), 1, scr, r, F.lane); continue; } r -= I_IN;
        if (r < I_SQ) { tr_item(in_wout + (size_t)l * D * D, D, D, nullptr, (bf16*)(wl + W_OUT), 0, scr, r, F.lane); continue; } r -= I_SQ;
        if (r < I_EX) { const int e = r >> 9; tr_item(in_wg + ((size_t)l * NEXP + e) * D * DFF, D, DFF, in_nffn + l * D, (bf16*)(wl + W_GU) + (size_t)e * 1024 * D, 2, scr, r & 511, F.lane); continue; } r -= I_EX;
        if (r < I_EX) { const int e = r >> 9; tr_item(in_wu + ((size_t)l * NEXP + e) * D * DFF, D, DFF, in_nffn + l * D, (bf16*)(wl + W_GU) + (size_t)e * 1024 * D, 3, scr, r & 511, F.lane); continue; } r -= I_EX;
        if (r < I_EX) { const int e = r >> 9; tr_item(in_wd + ((size_t)l * NEXP + e) * DFF * D, DFF, D, nullptr, (bf16*)(wl + W_DN) + (size_t)e * D * DFF, 0, scr, r & 511, F.lane); continue; } r -= I_EX;
        if (r < I_SQ) { tr_item(in_wpg + (size_t)l * D * D, D, D, in_nple + l * D, (bf16*)(wl + W_PG), 0, scr, r, F.lane); continue; } r -= I_SQ;
        tr_item(in_wpp + (size_t)l * PLE * D, PLE, D, nullptr, (bf16*)(wl + W_PP), 0, scr, r, F.lane);
    }
    const int gt = F.vcu * (NWAVES * 64) + F.tid, NGT = F.G * NWAVES * 64;
    { float* cosT = (float*)(F.ws + WS_ROPE); float* sinT = cosT + SEQ * 128;
      for (int i = gt; i < SEQ * 128; i += NGT) { const int s = i >> 7, d = i & 127; const float inv = powf(10000.0f, -(float)d / 128.0f); const float ang = (float)s * inv; float sn, cs; sincosf(ang, &sn, &cs); cosT[i] = cs; sinT[i] = sn; } }
    { const float* p = in_p; bf16* pb = (bf16*)(F.ws + WS_PB);
      for (int i = gt; i < DEPTH * T * PLE / 8; i += NGT) { const f32x4 a = ((const GAS f32x4*)p)[2 * i], b = ((const GAS f32x4*)p)[2 * i + 1];
          v4u o; o.x = pg8::cvt_pk_bf16(a.x, a.y); o.y = pg8::cvt_pk_bf16(a.z, a.w); o.z = pg8::cvt_pk_bf16(b.x, b.y); o.w = pg8::cvt_pk_bf16(b.z, b.w); ((GAS v4u*)pb)[i] = o; } }
    { bf16* wr = (bf16*)(F.ws + WS_WR);
      for (int i = gt; i < DEPTH * 48 * D; i += NGT) { const int l = i / (48 * D), n = (i / D) % 48, k = i % D; float v = 0.f;
          if (n < 4) v = in_wrg[((size_t)l * D + k) * 4 + n]; else if (n < 36) v = in_wre[((size_t)l * D + k) * 32 + (n - 4)];
          v *= in_nffn[l * D + k];
          const unsigned hi = f2bf(v); const float lo = v - bf2f(hi);
          wr[((size_t)(l * 2 + 0) * 48 + n) * D + k] = (bf16)hi; wr[((size_t)(l * 2 + 1) * 48 + n) * D + k] = (bf16)f2bf(lo); } }
    { float* dt = (float*)(F.ws + WS_DT);
      for (int i = gt; i < DEPTH * 2 * 8 * 128; i += NGT) { const int j = i & 127, h = (i >> 7) & 7, dir = (i >> 10) & 1, l = i >> 11;
          const float x = dir == 0 ? in_decf[l * 8 + h] : in_decb[l * 8 + h]; const float lg = log_sigmoidf_(x);
          float* e = dt + (size_t)((l * 2 + dir) * 8 + h) * DT_STRIDE;
          if (j == 0) { e[0] = lg; e[1] = expf(128.0f * lg); }
          e[128 + j] = dir == 0 ? expf((float)(j + 1) * lg) : expf((float)(128 - j) * lg);
          e[256 + j] = dir == 0 ? expf((float)(127 - j) * lg) : expf((float)j * lg); } }
}

#define WSEL(w) 1.0f
template <int MODE, bool SRCF>
__device__ __forceinline__ void rowpass(Frame& F, const float* src, float* dst, const float* gfin) {
    bf16* xb = (bf16*)((unsigned char*)F.out + XB_OFF); const bf16* xs = MODE == 2 ? (const bf16*)(F.ws + WS_XB2) : xb;
    const int gw = F.vcu * NWAVES + F.wave, NGW = F.G * NWAVES;
    bf16* hb = (bf16*)(F.ws + WS_HB); float* rs = (float*)(F.ws + WS_RS);
    const int* inv = (const int*)(F.ws + WS_INV); const bf16* yp = (const bf16*)(F.ws + WS_YP);
    f32x4 gq[8];
    if (MODE == 2) {
#pragma unroll
        for (int j = 0; j < 8; ++j) gq[j] = ((const GAS f32x4*)gfin)[F.lane + 64 * j];
    }
    for (int m = gw; m < T; m += NGW) {
        f32x4 v[8]; float s = 0.f;
        if (SRCF) { const GAS f32x4* xr = (const GAS f32x4*)(src + (size_t)m * D) + F.lane;
#pragma unroll
            for (int j = 0; j < 8; ++j) v[j] = xr[64 * j];
            GAS v2u* xo = (GAS v2u*)(xb + (size_t)m * D) + F.lane;
#pragma unroll
            for (int j = 0; j < 8; ++j) { v2u o; o.x = pg8::cvt_pk_bf16(v[j].x, v[j].y); o.y = pg8::cvt_pk_bf16(v[j].z, v[j].w); xo[64 * j] = o; }
        } else { const GAS v2u* xr = (const GAS v2u*)(xs + (size_t)m * D) + F.lane;
#pragma unroll
            for (int j = 0; j < 8; ++j) { const v2u a = xr[64 * j]; v[j] = (f32x4){bflo(a.x), bfhi(a.x), bflo(a.y), bfhi(a.y)}; } }
        if (MODE == 1) {
            const int p0 = inv[2 * m], p1 = inv[2 * m + 1]; const v4u rt = ((const v4u*)(F.ws + WS_ROUTE))[m]; const float w0 = __builtin_bit_cast(float, rt.z), w1 = __builtin_bit_cast(float, rt.w);
            const GAS v2u* y0 = (const GAS v2u*)(yp + (size_t)p0 * D) + F.lane; const GAS v2u* y1 = (const GAS v2u*)(yp + (size_t)p1 * D) + F.lane;
#pragma unroll
            for (int j = 0; j < 8; ++j) { const v2u a = y0[64 * j], b = y1[64 * j];
                v[j].x += WSEL(w0) * bflo(a.x) + WSEL(w1) * bflo(b.x); v[j].y += WSEL(w0) * bfhi(a.x) + WSEL(w1) * bfhi(b.x); v[j].z += WSEL(w0) * bflo(a.y) + WSEL(w1) * bflo(b.y); v[j].w += WSEL(w0) * bfhi(a.y) + WSEL(w1) * bfhi(b.y); }
            GAS v2u* xo = (GAS v2u*)(xb + (size_t)m * D) + F.lane;
#pragma unroll
            for (int j = 0; j < 8; ++j) { v2u o; o.x = pg8::cvt_pk_bf16(v[j].x, v[j].y); o.y = pg8::cvt_pk_bf16(v[j].z, v[j].w); xo[64 * j] = o; }
        }
#pragma unroll
        for (int j = 0; j < 8; ++j) s += (v[j].x * v[j].x + v[j].y * v[j].y) + (v[j].z * v[j].z + v[j].w * v[j].w);
        const float r = 1.0f / sqrtf(wave_sum(s, F.lane) * (1.0f / D) + EPS);
        if (MODE == 2) {
            GAS f32x4* xo = (GAS f32x4*)(dst + (size_t)m * D) + F.lane;
#pragma unroll
            for (int j = 0; j < 8; ++j) xo[64 * j] = v[j] * r * gq[j];
        } else {
            GAS v2u* o8 = (GAS v2u*)(hb + (size_t)m * D) + F.lane;
#pragma unroll
            for (int j = 0; j < 8; ++j) { v2u o; o.x = pg8::cvt_pk_bf16(v[j].x * r, v[j].y * r); o.y = pg8::cvt_pk_bf16(v[j].z * r, v[j].w * r); o8[64 * j] = o; }
            if (F.lane == 0) rs[m] = r;
        }
    }
}

__device__ __forceinline__ void router_phase(Frame& F, int layer) {
    const int NGW = F.G * NWAVES, fr = F.lane & 15, g = F.lane >> 4;
    const bf16* wr = (const bf16*)(F.ws + WS_WR) + (size_t)layer * 2 * 48 * D;
    float* rsw = (float*)(F.ws + WS_RS); const bf16* xb = (const bf16*)((unsigned char*)F.out + XB_OFF); v4u* route = (v4u*)(F.ws + WS_ROUTE);
    LAS float* lg = (LAS float*)(F.lds + F.wave * 4096);
    constexpr unsigned WB = 32768u, WROW = 528u, WBUF = 96u * WROW;
    const int srow = F.tid >> 5, scol = F.tid & 31;
    const bf16* wsrc = wr + (size_t)srow * D + scol * 8;
    const unsigned wdst = WB + (unsigned)srow * WROW + (unsigned)scol * 16u, bfrag = WB + (unsigned)fr * WROW + (unsigned)g * 16u;
    for (int base = 0; base < T / 16; base += NGW) {
        const int tile = base + F.vcu * NWAVES + F.wave; const bool live = tile < T / 16; const int t0 = (live ? tile : 0) * 16;
        f32x4 acc[3]; acc[0] = acc[1] = acc[2] = (f32x4){0.f, 0.f, 0.f, 0.f}; float ssq = 0.f;
        const bf16* xrow = xb + (size_t)(t0 + fr) * D + 8 * g;
        v4u wreg[6], xc[8], xn[8];
#pragma unroll
        for (int i = 0; i < 6; ++i) wreg[i] = *(const GAS v4u*)(wsrc + (size_t)i * 16 * D);
#pragma unroll
        for (int k = 0; k < 8; ++k) xc[k] = *(const GAS v4u*)(xrow + 32 * k);
#pragma unroll 1
        for (int c = 0; c < 8; ++c) {
            const unsigned bo = (unsigned)(c & 1) * WBUF;
#pragma unroll
            for (int i = 0; i < 6; ++i) *(LAS v4u*)(F.lds + wdst + bo + (unsigned)i * 16u * WROW) = wreg[i];
            __syncthreads();
            if (c + 1 < 8) {
#pragma unroll
                for (int i = 0; i < 6; ++i) wreg[i] = *(const GAS v4u*)(wsrc + (size_t)i * 16 * D + 256 * (c + 1));
#pragma unroll
                for (int k = 0; k < 8; ++k) xn[k] = *(const GAS v4u*)(xrow + 256 * (c + 1) + 32 * k);
            }
#pragma unroll
            for (int ksl = 0; ksl < 8; ++ksl) {
                const v4u a = xc[ksl];
                { const float x0 = bflo(a.x), x1 = bfhi(a.x), x2 = bflo(a.y), x3 = bfhi(a.y), x4 = bflo(a.z), x5 = bfhi(a.z), x6 = bflo(a.w), x7 = bfhi(a.w);
                  ssq += (x0 * x0 + x1 * x1) + (x2 * x2 + x3 * x3) + (x4 * x4 + x5 * x5) + (x6 * x6 + x7 * x7); }
                const bf16x8 ah = __builtin_bit_cast(bf16x8, a);
#pragma unroll
                for (int nt = 0; nt < 3; ++nt) {
                    const bf16x8 bh = *(const LAS bf16x8*)(F.lds + bfrag + bo + (unsigned)(16 * nt) * WROW + (unsigned)ksl * 64u);
                    const bf16x8 bl = *(const LAS bf16x8*)(F.lds + bfrag + bo + (unsigned)(48 + 16 * nt) * WROW + (unsigned)ksl * 64u);
                    acc[nt] = __builtin_amdgcn_mfma_f32_16x16x32_bf16(ah, bh, acc[nt], 0, 0, 0);
                    acc[nt] = __builtin_amdgcn_mfma_f32_16x16x32_bf16(ah, bl, acc[nt], 0, 0, 0);
                }
            }
#pragma unroll
            for (int k = 0; k < 8; ++k) xc[k] = xn[k];
        }
        ssq += shx(ssq, 16, F.lane); ssq += shx(ssq, 32, F.lane);
        const float rtok = 1.0f / sqrtf(ssq * (1.0f / D) + EPS);
        if (g == 0 && live) rsw[t0 + fr] = rtok;
#pragma unroll
        for (int nt = 0; nt < 3; ++nt)
#pragma unroll
            for (int r = 0; r < 4; ++r) lg[(4 * g + r) * 52 + 16 * nt + fr] = acc[nt][r];
        LDS_WAIT(); asm volatile("" ::: "memory");
        if (F.lane < 16) {
            const int t = t0 + F.lane; const float rr = rtok; const LAS float* L = lg + F.lane * 52;
            float gl[4]; int gs = 0; float gm = -3.0e38f;
#pragma unroll
            for (int i = 0; i < 4; ++i) { gl[i] = L[i] * rr; if (gl[i] > gm) { gm = gl[i]; gs = i; } }
            float se = 0.f;
#pragma unroll
            for (int i = 0; i < 4; ++i) se += expf(gl[i] - gm);
            const float pg = 1.0f / se;
            float v0 = -3.0e38f, v1 = -3.0e38f; int i0 = 0, i1 = 0;
            for (int i = 0; i < 8; ++i) { const float v = L[4 + 8 * gs + i] * rr;
                if (v > v0) { v1 = v0; i1 = i0; v0 = v; i0 = i; } else if (v > v1) { v1 = v; i1 = i; } }
            const float e1 = expf(v1 - v0); const float w0 = pg / (1.0f + e1), w1 = pg * e1 / (1.0f + e1);
            v4u o; o.x = (unsigned)(gs * 8 + i0); o.y = (unsigned)(gs * 8 + i1); o.z = __builtin_bit_cast(unsigned, w0); o.w = __builtin_bit_cast(unsigned, w1);
            if (live) { route[t] = o;
                int* cnt = (int*)(F.ws + WS_CTL + 262144) + layer * 256;
                __hip_atomic_fetch_add(cnt + (gs * 8 + i0) * 8 + (t >> 12), 1, __ATOMIC_RELAXED, __HIP_MEMORY_SCOPE_AGENT); __hip_atomic_fetch_add(cnt + (gs * 8 + i1) * 8 + (t >> 12), 1, __ATOMIC_RELAXED, __HIP_MEMORY_SCOPE_AGENT); }
        }
        LDS_WAIT(); asm volatile("" ::: "memory");
    }
}

__device__ __forceinline__ void lists_phase(Frame& F, int layer) {
    const v4u* route = (const v4u*)(F.ws + WS_ROUTE);
    int* inv = (int*)(F.ws + WS_INV); int* ltok = (int*)(F.ws + WS_LTOK); float* lw = (float*)(F.ws + WS_LW); int* meta = (int*)(F.ws + WS_META); const float* rsr = (const float*)(F.ws + WS_RS); float* lrs = (float*)(F.ws + WS_LRS);
    LAS int* hist = (LAS int*)F.lds;
    const int c = F.vcu; if (c >= 256) return;
    const int e = c >> 3, part = c & 7;
    if (F.tid < 256) hist[128 + F.tid] = __hip_atomic_load((const int*)(F.ws + WS_CTL + 262144) + layer * 256 + F.tid, __ATOMIC_RELAXED, __HIP_MEMORY_SCOPE_AGENT);
    __syncthreads();
    if (F.tid < 32) { int s_ = 0; for (int p_ = 0; p_ < 8; ++p_) s_ += hist[128 + F.tid * 8 + p_]; hist[F.tid] = s_; }
    if (F.tid == 32) { int s_ = 0; for (int p_ = 0; p_ < part; ++p_) s_ += hist[128 + e * 8 + p_]; hist[32] = s_; }
    __syncthreads();
    if (F.tid == 0) { int acc = 0; for (int i = 0; i < 32; ++i) { hist[64 + i] = acc; acc += (hist[i] + 255) >> 8; } hist[96] = acc; }
    __syncthreads();
    if (c == 0 && F.tid < 33) meta[F.tid] = hist[64 + F.tid];
    const int region = hist[64 + e] * 256; int base = hist[32];
    const int cnt_e = hist[e];
    for (int ch = 0; ch < (T / 8) / 512; ++ch) {
        const int t = part * (T / 8) + ch * 512 + F.tid; const v4u r = route[t];
        const int m0 = ((int)r.x == e), m1 = ((int)r.y == e);
        const int mt = m0 | m1;
        const unsigned long long bal = __ballot(mt);
        const int pre = __popcll(bal & ((1ull << F.lane) - 1ull)); const int wc = __popcll(bal);
        __syncthreads();
        if (F.lane == 0) hist[40 + F.wave] = wc;
        __syncthreads();
        int woff = 0, tot = 0;
#pragma unroll
        for (int w = 0; w < NWAVES; ++w) { const int cw = hist[40 + w]; if (w < F.wave) woff += cw; tot += cw; }
        if (mt) { const int pos = region + base + woff + pre; ltok[pos] = t; lrs[pos] = rsr[t]; lw[pos] = __builtin_bit_cast(float, m0 ? r.z : r.w); inv[2 * t + (m0 ? 0 : 1)] = pos; }
        base += tot;
    }
    if (part == 7) { const int padend = ((cnt_e + 255) >> 8) * 256; for (int p = cnt_e + F.tid; p < padend; p += NWAVES * 64) { ltok[region + p] = 0; lw[region + p] = 0.f; lrs[region + p] = 0.f; } }
    __syncthreads();
}

constexpr int NA_KB = 64 * 272, NA_VB = 64 * 288, NA_RPB = 2 * NA_KB + 2 * NA_VB;
typedef short s16x4 __attribute__((ext_vector_type(4)));
__device__ __forceinline__ s16x4 tr_read16(unsigned addr) { s16x4 r; asm volatile("ds_read_b64_tr_b16 %0, %1" : "=&v"(r) : "v"(addr) : "memory"); return r; }
template <int OFF> __device__ __forceinline__ s16x4 tr_read16o(unsigned addr) { s16x4 r; asm volatile("ds_read_b64_tr_b16 %0, %1 offset:%2" : "=&v"(r) : "v"(addr), "i"(OFF) : "memory"); return r; }
__device__ __forceinline__ void na_unit4(Frame& F, const bf16* Qn, const bf16* Kn, const bf16* Vn, bf16* out, const float* rpb, int u) {
    const int bl = u >> 9, h = (u >> 5) & 15, r0 = (u & 31) * 4;
    const int rq = r0 + (F.wave >> 1), qp = F.wave & 1, fr = F.lane & 15, g = F.lane >> 4;
    const int rs_row = min(max(rq - 4, 0), 120);
    const int kr_lo = min(max(r0 - 4, 0), 120), kr_hi = min(max(r0 - 1, 0), 120) + 7, nkr = kr_hi - kr_lo + 1;
    bf16x8 qf[2][4]; f32x4 o[2][8]; float mrun[2], lrun[2];
#pragma unroll
    for (int j = 0; j < 2; ++j) { const int tq = bl * SEQ + rq * 64 + 16 * (2 * qp + j) + fr;
#pragma unroll
        for (int ks = 0; ks < 4; ++ks) qf[j][ks] = ld_frag16(Qn + ((size_t)(bl * 16 + h) * SEQ + (tq - bl * SEQ)) * 128 + 32 * ks + 8 * g);
#pragma unroll
        for (int dt = 0; dt < 8; ++dt) o[j][dt] = (f32x4){0.f, 0.f, 0.f, 0.f};
        mrun[j] = -1e30f; lrun[j] = 0.f; }
    const int c0i = F.tid >> 4, d0i = F.tid & 15;
    const bf16* kg = Kn + (size_t)(bl * 16 + h) * SEQ * 128 + d0i * 8;
    const bf16* vg = Vn + (size_t)(bl * 16 + h) * SEQ * 128 + d0i * 8;
    const unsigned kl0 = (unsigned)(c0i * 272 + d0i * 16), vl0 = (unsigned)(2 * NA_KB + c0i * 288 + d0i * 16);
#define NA_TR8(LO, HI, VA, O0) do { LO[0] = tr_read16o<(O0)>(VA); HI[0] = tr_read16o<(O0) + 4608>(VA); LO[1] = tr_read16o<(O0) + 32>(VA); HI[1] = tr_read16o<(O0) + 4640>(VA); \
        LO[2] = tr_read16o<(O0) + 64>(VA); HI[2] = tr_read16o<(O0) + 4672>(VA); LO[3] = tr_read16o<(O0) + 96>(VA); HI[3] = tr_read16o<(O0) + 4704>(VA); } while (0)
#define NA_COMPUTE() do { \
        if (kr >= rs_row && kr < rs_row + 8) { \
            const LAS unsigned char* Kl = F.lds + buf * NA_KB; const unsigned Vl = (unsigned)(2 * NA_KB + buf * NA_VB); \
            const unsigned brow = (unsigned)(NA_RPB + (kr - rq + 7) * 128);     \
            const int kc0[2] = {qp == 0 ? 0 : 24, qp == 0 ? 8 : 32}; \
            unsigned bp[2][2] = {{bpk[0][0], bpk[0][1]}, {bpk[1][0], bpk[1][1]}}; asm volatile("" : "+v"(bp[0][0]), "+v"(bp[0][1]), "+v"(bp[1][0]), "+v"(bp[1][1]));     \
            f32x4 sc[2][2]; float bb[2][2][4]; \
        _Pragma("unroll") \
            for (int j = 0; j < 2; ++j) \
        _Pragma("unroll") \
              for (int kb = 0; kb < 2; ++kb) \
        _Pragma("unroll") \
                for (int rg = 0; rg < 4; ++rg) bb[j][kb][rg] = *(const LAS float*)(F.lds + brow + ((bp[j][kb] >> (8 * rg)) & 0xffu)); \
        _Pragma("unroll") \
            for (int kb = 0; kb < 2; ++kb) { bf16x8 kf[2][4]; \
        _Pragma("unroll") \
              for (int j = 0; j < 2; ++j) \
        _Pragma("unroll") \
                  for (int ks = 0; ks < 4; ++ks) kf[j][ks] = *(const LAS bf16x8*)(Kl + (kc0[j] + 16 * kb + fr) * 272 + (32 * ks + 8 * g) * 2); \
              asm volatile("s_waitcnt lgkmcnt(0)" ::: "memory"); __builtin_amdgcn_sched_barrier(0); \
        _Pragma("unroll") \
              for (int j = 0; j < 2; ++j) { f32x4 a = (f32x4){0.f, 0.f, 0.f, 0.f}; \
        _Pragma("unroll") \
                  for (int ks = 0; ks < 4; ++ks) a = __builtin_amdgcn_mfma_f32_16x16x32_bf16(kf[j][ks], qf[j][ks], a, 0, 0, 0); \
                  sc[j][kb] = a; } \
              __builtin_amdgcn_sched_barrier(0); } \
            float tmax[2] = {-1e30f, -1e30f}; \
        _Pragma("unroll") \
            for (int j = 0; j < 2; ++j) \
        _Pragma("unroll") \
              for (int kb = 0; kb < 2; ++kb) \
        _Pragma("unroll") \
                for (int rg = 0; rg < 4; ++rg) { const float sv = sc[j][kb][rg] + bb[j][kb][rg]; sc[j][kb][rg] = sv; tmax[j] = fmaxf(tmax[j], sv); } \
            { const float t0 = shx(tmax[0], 16, F.lane), t1 = shx(tmax[1], 16, F.lane); tmax[0] = fmaxf(tmax[0], t0); tmax[1] = fmaxf(tmax[1], t1); } \
            { const float t0 = shx(tmax[0], 32, F.lane), t1 = shx(tmax[1], 32, F.lane); tmax[0] = fmaxf(tmax[0], t0); tmax[1] = fmaxf(tmax[1], t1); } \
            bf16x8 pf[2]; float alpha[2]; \
        _Pragma("unroll") \
            for (int j = 0; j < 2; ++j) { \
                const float mnew = fmaxf(mrun[j], tmax[j]); alpha[j] = __builtin_amdgcn_exp2f(mrun[j] - mnew); mrun[j] = mnew; \
                float ps = 0.f; \
        _Pragma("unroll") \
                for (int kb = 0; kb < 2; ++kb) \
        _Pragma("unroll") \
                    for (int rg = 0; rg < 4; ++rg) { const float p = __builtin_amdgcn_exp2f(sc[j][kb][rg] - mnew); sc[j][kb][rg] = p; ps += p; } \
                lrun[j] = lrun[j] * alpha[j] + ps; \
                v4u pw; pw.x = pg8::cvt_pk_bf16(sc[j][0][0], sc[j][0][1]); pw.y = pg8::cvt_pk_bf16(sc[j][0][2], sc[j][0][3]); pw.z = pg8::cvt_pk_bf16(sc[j][1][0], sc[j][1][1]); pw.w = pg8::cvt_pk_bf16(sc[j][1][2], sc[j][1][3]); \
                pf[j] = __builtin_bit_cast(bf16x8, pw); } \
            if (__any(alpha[0] != 1.0f || alpha[1] != 1.0f)) {     \
        _Pragma("unroll") \
                for (int j = 0; j < 2; ++j) \
        _Pragma("unroll") \
                    for (int dt = 0; dt < 8; ++dt) o[j][dt] = o[j][dt] * alpha[j]; } \
            const unsigned va0 = Vl + (unsigned)((kc0[0] + 4 * g + (fr >> 2)) * 288 + (fr & 3) * 8), va1 = Vl + (unsigned)((kc0[1] + 4 * g + (fr >> 2)) * 288 + (fr & 3) * 8); \
            { s16x4 lo0[4], hi0[4], lo1[4], hi1[4]; \
              NA_TR8(lo0, hi0, va0, 0); NA_TR8(lo1, hi1, va1, 0); \
              asm volatile("s_waitcnt lgkmcnt(0)" ::: "memory"); __builtin_amdgcn_sched_barrier(0); \
        _Pragma("unroll") \
              for (int d4 = 0; d4 < 4; ++d4) { \
                  o[0][d4] = __builtin_amdgcn_mfma_f32_16x16x32_bf16((bf16x8){lo0[d4][0], lo0[d4][1], lo0[d4][2], lo0[d4][3], hi0[d4][0], hi0[d4][1], hi0[d4][2], hi0[d4][3]}, pf[0], o[0][d4], 0, 0, 0); \
                  o[1][d4] = __builtin_amdgcn_mfma_f32_16x16x32_bf16((bf16x8){lo1[d4][0], lo1[d4][1], lo1[d4][2], lo1[d4][3], hi1[d4][0], hi1[d4][1], hi1[d4][2], hi1[d4][3]}, pf[1], o[1][d4], 0, 0, 0); } \
              __builtin_amdgcn_sched_barrier(0); \
              NA_TR8(lo0, hi0, va0, 128); NA_TR8(lo1, hi1, va1, 128); \
              asm volatile("s_waitcnt lgkmcnt(0)" ::: "memory"); __builtin_amdgcn_sched_barrier(0); \
        _Pragma("unroll") \
              for (int d4 = 0; d4 < 4; ++d4) { \
                  o[0][4 + d4] = __builtin_amdgcn_mfma_f32_16x16x32_bf16((bf16x8){lo0[d4][0], lo0[d4][1], lo0[d4][2], lo0[d4][3], hi0[d4][0], hi0[d4][1], hi0[d4][2], hi0[d4][3]}, pf[0], o[0][4 + d4], 0, 0, 0); \
                  o[1][4 + d4] = __builtin_amdgcn_mfma_f32_16x16x32_bf16((bf16x8){lo1[d4][0], lo1[d4][1], lo1[d4][2], lo1[d4][3], hi1[d4][0], hi1[d4][1], hi1[d4][2], hi1[d4][3]}, pf[1], o[1][4 + d4], 0, 0, 0); } } \
        } \
    } while (0)
    unsigned bpk[2][2];
#pragma unroll
    for (int j = 0; j < 2; ++j) { const int kc0_ = j == 0 ? (qp == 0 ? 0 : 24) : (qp == 0 ? 8 : 32), qc_ = 32 * qp + 16 * j + fr, cs_ = min(max(qc_ - 8, 0), 48);
#pragma unroll
        for (int kb = 0; kb < 2; ++kb) { unsigned pk = 0u;
#pragma unroll
            for (int rg = 0; rg < 4; ++rg) { const int kcol = kc0_ + 16 * kb + 4 * g + rg; const bool valid = (kcol >= cs_) && (kcol < cs_ + 16); const int dc = valid ? min(max(kcol - qc_, -15), 15) + 15 : 31; pk |= (unsigned)(4 * dc) << (8 * rg); }
            bpk[j][kb] = pk; } }
    v4u kA0, kA1, vA0, vA1, kB0, kB1, vB0, vB1;
#define NA_LOAD(k0, k1, v0, v1, row) do { const size_t ro_ = (size_t)((row) * 64 + c0i) * 128; k0 = *(const GAS v4u*)(kg + ro_); k1 = *(const GAS v4u*)(kg + ro_ + (size_t)32 * 128); v0 = *(const GAS v4u*)(vg + ro_); v1 = *(const GAS v4u*)(vg + ro_ + (size_t)32 * 128); } while (0)
#define NA_WRITE(k0, k1, v0, v1, b) do { const unsigned bo_ = (unsigned)((b) * NA_KB), bv_ = (unsigned)((b) * NA_VB); *(LAS v4u*)(F.lds + kl0 + bo_) = k0; *(LAS v4u*)(F.lds + kl0 + bo_ + 32 * 272) = k1; *(LAS v4u*)(F.lds + vl0 + bv_) = v0; *(LAS v4u*)(F.lds + vl0 + bv_ + 32 * 288) = v1; } while (0)
    if (F.tid < 480) { const int r_ = F.tid >> 5, c_ = F.tid & 31; *(LAS float*)(F.lds + NA_RPB + 4 * F.tid) = c_ < 31 ? rpb[h * 465 + r_ * 31 + c_] * 1.4426950408889634f : -1e30f; }
    NA_LOAD(kA0, kA1, vA0, vA1, kr_lo);
    if (nkr > 1) NA_LOAD(kB0, kB1, vB0, vB1, kr_lo + 1);
    NA_WRITE(kA0, kA1, vA0, vA1, 0);
    __syncthreads();
#define NA_STEP(S, BUF, LK0, LK1, LV0, LV1, WK0, WK1, WV0, WV1) do { \
        const int s = (S); const int kr = kr_lo + s; constexpr int buf = (BUF); \
        if (s + 2 < nkr) NA_LOAD(LK0, LK1, LV0, LV1, kr + 2); \
        NA_COMPUTE(); \
        if (s + 1 < nkr) NA_WRITE(WK0, WK1, WV0, WV1, buf ^ 1); \
        asm volatile("s_waitcnt lgkmcnt(0)" ::: "memory"); __builtin_amdgcn_s_barrier(); asm volatile("" ::: "memory"); } while (0)
#pragma unroll 1
    for (int s2 = 0; s2 < nkr; s2 += 2) {
        NA_STEP(s2, 0, kA0, kA1, vA0, vA1, kB0, kB1, vB0, vB1);
        if (s2 + 1 < nkr) NA_STEP(s2 + 1, 1, kB0, kB1, vB0, vB1, kA0, kA1, vA0, vA1);
    }
#undef NA_STEP
#undef NA_LOAD
#undef NA_WRITE
#undef NA_COMPUTE
#undef NA_TR8
#pragma unroll
    for (int j = 0; j < 2; ++j) { float l = lrun[j]; l += shx(l, 16, F.lane); l += shx(l, 32, F.lane); const float inv = 1.0f / l;
        const int tq = bl * SEQ + rq * 64 + 16 * (2 * qp + j) + fr;
#pragma unroll
        for (int dt = 0; dt < 8; ++dt) { v2u w; w.x = pg8::cvt_pk_bf16(o[j][dt][0] * inv, o[j][dt][1] * inv); w.y = pg8::cvt_pk_bf16(o[j][dt][2] * inv, o[j][dt][3] * inv);
            *(GAS v2u*)(out + ((size_t)(bl * 16 + h) * SEQ + (tq - bl * SEQ)) * 128 + 16 * dt + 4 * g) = w; } }
}

__device__ __forceinline__ void rp_unit(Frame& F, const bf16* Qr, const bf16* Kr, bf16* Pf, bf16* Pb, const float* dtl  , int u) {
    const int bl = u >> 9, h = (u >> 6) & 7, c = u & 63, fr = F.lane & 15, g = F.lane >> 4;
    const int t0 = bl * SEQ + c * 128, il = 16 * F.wave + fr;
    const float lgf = dtl[(0 * 8 + h) * DT_STRIDE] * 1.4426950408889634f, lgb = dtl[(1 * 8 + h) * DT_STRIDE] * 1.4426950408889634f;
    bf16x8 qf[8];
#pragma unroll
    for (int ks = 0; ks < 8; ++ks) qf[ks] = *(const GAS bf16x8*)((const char*)Qr + qk_frag(bl, h, c * 8 + F.wave, ks) + F.lane * 16);
#pragma unroll 4
    for (int jt = 0; jt < 8; ++jt) {
        f32x4 a = (f32x4){0.f, 0.f, 0.f, 0.f};
#pragma unroll
        for (int ks = 0; ks < 8; ++ks) { const bf16x8 kf = *(const GAS bf16x8*)((const char*)Kr + qk_frag(bl, h, c * 8 + jt, ks) + F.lane * 16); a = __builtin_amdgcn_mfma_f32_16x16x32_bf16(kf, qf[ks], a, 0, 0, 0); }
        float pf[4], pb[4];
#pragma unroll
        for (int rg = 0; rg < 4; ++rg) { const int j = 16 * jt + 4 * g + rg, diff = il - j;
            const float dec = __builtin_amdgcn_exp2f(diff >= 0 ? (float)diff * lgf : (float)(-diff) * lgb) * a[rg];
            pf[rg] = diff >= 0 ? dec : 0.f; pb[rg] = diff < 0 ? dec : 0.f; }
        const size_t po = p_frag(u, F.wave, jt >> 1) + (size_t)((fr + 16 * (2 * (jt & 1) + (g >> 1))) * 16 + 8 * (g & 1));
        v2u w; w.x = pg8::cvt_pk_bf16(pf[0], pf[1]); w.y = pg8::cvt_pk_bf16(pf[2], pf[3]); *(GAS v2u*)((char*)Pf + po) = w;
        w.x = pg8::cvt_pk_bf16(pb[0], pb[1]); w.y = pg8::cvt_pk_bf16(pb[2], pb[3]); *(GAS v2u*)((char*)Pb + po) = w;
    }
}

__device__ __forceinline__ void rp_wg(Frame& F, const bf16* Qr, const bf16* Kr, bf16* Pf, bf16* Pb, const float* dtl  , int u0) {
    const int bl = u0 >> 9, h = (u0 >> 6) & 7, c0 = u0 & 63, fr = F.lane & 15, g = F.lane >> 4;
    const int il = 16 * F.wave + fr;
    const float lgf = dtl[(0 * 8 + h) * DT_STRIDE] * 1.4426950408889634f, lgb = dtl[(1 * 8 + h) * DT_STRIDE] * 1.4426950408889634f;
    const char* kbase = (const char*)Kr + qk_frag(bl, h, c0 * 8, 0) + (size_t)(F.wave * 8) * 1024 + (size_t)F.lane * 16;
    const char* qbase = (const char*)Qr + qk_frag(bl, h, c0 * 8 + F.wave, 0) + (size_t)F.lane * 16;
#define RP_DMA(k, buf) do { _Pragma("unroll") for (int ks_ = 0; ks_ < 8; ++ks_) \
        __builtin_amdgcn_global_load_lds((const unsigned*)(kbase + (size_t)(k) * 65536 + (size_t)ks_ * 1024), (LAS unsigned*)(F.lds + (buf) * 65536 + (F.wave * 8 + ks_) * 1024), 16, 0, 0); } while (0)
    bf16x8 qf[8], qn[8];
    RP_DMA(0, 0);
#pragma unroll
    for (int ks = 0; ks < 8; ++ks) qf[ks] = *(const GAS bf16x8*)(qbase + (size_t)ks * 1024);
#pragma unroll 1
    for (int k = 0; k < 4; ++k) {
        asm volatile("s_waitcnt vmcnt(0)" ::: "memory");
        __syncthreads();
        if (k + 1 < 4) { RP_DMA(k + 1, (k + 1) & 1);
#pragma unroll
            for (int ks = 0; ks < 8; ++ks) qn[ks] = *(const GAS bf16x8*)(qbase + (size_t)(k + 1) * 65536 + (size_t)ks * 1024); }
        const LAS unsigned char* KB = F.lds + (k & 1) * 65536 + F.lane * 16;
        const int u = u0 + k;
#pragma unroll 4
        for (int jt = 0; jt < 8; ++jt) {
            f32x4 a = (f32x4){0.f, 0.f, 0.f, 0.f};
#pragma unroll
            for (int ks = 0; ks < 8; ++ks) { const bf16x8 kf = *(const LAS bf16x8*)(KB + (jt * 8 + ks) * 1024); a = __builtin_amdgcn_mfma_f32_16x16x32_bf16(kf, qf[ks], a, 0, 0, 0); }
            float pf[4], pb[4];
#pragma unroll
            for (int rg = 0; rg < 4; ++rg) { const int j = 16 * jt + 4 * g + rg, diff = il - j;
                const float dec = __builtin_amdgcn_exp2f(diff >= 0 ? (float)diff * lgf : (float)(-diff) * lgb) * a[rg];
                pf[rg] = diff >= 0 ? dec : 0.f; pb[rg] = diff < 0 ? dec : 0.f; }
            const size_t po = p_frag(u, F.wave, jt >> 1) + (size_t)((fr + 16 * (2 * (jt & 1) + (g >> 1))) * 16 + 8 * (g & 1));
            v2u w; w.x = pg8::cvt_pk_bf16(pf[0], pf[1]); w.y = pg8::cvt_pk_bf16(pf[2], pf[3]); *(GAS v2u*)((char*)Pf + po) = w;
            w.x = pg8::cvt_pk_bf16(pb[0], pb[1]); w.y = pg8::cvt_pk_bf16(pb[2], pb[3]); *(GAS v2u*)((char*)Pb + po) = w;
        }
#pragma unroll
        for (int ks = 0; ks < 8; ++ks) qf[ks] = qn[ks];
    }
#undef RP_DMA
    asm volatile("s_waitcnt vmcnt(0)" ::: "memory");
    __syncthreads();
}

struct RsFr { bf16x8 qf[8]; };
__device__ __forceinline__ void rs_load(RsFr& f, const bf16* Qr, int bl, int h, int c, int il, int g) {
#pragma unroll
    for (int ks = 0; ks < 8; ++ks) f.qf[ks] = *(const GAS bf16x8*)((const char*)Qr + qk_frag(bl, h, c * 8 + (il >> 4), ks) + (size_t)(((il & 15) + 16 * g) * 16));
}
__device__ __forceinline__ void rs_dma_kz(LAS unsigned char* dst  , LAS unsigned char* dstp, const bf16* KzT, const bf16* P, int il, int bl, int h, int c, int wave, int fr, int g, int klo, int khi) {
    const int unit = (bl * 8 + h) * 64 + c;
#pragma unroll
    for (int ks = 0; ks < 4; ++ks)
        if (ks >= klo && ks <= khi)
        __builtin_amdgcn_global_load_lds((const unsigned*)((const char*)P + p_frag(unit, il >> 4, ks) + (size_t)(((il & 15) + 16 * g) * 16)), (LAS unsigned*)(dstp + ks * 1024), 16, 0, 0);
#pragma unroll
    for (int dd = 0; dd < 2; ++dd)
#pragma unroll
        for (int ks = 0; ks < 4; ++ks)
            __builtin_amdgcn_global_load_lds((const unsigned*)((const char*)KzT + kz_frag(bl, h, c, 2 * wave + dd, ks) + (size_t)((fr + 16 * g) * 16)), (LAS unsigned*)(dst + (dd * 4 + ks) * 1024), 16, 0, 0);
}
__device__ __forceinline__ void rs_job(Frame& F, const bf16* Qr, const bf16* KzT, const bf16* VrT, const bf16* P, bf16* O, const float* dte  , int bl, int h, int dir, int vs, unsigned* lock) {
    const int fr = F.lane & 15, g = F.lane >> 4, il = 16 * F.wave + fr;
    LAS unsigned char* KZ = F.lds + 55296 + F.wave * 8192;
    LAS unsigned char* PZ = F.lds + 120832 + F.wave * 4096;
    const float gC = dte[1]; const float xi = dte[128 + il];
    f32x4 accS[4][2];
#pragma unroll
    for (int vt = 0; vt < 4; ++vt)
#pragma unroll
        for (int dd = 0; dd < 2; ++dd) accS[vt][dd] = (f32x4){0.f, 0.f, 0.f, 0.f};
    for (int i = F.tid; i < 36864 / 4; i += NWAVES * 64) ((LAS unsigned*)F.lds)[i] = 0u;
    const int trow = F.tid >> 2, tpart = F.tid & 3;
    const bf16* vsrc = VrT + ((size_t)(bl * 16 + h * 2 + (vs >> 1)) * SEQ + trow) * 128 + (vs & 1) * 64 + tpart * 16;
    LAS unsigned char* vtw = F.lds + 36864 + trow * 144 + tpart * 32;
    const int c0 = dir == 0 ? 0 : 63, cstep = dir == 0 ? 1 : -1;
    const int klo = dir == 0 ? 0 : (F.wave >> 1), khi = dir == 0 ? (F.wave >> 1) : 3;
    v4u vr0 = *(const GAS v4u*)(vsrc + (size_t)c0 * 16384), vr1 = *(const GAS v4u*)(vsrc + (size_t)c0 * 16384 + 8);
    RsFr fa, fb; v2u ow[4]; bf16* opend = nullptr;
    rs_load(fa, Qr, bl, h, c0, il, g);
    rs_dma_kz(KZ, PZ, KzT, P, il, bl, h, c0, F.wave, fr, g, klo, khi);
#ifdef RS_SYNC4
#define RS_LOCKSTEP(stepi) do { if (F.tid == 0) { __hip_atomic_fetch_add(lock, 1u, __ATOMIC_RELAXED, __HIP_MEMORY_SCOPE_AGENT); const unsigned want = 4u * (unsigned)((stepi) + 1); unsigned sp = 0; \
        while (__hip_atomic_load(lock, __ATOMIC_RELAXED, __HIP_MEMORY_SCOPE_AGENT) < want && ++sp < 20000u) __builtin_amdgcn_s_sleep(1); } __builtin_amdgcn_s_barrier(); } while (0)
#else
#define RS_LOCKSTEP(stepi) do { } while (0)
#endif
#ifdef RS_DUP_DMA
#define RS_EXTRA_DMA rs_dma_kz(KZ, PZ, KzT, P, il, bl, h, c + cstep, F.wave, fr, g, klo, khi)
#else
#define RS_EXTRA_DMA do { } while (0)
#endif
#define RS_LDS4(dst, base, stride, ks) do { _Pragma("unroll") for (int vt_ = 0; vt_ < 4; ++vt_) dst[vt_] = *(const LAS bf16x8*)((base) + (16 * vt_ + fr) * (stride) + 32 * (ks) + 8 * g); } while (0)
#define RS_CAT(l, h) ((bf16x8){l[0], l[1], l[2], l[3], h[0], h[1], h[2], h[3]})
#define RS_TR(base, off) __builtin_amdgcn_ds_read_tr16_b64_v4i16((LAS s16x4*)(F.lds + (base) + (off)))
#define RS_LDV1(L, H, ks, vt) do { L[vt] = RS_TR(vta, 36864 + (ks) * 4608 + (vt) * 32); H[vt] = RS_TR(vta, 36864 + (ks) * 4608 + (vt) * 32 + 576); } while (0)
#define RS_LDS1(L, H, ks, vt) do { L[vt] = RS_TR(vta, (ks) * 4608 + (vt) * 32); H[vt] = RS_TR(vta, (ks) * 4608 + (vt) * 32 + 576); } while (0)
#define RS_LDS(L, H, ks) do { RS_LDS1(L, H, ks, 0); RS_LDS1(L, H, ks, 1); RS_LDS1(L, H, ks, 2); RS_LDS1(L, H, ks, 3); } while (0)
#define RS_LDV(L, H, ks) do { RS_LDV1(L, H, ks, 0); RS_LDV1(L, H, ks, 1); RS_LDV1(L, H, ks, 2); RS_LDV1(L, H, ks, 3); } while (0)
#define RS_LDKZ(dd, ks) do { kzl[dd][ks] = RS_TR(kza, ((dd) * 4 + (ks)) * 1024); kzh[dd][ks] = RS_TR(kza, ((dd) * 4 + (ks)) * 1024 + 128); } while (0)
#define RS_MMA12(L, H, ks) do { if ((ks) >= klo && (ks) <= khi) { _Pragma("unroll") for (int vt_ = 0; vt_ < 4; ++vt_) accO[vt_] = __builtin_amdgcn_mfma_f32_16x16x32_bf16(RS_CAT(L[vt_], H[vt_]), cur_pf[ks], accO[vt_], 0, 0, 0); } \
        _Pragma("unroll") for (int vt_ = 0; vt_ < 4; ++vt_) { const bf16x8 vf_ = RS_CAT(L[vt_], H[vt_]); \
        accS[vt_][0] = __builtin_amdgcn_mfma_f32_16x16x32_bf16(vf_, RS_CAT(kzl[0][ks], kzh[0][ks]), accS[vt_][0], 0, 0, 0); accS[vt_][1] = __builtin_amdgcn_mfma_f32_16x16x32_bf16(vf_, RS_CAT(kzl[1][ks], kzh[1][ks]), accS[vt_][1], 0, 0, 0); } } while (0)
#define RS_STEP(CUR, NXT, cexpr, hasnext, stepi) do { const int c = (cexpr); const int t0 = bl * SEQ + c * 128; \
        *(LAS v4u*)vtw = vr0; *(LAS v4u*)(vtw + 16) = vr1; \
        asm volatile("s_waitcnt vmcnt(0)" ::: "memory"); \
        __syncthreads(); \
        bf16x8 cur_pf[4]; s16x4 kzl[2][4], kzh[2][4]; \
        unsigned kza, vta; { int ln_ = F.lane; asm volatile("" : "+v"(ln_)); const int row_ = ((ln_ >> 4) << 3) | ((ln_ >> 2) & 3);     \
            kza = (unsigned)(55296 + F.wave * 8192 + row_ * 32 + (ln_ & 3) * 8); vta = (unsigned)(row_ * 144 + (ln_ & 3) * 8); } \
        _Pragma("unroll") for (int ks = 0; ks < 4; ++ks) cur_pf[ks] = *(const LAS bf16x8*)(PZ + ks * 1024 + F.lane * 16); \
        RS_LDKZ(0, 0); RS_LDKZ(0, 1); RS_LDKZ(0, 2); RS_LDKZ(0, 3); RS_LDKZ(1, 0); RS_LDKZ(1, 1); RS_LDKZ(1, 2); RS_LDKZ(1, 3);     \
        RS_LOCKSTEP(stepi); \
        if (hasnext) { const int cn = c + cstep; vr0 = *(const GAS v4u*)(vsrc + (size_t)cn * 16384); vr1 = *(const GAS v4u*)(vsrc + (size_t)cn * 16384 + 8); rs_load(NXT, Qr, bl, h, cn, il, g); }     \
        if (opend) { _Pragma("unroll") for (int vt = 0; vt < 4; ++vt) *(GAS v2u*)(opend + 16 * vt) = ow[vt]; }     \
        f32x4 accO[4]; s16x4 aL[4], aH[4], bL[4], bH[4]; \
        _Pragma("unroll") for (int vt = 0; vt < 4; ++vt) accO[vt] = (f32x4){0.f, 0.f, 0.f, 0.f}; \
        RS_LDS(aL, aH, 0); \
        _Pragma("unroll") for (int k2 = 0; k2 < 4; ++k2) { \
            RS_LDS(bL, bH, 2 * k2 + 1); asm volatile("s_waitcnt lgkmcnt(8)" ::: "memory"); __builtin_amdgcn_sched_barrier(0); \
            _Pragma("unroll") for (int vt = 0; vt < 4; ++vt) accO[vt] = __builtin_amdgcn_mfma_f32_16x16x32_bf16(RS_CAT(aL[vt], aH[vt]), CUR.qf[2 * k2], accO[vt], 0, 0, 0); \
            __builtin_amdgcn_sched_barrier(0); \
            if (k2 < 3) { RS_LDS(aL, aH, 2 * k2 + 2); asm volatile("s_waitcnt lgkmcnt(8)" ::: "memory"); } else { RS_LDV(aL, aH, 0); asm volatile("s_waitcnt lgkmcnt(8)" ::: "memory"); } \
            __builtin_amdgcn_sched_barrier(0); \
            _Pragma("unroll") for (int vt = 0; vt < 4; ++vt) accO[vt] = __builtin_amdgcn_mfma_f32_16x16x32_bf16(RS_CAT(bL[vt], bH[vt]), CUR.qf[2 * k2 + 1], accO[vt], 0, 0, 0); \
            __builtin_amdgcn_sched_barrier(0); } \
        asm volatile("" ::: "memory"); if (hasnext) { rs_dma_kz(KZ, PZ, KzT, P, il, bl, h, c + cstep, F.wave, fr, g, klo, khi); RS_EXTRA_DMA; }     \
        __builtin_amdgcn_sched_barrier(0); \
        _Pragma("unroll") for (int vt = 0; vt < 4; ++vt) accO[vt] = accO[vt] * xi; \
        _Pragma("unroll") for (int vt = 0; vt < 4; ++vt) _Pragma("unroll") for (int dd = 0; dd < 2; ++dd) accS[vt][dd] = accS[vt][dd] * gC; \
          \
        RS_LDV(bL, bH, 1); asm volatile("s_waitcnt lgkmcnt(8)" ::: "memory"); __builtin_amdgcn_sched_barrier(0); \
        RS_MMA12(aL, aH, 0); __builtin_amdgcn_sched_barrier(0); \
        RS_LDV(aL, aH, 2); asm volatile("s_waitcnt lgkmcnt(8)" ::: "memory"); __builtin_amdgcn_sched_barrier(0); \
        RS_MMA12(bL, bH, 1); __builtin_amdgcn_sched_barrier(0); \
        RS_LDV(bL, bH, 3); asm volatile("s_waitcnt lgkmcnt(8)" ::: "memory"); __builtin_amdgcn_sched_barrier(0); \
        RS_MMA12(aL, aH, 2); __builtin_amdgcn_sched_barrier(0); \
        asm volatile("s_waitcnt lgkmcnt(0)" ::: "memory"); __builtin_amdgcn_sched_barrier(0); \
        RS_MMA12(bL, bH, 3); __builtin_amdgcn_sched_barrier(0); \
        _Pragma("unroll") for (int vt = 0; vt < 4; ++vt) { ow[vt].x = pg8::cvt_pk_bf16(accO[vt][0], accO[vt][1]); ow[vt].y = pg8::cvt_pk_bf16(accO[vt][2], accO[vt][3]); } \
        opend = O + (size_t)(t0 + il) * D + h * 256 + vs * 64 + 4 * g; \
        asm volatile("s_waitcnt lgkmcnt(0)" ::: "memory"); __builtin_amdgcn_s_barrier(); asm volatile("" ::: "memory");     \
        _Pragma("unroll") for (int vt = 0; vt < 4; ++vt) _Pragma("unroll") for (int dd = 0; dd < 2; ++dd) { v2u w_; w_.x = pg8::cvt_pk_bf16(accS[vt][dd][0], accS[vt][dd][1]); w_.y = pg8::cvt_pk_bf16(accS[vt][dd][2], accS[vt][dd][3]); \
            *(LAS v2u*)(F.lds + (16 * (2 * F.wave + dd) + fr) * 144 + (16 * vt + 4 * g) * 2) = w_; }     \
    } while (0)
#pragma unroll 1
    for (int step = 0; step < 64; step += 2) {
        RS_STEP(fa, fb, c0 + cstep * step, true, step);
        RS_STEP(fb, fa, c0 + cstep * (step + 1), (step + 2 < 64), step + 1);
    }
#undef RS_STEP
#undef RS_LDS4
#undef RS_LDS
#undef RS_LDS1
#undef RS_MMA12
#undef RS_LDV
#undef RS_LDV1
#undef RS_LDKZ
#undef RS_TR
#undef RS_CAT
#pragma unroll
    for (int vt = 0; vt < 4; ++vt) *(GAS v2u*)(opend + 16 * vt) = ow[vt];
    asm volatile("s_waitcnt vmcnt(0)" ::: "memory");
    __syncthreads();
}

__device__ __forceinline__ void rn_phase(Frame& F, bf16* Of, const bf16* Ob, const float* gn) {
    const int gw = F.vcu * NWAVES + F.wave, NGW = F.G * NWAVES;
    for (int m = gw; m < HT; m += NGW) {
#pragma unroll
        for (int j = 0; j < 4; ++j) {
            const int col = j * 512 + F.lane * 8;
            const v4u a = *(const GAS v4u*)(Of + (size_t)m * D + col), b = *(const GAS v4u*)(Ob + (size_t)m * D + col);
            float x[8]; x[0] = bflo(a.x) + bflo(b.x); x[1] = bfhi(a.x) + bfhi(b.x); x[2] = bflo(a.y) + bflo(b.y); x[3] = bfhi(a.y) + bfhi(b.y);
            x[4] = bflo(a.z) + bflo(b.z); x[5] = bfhi(a.z) + bfhi(b.z); x[6] = bflo(a.w) + bflo(b.w); x[7] = bfhi(a.w) + bfhi(b.w);
            float s = 0.f;
#pragma unroll
            for (int i = 0; i < 8; ++i) s += x[i];
#pragma unroll
            for (int o = 1; o < 32; o <<= 1) s += shx(s, o, F.lane);
            const float mu = s * (1.0f / 256.0f); float q = 0.f;
#pragma unroll
            for (int i = 0; i < 8; ++i) { x[i] -= mu; q += x[i] * x[i]; }
#pragma unroll
            for (int o = 1; o < 32; o <<= 1) q += shx(q, o, F.lane);
            const float rstd = 1.0f / sqrtf(q * (1.0f / 256.0f) + EPS);
            const f32x4 g0 = *(const GAS f32x4*)(gn + col), g1 = *(const GAS f32x4*)(gn + col + 4);
            v4u o; o.x = pg8::cvt_pk_bf16(x[0] * rstd * g0.x, x[1] * rstd * g0.y); o.y = pg8::cvt_pk_bf16(x[2] * rstd * g0.z, x[3] * rstd * g0.w);
            o.z = pg8::cvt_pk_bf16(x[4] * rstd * g1.x, x[5] * rstd * g1.y); o.w = pg8::cvt_pk_bf16(x[6] * rstd * g1.z, x[7] * rstd * g1.w);
            *(GAS v4u*)(Of + (size_t)m * D + col) = o;
        }
    }
}

__device__ __forceinline__ void rn_tile(Frame& F, bf16* Of, const bf16* Ob, const float* gn, int pm, int head) {
    const int half = F.lane >> 5, l32 = F.lane & 31, col = head * 256 + l32 * 8;
    const f32x4 g0 = *(const GAS f32x4*)(gn + col), g1 = *(const GAS f32x4*)(gn + col + 4);
#pragma unroll 8
    for (int it = 0; it < 16; ++it) {
        const int m = pm * 256 + F.wave * 32 + it * 2 + half;
        const v4u a = *(const GAS v4u*)(Of + (size_t)m * D + col), b = *(const GAS v4u*)(Ob + (size_t)m * D + col);
        float x[8]; x[0] = bflo(a.x) + bflo(b.x); x[1] = bfhi(a.x) + bfhi(b.x); x[2] = bflo(a.y) + bflo(b.y); x[3] = bfhi(a.y) + bfhi(b.y);
        x[4] = bflo(a.z) + bflo(b.z); x[5] = bfhi(a.z) + bfhi(b.z); x[6] = bflo(a.w) + bflo(b.w); x[7] = bfhi(a.w) + bfhi(b.w);
        float s = 0.f, q = 0.f;
#pragma unroll
        for (int i = 0; i < 8; ++i) { s += x[i]; q += x[i] * x[i]; }
#pragma unroll
        for (int o = 1; o < 32; o <<= 1) { const float s2 = shx(s, o, F.lane), q2 = shx(q, o, F.lane); s += s2; q += q2; }
        const float mu = s * (1.0f / 256.0f);
        const float rstd = __builtin_amdgcn_rsqf(fmaxf(q * (1.0f / 256.0f) - mu * mu, 0.f) + EPS);
#pragma unroll
        for (int i = 0; i < 8; ++i) x[i] -= mu;
        v4u o; o.x = pg8::cvt_pk_bf16(x[0] * rstd * g0.x, x[1] * rstd * g0.y); o.y = pg8::cvt_pk_bf16(x[2] * rstd * g0.z, x[3] * rstd * g0.w);
        o.z = pg8::cvt_pk_bf16(x[4] * rstd * g1.x, x[5] * rstd * g1.y); o.w = pg8::cvt_pk_bf16(x[6] * rstd * g1.z, x[7] * rstd * g1.w);
        *(GAS v4u*)(Of + (size_t)m * D + col) = o;
    }
}
struct LinSched {
    pg8::DenseOrder o; unsigned row0; const char* Bt; size_t tstep;
    __device__ __forceinline__ void init(int M, int N, int K, int G, int c, unsigned row0_, const bf16* Bt_) { o.init(M, N, G, c); row0 = row0_; Bt = (const char*)Bt_; tstep = (size_t)256 * K * 2; }
    __device__ __forceinline__ bool next(int i, pg8::Unit& u) const { u.e = 0; return o.next_mn(i, u.pm, u.pn); }
    static constexpr bool GATHER = false;
    __device__ __forceinline__ unsigned a_row(const pg8::Unit& u, int r) const { return 0u; }
    __device__ __forceinline__ size_t a_off(const pg8::Unit& u, unsigned rowb) const { return (size_t)(row0 + (unsigned)u.pm * 256u) * rowb; }
    __device__ __forceinline__ const char* b_base(const pg8::Unit& u) const { return Bt + (size_t)u.pn * tstep; }
};
#ifndef SHADOW_N
#define SHADOW_N 2
#endif
struct ShadowSched {
    int pm, pn0; unsigned row0; const char* Bt; size_t tstep;
    static constexpr bool GATHER = false;
    __device__ __forceinline__ bool next(int i, pg8::Unit& u) const { if (i >= SHADOW_N) return false; u.pm = pm; u.pn = pn0 + i; u.e = 0; return true; }
    __device__ __forceinline__ unsigned a_row(const pg8::Unit& u, int r) const { return 0u; }
    __device__ __forceinline__ size_t a_off(const pg8::Unit& u, unsigned rowb) const { return (size_t)(row0 + (unsigned)u.pm * 256u) * rowb; }
    __device__ __forceinline__ const char* b_base(const pg8::Unit& u) const { return Bt + (size_t)u.pn * tstep; }
};
struct GatesSched {
    pg8::DenseOrder o; int G, c; unsigned row0; const char* Bt; size_t tstep;
    static constexpr bool GATHER = false;
    __device__ __forceinline__ bool next(int i, pg8::Unit& u) const {
        const int L = i * G + c; constexpr int REST = 4 - SHADOW_N;
        if (L < 512) { u.e = 0; return o.next_mn(i, u.pm, u.pn); }
        const int idx = L - 512; if (idx >= 64 * 2 * REST) return false;
        u.e = 1; u.pm = idx / (2 * REST); const int q = idx % (2 * REST); u.pn = 4 * (q / REST) + SHADOW_N + (q % REST); return true;
    }
    __device__ __forceinline__ unsigned a_row(const pg8::Unit& u, int r) const { return 0u; }
    __device__ __forceinline__ size_t a_off(const pg8::Unit& u, unsigned rowb) const { return (size_t)(row0 + (unsigned)u.pm * 256u) * rowb; }
    __device__ __forceinline__ const char* b_base(const pg8::Unit& u) const { return Bt + (size_t)(u.e * 8 + u.pn) * tstep; }
};
template <bool GATHER_>
struct MoeSched {
    const volatile LAS int* ts; int ncol, G, c; const int* ltok; const char* Bt; size_t estep, tstep;
    __device__ __forceinline__ bool next(int i, pg8::Unit& u) const {
        const int L = i * G + c; const int total = ts[32] * ncol; if (L >= total) return false;
        const int tile = L / ncol; u.pm = tile; u.pn = L % ncol; int e = 0;
        e = (int)((const volatile LAS unsigned char*)(ts + 48))[tile];
        u.e = e; return true;
    }
    static constexpr bool GATHER = GATHER_;
    __device__ __forceinline__ unsigned a_row(const pg8::Unit& u, int r) const { return (unsigned)ltok[u.pm * 256 + r]; }
    __device__ __forceinline__ size_t a_off(const pg8::Unit& u, unsigned rowb) const { return GATHER_ ? (size_t)0 : (size_t)((unsigned)u.pm * 256u) * rowb; }
    __device__ __forceinline__ const char* b_base(const pg8::Unit& u) const { return Bt + (size_t)u.e * estep + (size_t)u.pn * tstep; }
};

using pg8::Unit; using pg8::cvt_pk_bf16;
typedef const f32x4 (&AccRef)[2][2][4][2];

struct EpiProj {
    static constexpr bool PERM = true;
    unsigned char* ws; const float* rs; const float* dtl;
    __device__ __forceinline__ void operator()(AccRef acc, const Unit& u, int wr, int wc, int fr, int fq) const {
        const int type = u.pn >> 3, hh = u.pn & 7, c0 = wc * 32 + 8 * fq;
        bf16 *Qn = (bf16*)(ws + WS_QN), *Kn = (bf16*)(ws + WS_KN), *VnT = (bf16*)(ws + WS_VNT), *Qr = (bf16*)(ws + WS_QR), *Kr = (bf16*)(ws + WS_KR), *KzTf = (bf16*)(ws + WS_KZF), *KzTb = (bf16*)(ws + WS_KZB), *VrT = (bf16*)(ws + WS_VRT);
        const float* cosT = (const float*)(ws + WS_ROPE); const float* sinT = cosT + SEQ * 128;
        if (type <= 2 || type == 5) {
#pragma unroll
            for (int ai = 0; ai < 2; ++ai)
#pragma unroll
                for (int m = 0; m < 4; ++m) {
                    const int r = u.pm * 256 + ai * 128 + wr * 64 + m * 16 + fr; const int bl = r >> 13, s = r & (SEQ - 1);
                    bf16* dst = (type == 0 ? Qn : (type == 1 ? Kn : (type == 2 ? VnT : VrT))) + ((size_t)(bl * 16 + hh * 2) * SEQ + s) * 128 + c0;
#pragma unroll
                    for (int bj = 0; bj < 2; ++bj) { const f32x4 v0 = acc[ai][bj][m][0], v1 = acc[ai][bj][m][1]; v4u w; w.x = cvt_pk_bf16(v0[0], v0[1]); w.y = cvt_pk_bf16(v0[2], v0[3]); w.z = cvt_pk_bf16(v1[0], v1[1]); w.w = cvt_pk_bf16(v1[2], v1[3]);
                        *(GAS v4u*)(dst + (size_t)bj * SEQ * 128) = w; }
                }
        } else {
#pragma unroll
            for (int ai = 0; ai < 2; ++ai)
#pragma unroll
                for (int mp = 0; mp < 2; ++mp) {
                    f32x4 cs[2][2], sn[2][2]; float zf[2] = {0.f, 0.f}, zb[2] = {0.f, 0.f};
#pragma unroll
                    for (int mi = 0; mi < 2; ++mi) { const int s = (u.pm * 256 + ai * 128 + wr * 64 + (2 * mp + mi) * 16 + fr) & (SEQ - 1);
#pragma unroll
                        for (int n = 0; n < 2; ++n) { cs[mi][n] = *(const GAS f32x4*)(cosT + (size_t)s * 128 + c0 + 4 * n); sn[mi][n] = *(const GAS f32x4*)(sinT + (size_t)s * 128 + c0 + 4 * n); }
                        if (type == 4) { zf[mi] = dtl[(0 * 8 + hh) * DT_STRIDE + 256 + (s & 127)]; zb[mi] = dtl[(1 * 8 + hh) * DT_STRIDE + 256 + (s & 127)]; } }
                    asm volatile("" ::: "memory");
#pragma unroll
                    for (int mi = 0; mi < 2; ++mi) { const int m = 2 * mp + mi; const int r = u.pm * 256 + ai * 128 + wr * 64 + m * 16 + fr; const int bl = r >> 13, s = r & (SEQ - 1);
                        char* dst = (char*)(type == 3 ? Qr : Kr) + qk_frag(bl, hh, s >> 4, wc) + (size_t)(((s & 15) + 16 * fq) * 16);
                        const int jj = s & 127; const size_t zo = kz_frag(bl, hh, s >> 7, 2 * wc + (fq >> 1), jj >> 5) + (size_t)((jj & 31) * 32 + 16 * (fq & 1));
#pragma unroll
                        for (int n = 0; n < 2; ++n) { const f32x4 c4 = cs[mi][n], s4 = sn[mi][n];
                            float o1[4], o2[4];
#pragma unroll
                            for (int e = 0; e < 4; ++e) { const float x1 = acc[ai][0][m][n][e], x2 = acc[ai][1][m][n][e]; o1[e] = x1 * c4[e] - x2 * s4[e]; o2[e] = x1 * s4[e] + x2 * c4[e]; }
                            v2u w; w.x = cvt_pk_bf16(o1[0], o1[1]); w.y = cvt_pk_bf16(o1[2], o1[3]); *(GAS v2u*)(dst + 8 * n) = w;
                            w.x = cvt_pk_bf16(o2[0], o2[1]); w.y = cvt_pk_bf16(o2[2], o2[3]); *(GAS v2u*)(dst + 4 * 1024 + 8 * n) = w;
                            if (type == 4) { char* df = (char*)KzTf + zo + 8 * n; char* db = (char*)KzTb + zo + 8 * n; const float zf_ = zf[mi], zb_ = zb[mi];
                                w.x = cvt_pk_bf16(o1[0] * zf_, o1[1] * zf_); w.y = cvt_pk_bf16(o1[2] * zf_, o1[3] * zf_); *(GAS v2u*)df = w;
                                w.x = cvt_pk_bf16(o2[0] * zf_, o2[1] * zf_); w.y = cvt_pk_bf16(o2[2] * zf_, o2[3] * zf_); *(GAS v2u*)(df + 8 * 4096) = w;
                                w.x = cvt_pk_bf16(o1[0] * zb_, o1[1] * zb_); w.y = cvt_pk_bf16(o1[2] * zb_, o1[3] * zb_); *(GAS v2u*)db = w;
                                w.x = cvt_pk_bf16(o2[0] * zb_, o2[1] * zb_); w.y = cvt_pk_bf16(o2[2] * zb_, o2[3] * zb_); *(GAS v2u*)(db + 8 * 4096) = w; }
                        } }
                    asm volatile("" ::: "memory"); }
        }
    }
};
struct EpiGates;
struct EpiGateNa {
    static constexpr bool PERM = true;
    const bf16* na; bf16* mix; const float* rs;
    __device__ __forceinline__ void operator()(AccRef acc, const Unit& u, int wr, int wc, int fr, int fq) const {
        const int cg = u.pn * 256 + wc * 32 + 8 * fq;
#pragma unroll
        for (int ai = 0; ai < 2; ++ai) {
            v4u in[4][2];
#pragma unroll
            for (int m = 0; m < 4; ++m) { const int r = u.pm * 256 + ai * 128 + wr * 64 + m * 16 + fr;
#pragma unroll
                for (int bj = 0; bj < 2; ++bj) in[m][bj] = *(const GAS v4u*)(na + ((size_t)((r >> 13) * 16 + u.pn * 2 + bj) * SEQ + (r & (SEQ - 1))) * 128 + wc * 32 + 8 * fq); }
            asm volatile("" ::: "memory");
#pragma unroll
            for (int m = 0; m < 4; ++m) { const int r = u.pm * 256 + ai * 128 + wr * 64 + m * 16 + fr;
#pragma unroll
                for (int bj = 0; bj < 2; ++bj) { const size_t off = (size_t)r * D + cg + bj * 128; const v4u i4 = in[m][bj];
                    const f32x4 v0 = acc[ai][bj][m][0], v1 = acc[ai][bj][m][1]; float o[8];
                    const float x[8] = {bflo(i4.x), bfhi(i4.x), bflo(i4.y), bfhi(i4.y), bflo(i4.z), bfhi(i4.z), bflo(i4.w), bfhi(i4.w)};
#pragma unroll
                    for (int e = 0; e < 4; ++e) { o[e] = x[e] * sigmoidf_(v0[e]); o[4 + e] = x[4 + e] * sigmoidf_(v1[e]); }
                    v4u w; w.x = cvt_pk_bf16(o[0], o[1]); w.y = cvt_pk_bf16(o[2], o[3]); w.z = cvt_pk_bf16(o[4], o[5]); w.w = cvt_pk_bf16(o[6], o[7]);
                    *(GAS v4u*)(mix + off) = w; } }
            asm volatile("" ::: "memory"); }
    }
};
struct EpiRg {
    static constexpr bool PERM = true;
    bf16* retn; const float* rs;
    __device__ __forceinline__ void operator()(AccRef acc, const Unit& u, int wr, int wc, int fr, int fq) const {
        const int cg = u.pn * 256 + wc * 32 + 8 * fq;
#pragma unroll
        for (int ai = 0; ai < 2; ++ai)
#pragma unroll
            for (int m = 0; m < 4; ++m) { const int r = u.pm * 256 + ai * 128 + wr * 64 + m * 16 + fr; const float rv = 1.0f;
#pragma unroll
                for (int bj = 0; bj < 2; ++bj) { const size_t off = (size_t)r * D + cg + bj * 128;
                    const v4u in = *(const GAS v4u*)(retn + off);
                    const f32x4 v0 = acc[ai][bj][m][0] * rv, v1 = acc[ai][bj][m][1] * rv; float o[8];
                    const float x[8] = {bflo(in.x), bfhi(in.x), bflo(in.y), bfhi(in.y), bflo(in.z), bfhi(in.z), bflo(in.w), bfhi(in.w)};
#pragma unroll
                    for (int e = 0; e < 4; ++e) { o[e] = x[e] * siluf_(v0[e]); o[4 + e] = x[4 + e] * siluf_(v1[e]); }
                    v4u w; w.x = cvt_pk_bf16(o[0], o[1]); w.y = cvt_pk_bf16(o[2], o[3]); w.z = cvt_pk_bf16(o[4], o[5]); w.w = cvt_pk_bf16(o[6], o[7]);
                    *(GAS v4u*)(retn + off) = w; }
                asm volatile("" ::: "memory"); }
    }
};
struct EpiGates {
    static constexpr bool PERM = true;
    bf16* retn; const bf16* na; bf16* mix; const float* rs;
    __device__ __forceinline__ void operator()(AccRef acc, const Unit& u, int wr, int wc, int fr, int fq) const {
        const bool isg = u.e == 0; const int cg = u.pn * 256 + wc * 32 + 8 * fq;
#pragma unroll
        for (int ai = 0; ai < 2; ++ai)
#pragma unroll
            for (int m = 0; m < 4; ++m) { const int r = u.pm * 256 + ai * 128 + wr * 64 + m * 16 + fr; const float rv = 1.0f;
#pragma unroll
                for (int bj = 0; bj < 2; ++bj) { const size_t off = (size_t)r * D + cg + bj * 128;
                    const size_t offn = ((size_t)((r >> 13) * 16 + u.pn * 2 + bj) * SEQ + (r & (SEQ - 1))) * 128 + wc * 32 + 8 * fq;
                    const v4u in = *(const GAS v4u*)(isg ? retn + off : na + offn);
                    const f32x4 v0 = acc[ai][bj][m][0] * rv, v1 = acc[ai][bj][m][1] * rv; float o[8];
                    const float x[8] = {bflo(in.x), bfhi(in.x), bflo(in.y), bfhi(in.y), bflo(in.z), bfhi(in.z), bflo(in.w), bfhi(in.w)};
#pragma unroll
                    for (int e = 0; e < 4; ++e) { const float s0 = sigmoidf_(v0[e]), s1 = sigmoidf_(v1[e]); o[e] = x[e] * (isg ? v0[e] * s0 : s0); o[4 + e] = x[4 + e] * (isg ? v1[e] * s1 : s1); }
                    v4u w; w.x = cvt_pk_bf16(o[0], o[1]); w.y = cvt_pk_bf16(o[2], o[3]); w.z = cvt_pk_bf16(o[4], o[5]); w.w = cvt_pk_bf16(o[6], o[7]);
                    *(GAS v4u*)((isg ? retn : mix) + off) = w; }
                asm volatile("" ::: "memory"); }
    }
};
struct EpiGate2 {
    static constexpr bool PERM = true;
    const bf16* t2; bf16* mix; const float* rs;
    __device__ __forceinline__ void operator()(AccRef acc, const Unit& u, int wr, int wc, int fr, int fq) const {
        const int cg = u.pn * 256 + wc * 32 + 8 * fq;
#pragma unroll
        for (int ai = 0; ai < 2; ++ai)
#pragma unroll
            for (int mp = 0; mp < 2; ++mp) {
                v4u a[2][2], b[2][2];
#pragma unroll
                for (int mi = 0; mi < 2; ++mi) { const int r = u.pm * 256 + ai * 128 + wr * 64 + (2 * mp + mi) * 16 + fr;
#pragma unroll
                    for (int bj = 0; bj < 2; ++bj) { const size_t off = (size_t)r * D + cg + bj * 128; a[mi][bj] = *(const GAS v4u*)(t2 + off); b[mi][bj] = *(const GAS v4u*)(mix + off); } }
                asm volatile("" ::: "memory");
#pragma unroll
                for (int mi = 0; mi < 2; ++mi) { const int m = 2 * mp + mi; const int r = u.pm * 256 + ai * 128 + wr * 64 + m * 16 + fr;
#pragma unroll
                    for (int bj = 0; bj < 2; ++bj) { const size_t off = (size_t)r * D + cg + bj * 128; const v4u aa = a[mi][bj], bb = b[mi][bj];
                        const f32x4 v0 = acc[ai][bj][m][0], v1 = acc[ai][bj][m][1]; float o[8];
                        const float x[8] = {bflo(aa.x), bfhi(aa.x), bflo(aa.y), bfhi(aa.y), bflo(aa.z), bfhi(aa.z), bflo(aa.w), bfhi(aa.w)};
                        const float y[8] = {bflo(bb.x), bfhi(bb.x), bflo(bb.y), bfhi(bb.y), bflo(bb.z), bfhi(bb.z), bflo(bb.w), bfhi(bb.w)};
#pragma unroll
                        for (int e = 0; e < 4; ++e) { o[e] = y[e] + x[e] * sigmoidf_(v0[e]); o[4 + e] = y[4 + e] + x[4 + e] * sigmoidf_(v1[e]); }
                        v4u w; w.x = cvt_pk_bf16(o[0], o[1]); w.y = cvt_pk_bf16(o[2], o[3]); w.z = cvt_pk_bf16(o[4], o[5]); w.w = cvt_pk_bf16(o[6], o[7]);
                        *(GAS v4u*)(mix + off) = w; } }
                asm volatile("" ::: "memory"); }
    }
};
struct EpiRes {
    static constexpr bool PERM = true;
    bf16* x; int row0;
    __device__ __forceinline__ void operator()(AccRef acc, const Unit& u, int wr, int wc, int fr, int fq) const {
        const int cg = u.pn * 256 + wc * 32 + 8 * fq;
#pragma unroll
        for (int ai = 0; ai < 2; ++ai) {
            v4u in[4][2];
#pragma unroll
            for (int m = 0; m < 4; ++m)
#pragma unroll
                for (int bj = 0; bj < 2; ++bj) in[m][bj] = *(const GAS v4u*)(x + (size_t)(row0 + u.pm * 256 + ai * 128 + wr * 64 + m * 16 + fr) * D + cg + bj * 128);
            asm volatile("" ::: "memory");
#pragma unroll
            for (int m = 0; m < 4; ++m)
#pragma unroll
                for (int bj = 0; bj < 2; ++bj) { const size_t off = (size_t)(row0 + u.pm * 256 + ai * 128 + wr * 64 + m * 16 + fr) * D + cg + bj * 128; const v4u i4 = in[m][bj];
                    const f32x4 v0 = acc[ai][bj][m][0], v1 = acc[ai][bj][m][1];
                    v4u w; w.x = cvt_pk_bf16(bflo(i4.x) + v0[0], bfhi(i4.x) + v0[1]); w.y = cvt_pk_bf16(bflo(i4.y) + v0[2], bfhi(i4.y) + v0[3]); w.z = cvt_pk_bf16(bflo(i4.z) + v1[0], bfhi(i4.z) + v1[1]); w.w = cvt_pk_bf16(bflo(i4.w) + v1[2], bfhi(i4.w) + v1[3]);
                    *(GAS v4u*)(x + off) = w; }
            asm volatile("" ::: "memory"); }
    }
};
struct EpiPle {
    static constexpr bool PERM = true;
    const bf16* x; bf16* xd; const bf16* pp; const float* rs;
    __device__ __forceinline__ void operator()(AccRef acc, const Unit& u, int wr, int wc, int fr, int fq) const {
        const int cg = u.pn * 256 + wc * 32 + 8 * fq;
#pragma unroll
        for (int ai = 0; ai < 2; ++ai)
#pragma unroll
            for (int mp = 0; mp < 2; ++mp) {
                v4u a[2][2], b[2][2];
#pragma unroll
                for (int mi = 0; mi < 2; ++mi)
#pragma unroll
                    for (int bj = 0; bj < 2; ++bj) { const size_t off = (size_t)(u.pm * 256 + ai * 128 + wr * 64 + (2 * mp + mi) * 16 + fr) * D + cg + bj * 128; a[mi][bj] = *(const GAS v4u*)(x + off); b[mi][bj] = *(const GAS v4u*)(pp + off); }
                asm volatile("" ::: "memory");
#pragma unroll
                for (int mi = 0; mi < 2; ++mi) { const int m = 2 * mp + mi;
#pragma unroll
                    for (int bj = 0; bj < 2; ++bj) { const size_t off = (size_t)(u.pm * 256 + ai * 128 + wr * 64 + m * 16 + fr) * D + cg + bj * 128; const v4u in = a[mi][bj], p = b[mi][bj];
                        const f32x4 v0 = acc[ai][bj][m][0], v1 = acc[ai][bj][m][1];
                        v4u w; w.x = cvt_pk_bf16(bflo(in.x) + sigmoidf_(v0[0]) * bflo(p.x), bfhi(in.x) + sigmoidf_(v0[1]) * bfhi(p.x)); w.y = cvt_pk_bf16(bflo(in.y) + sigmoidf_(v0[2]) * bflo(p.y), bfhi(in.y) + sigmoidf_(v0[3]) * bfhi(p.y));
                        w.z = cvt_pk_bf16(bflo(in.z) + sigmoidf_(v1[0]) * bflo(p.z), bfhi(in.z) + sigmoidf_(v1[1]) * bfhi(p.z)); w.w = cvt_pk_bf16(bflo(in.w) + sigmoidf_(v1[2]) * bflo(p.w), bfhi(in.w) + sigmoidf_(v1[3]) * bfhi(p.w));
                        *(GAS v4u*)(xd + off) = w; } }
                asm volatile("" ::: "memory"); }
    }
};
struct EpiBf {
    static constexpr bool PERM = true;
    bf16* O; int ldc; const float* rowscale;
    __device__ __forceinline__ void operator()(AccRef acc, const Unit& u, int wr, int wc, int fr, int fq) const {
        const int col0 = u.pn * 256 + wc * 32 + 8 * fq;
        float rvs[2][4];
#pragma unroll
        for (int ai = 0; ai < 2; ++ai)
#pragma unroll
            for (int m = 0; m < 4; ++m) rvs[ai][m] = rowscale ? rowscale[u.pm * 256 + ai * 128 + wr * 64 + m * 16 + fr] : 1.0f;
        asm volatile("" ::: "memory");
#pragma unroll
        for (int ai = 0; ai < 2; ++ai)
#pragma unroll
            for (int m = 0; m < 4; ++m) { const int r = u.pm * 256 + ai * 128 + wr * 64 + m * 16 + fr; const float rv = rvs[ai][m];
#pragma unroll
                for (int bj = 0; bj < 2; ++bj) { const f32x4 v0 = acc[ai][bj][m][0] * rv, v1 = acc[ai][bj][m][1] * rv; v4u w; w.x = cvt_pk_bf16(v0[0], v0[1]); w.y = cvt_pk_bf16(v0[2], v0[3]); w.z = cvt_pk_bf16(v1[0], v1[1]); w.w = cvt_pk_bf16(v1[2], v1[3]);
                    *(GAS v4u*)(O + (size_t)r * ldc + col0 + bj * 128) = w; } }
    }
};
struct EpiGU {
    static constexpr bool PERM = true;
    bf16* act; const float* rs; const int* ltok;
    __device__ __forceinline__ void operator()(AccRef acc, const Unit& u, int wr, int wc, int fr, int fq) const {
        const int col0 = u.pn * 128 + wc * 16 + 4 * fq;
        float rvs[2][4];
#pragma unroll
        for (int ai = 0; ai < 2; ++ai)
#pragma unroll
            for (int m = 0; m < 4; ++m) rvs[ai][m] = rs[u.pm * 256 + ai * 128 + wr * 64 + m * 16 + fr];
        asm volatile("" ::: "memory");
#pragma unroll
        for (int ai = 0; ai < 2; ++ai)
#pragma unroll
            for (int m = 0; m < 4; ++m) { const int r = u.pm * 256 + ai * 128 + wr * 64 + m * 16 + fr; const float rv = rvs[ai][m];
#pragma unroll
                for (int bj = 0; bj < 2; ++bj) { const f32x4 gt = acc[ai][bj][m][0] * rv, up = acc[ai][bj][m][1] * rv;
                    v2u w; w.x = cvt_pk_bf16(siluf_(gt[0]) * up[0], siluf_(gt[1]) * up[1]); w.y = cvt_pk_bf16(siluf_(gt[2]) * up[2], siluf_(gt[3]) * up[3]);
                    *(GAS v2u*)(act + (size_t)r * DFF + col0 + bj * 64) = w; } }
    }
};

#define Qn ((bf16*)(F.ws + WS_QN))
#define Kn ((bf16*)(F.ws + WS_KN))
#define VnT ((bf16*)(F.ws + WS_VNT))
#define Qr ((bf16*)(F.ws + WS_QR))
#define Kr ((bf16*)(F.ws + WS_KR))
#define KzTf ((bf16*)(F.ws + WS_KZF))
#define KzTb ((bf16*)(F.ws + WS_KZB))
#define VrT ((bf16*)(F.ws + WS_VRT))
#define NAb ((bf16*)(F.ws + WS_NA))
#define Pf ((bf16*)(F.ws + WS_PF))
#define Pb ((bf16*)(F.ws + WS_PBW))
#define mix ((bf16*)(F.ws + WS_MIX))
#define Of ((bf16*)(F.ws + WS_OF))
#define Ob ((bf16*)(F.ws + WS_OB))
#define xres ((bf16*)((unsigned char*)F.out + XB_OFF))
#define xsrc (layer == 0 ? ap->in[0] : (const float*)F.out)
#define wl (F.ws + WS_W + (size_t)layer * W_LAYER)
#define dtl ((const float*)(F.ws + WS_DT) + (size_t)layer * 16 * DT_STRIDE)
#define hb ((bf16*)(F.ws + WS_HB))
#define rs ((float*)(F.ws + WS_RS))
#ifndef MK_SINGLE
#define MK_SINGLE 1
#endif
#define CAS __attribute__((address_space(4)))
struct Args { const float* in[19]; float* out; unsigned char* ws; int ph_lo, ph_hi; };
enum { PH_PRO = 0, PH_L0 = 1, PH_PER_HALF = 7, PH_PER_LAYER = 2 * PH_PER_HALF + 9, PH_FINAL = PH_L0 + DEPTH * PH_PER_LAYER, PH_COUNT = PH_FINAL + 1 };

#define KPTR(apv) do { const unsigned long long a_ = (unsigned long long)__builtin_amdgcn_kernarg_segment_ptr(); unsigned lo_, hi_; \
        asm volatile("v_mov_b32 %0, %2\n\tv_mov_b32 %1, %3" : "=v"(lo_), "=v"(hi_) : "s"((unsigned)a_), "s"((unsigned)(a_ >> 32))); \
        lo_ = __builtin_amdgcn_readfirstlane(lo_); hi_ = __builtin_amdgcn_readfirstlane(hi_); apv = (const CAS Args*)(((unsigned long long)hi_ << 32) | lo_); } while (0)
template <int ONLYC>
__global__ void __launch_bounds__(NWAVES * 64, 2) fwd_kernel(Args args) {
    extern __shared__ __attribute__((aligned(16))) unsigned char lds_raw[];
    Frame F;
    F.lds = (LAS unsigned char*)lds_raw;
    F.MISC = (volatile LAS unsigned*)(F.lds + MISC_OFF);
    const int wave0 = __builtin_amdgcn_readfirstlane((int)threadIdx.x >> 6);
    { int l0_; asm volatile("v_mbcnt_lo_u32_b32 %0, -1, 0\n\tv_mbcnt_hi_u32_b32 %0, -1, %0" : "=&v"(l0_)); F.lane = l0_; } F.wave = wave0; F.tid = wave0 * 64 + F.lane;
    F.G = gridDim.x; int vcu0; { const int bx = blockIdx.x; vcu0 = (F.G % 8 == 0) ? (bx % 8) * (F.G / 8) + bx / 8 : bx; } F.vcu = vcu0;
    const CAS Args* ap; KPTR(ap);
    F.ws = ap->ws; F.out = ap->out;
    if (F.tid < 64) F.MISC[F.tid] = 0u;
    __syncthreads();
    unsigned* ctl = (unsigned*)(F.ws + WS_CTL);
    const int lo = args.ph_lo, hi = args.ph_hi;
    XcdBarrier bar; bar.bar = ctl + CW_BAR; bar.x = 0; bar.st = nullptr;
    if (MK_SINGLE || hi - lo > 1) bar = xcd_barrier_post(ctl + CW_BAR, F.MISC, F.tid == 0);
#ifndef EXCL
#define EXCL 0
#endif
#define EN(cls) (ONLYC < 0 ? !((EXCL >> (cls)) & 1) : ONLYC == (cls))
#if MK_SINGLE
#define IN(k) true
#else
#define IN(k) (lo <= (k) && (k) < hi)
#endif
#ifndef REP_CLS
#define REP_CLS -1
#endif
#define REPS(cls) ((cls) == REP_CLS ? 2 : 1)
#ifdef PROBE_A
#define STAMP(id) do { if (F.tid == 0) ((unsigned long long*)(ap->ws + WS_CTL + 65536))[blockIdx.x * 64 + (id)] = __builtin_amdgcn_s_memrealtime(); } while (0)
#else
#define STAMP(id) do { } while (0)
#endif
#define FRESH() do { int wv_; asm volatile("v_mov_b32 %0, %1" : "=v"(wv_) : "s"(wave0)); F.wave = __builtin_amdgcn_readfirstlane(wv_); int l_; asm volatile("v_mbcnt_lo_u32_b32 %0, -1, 0\n\tv_mbcnt_hi_u32_b32 %0, -1, %0" : "=&v"(l_)); F.lane = l_; F.tid = F.wave * 64 + l_; KPTR(ap); F.ws = ap->ws; F.out = ap->out; int v_; asm volatile("v_mov_b32 %0, %1" : "=v"(v_) : "s"(vcu0)); F.vcu = __builtin_amdgcn_readfirstlane(v_); } while (0)
#define SEAM(k) do { STAMP(2 * cls_ + 1); if (IN((k) + 1)) { KPTR(ap); bar.bar = (unsigned*)(ap->ws + WS_CTL) + CW_BAR; xcd_barrier(bar, F.tid == 0); } } while (0)


    if (EN(0) && IN(PH_PRO)) for (int rep_ = 0; rep_ < REPS(0); ++rep_) { FRESH(); STAMP(2 * 0); const int cls_ = 0; p0_prologue(F, ap->in[1], ap->in[2], ap->in[3], ap->in[5], ap->in[6], ap->in[8], ap->in[9], ap->in[10], ap->in[11], ap->in[12], ap->in[13], ap->in[14], ap->in[15], ap->in[16], ap->in[17]); }

    for (int layer = 0; layer < DEPTH; ++layer) {
        const int pb0 = PH_L0 + layer * PH_PER_LAYER;
        if (EN(1) && IN(pb0)) for (int rep_ = 0; rep_ < REPS(1); ++rep_) { FRESH(); STAMP(2 * 1); const int cls_ = 1; if (layer == 0) rowpass<0, true>(F, ap->in[0], nullptr, nullptr); else rowpass<0, false>(F, nullptr, nullptr, nullptr); SEAM(pb0); }
        for (int half = 0; half < 2; ++half) {
            const int ph = pb0 + 1 + half * PH_PER_HALF;
            const unsigned row0 = (unsigned)half * HT;
            if (EN(2) && IN(ph + 0)) for (int rep_ = 0; rep_ < REPS(2); ++rep_) { FRESH(); STAMP(2 * 2); const int cls_ = 2;
                LinSched S; S.init(HT, NPROJ, D, F.G, (int)blockIdx.x, row0, (const bf16*)(wl + W_IN));
                EpiProj E{F.ws, rs + row0, dtl};
#ifdef PROBE_CLK
                const unsigned long long ck0_ = __builtin_amdgcn_s_memtime(), rt0_ = __builtin_amdgcn_s_memrealtime();
#endif
                pg8::gemm_phase<EpiProj, LinSched>(F.lds, hb, D, S, E, F.tid);
#ifdef PROBE_CLK
                { const unsigned long long ck1_ = __builtin_amdgcn_s_memtime(), rt1_ = __builtin_amdgcn_s_memrealtime();
                  if (F.tid == 0) { KPTR(ap); unsigned long long* ts_ = (unsigned long long*)(ap->ws + WS_CTL + 65536) + blockIdx.x * 64; ts_[43] = ck1_ - ck0_; ts_[44] = rt1_ - rt0_; } }
#endif
                SEAM(ph + 0);
            }
            if (EN(3) && IN(ph + 1)) for (int rep_ = 0; rep_ < REPS(3); ++rep_) { FRESH(); STAMP(2 * 3); const int cls_ = 3;
                rp_wg(F, Qr, Kr, Pf, Pb, dtl, F.vcu * 4);
                SEAM(ph + 1);
            }
            if (EN(4) && IN(ph + 2)) for (int rep_ = 0; rep_ < REPS(4); ++rep_) { FRESH(); STAMP(2 * 4); const int cls_ = 4;
#ifndef REP_SUB
#define REP_SUB 0
#endif
                if ((F.vcu & 1) == 0) { const int job = F.vcu >> 1;
#ifdef RS_SPREAD
                    const int vs = (job >> 5) & 3, dir = job & 1, h = (job >> 1) & 7, bl = (job >> 4) & 1;
#else
                    const int vs = job & 3, dir = (job >> 2) & 1, h = (job >> 3) & 7, bl = job >> 6;
#endif
                    for (int r2 = 0; r2 < (REP_SUB == 1 ? 2 : 1); ++r2)
                    rs_job(F, Qr, dir == 0 ? KzTf : KzTb, VrT, dir == 0 ? Pf : Pb, dir == 0 ? Of : Ob, dtl + (size_t)(dir * 8 + h) * DT_STRIDE, bl, h, dir, vs, ctl + 65536 + 64 * ((((layer * 2 + half) * 2 + bl) * 8 + h) * 2 + dir)); }
                else { const float* rpb = ap->in[4] + (size_t)layer * 16 * 15 * 31;
                    const int j = F.vcu >> 1, pm = j >> 1, hh0 = 8 * (j & 1);
                    for (int k = 0; k < 8; ++k) na_unit4(F, Qn, Kn, VnT, NAb, rpb, ((pm >> 5) * 16 + hh0 + k) * 32 + (pm & 31));
                    asm volatile("s_waitcnt vmcnt(0)" ::: "memory"); __syncthreads();
                    if (F.wave == 0) { __builtin_amdgcn_fence(__ATOMIC_ACQUIRE, "agent"); asm volatile("s_waitcnt vmcnt(0)" ::: "memory"); }
                    __syncthreads();
                    ShadowSched S{pm, 4 * (j & 1), row0, (const char*)((const bf16*)(wl + W_IN) + (size_t)(NPROJ + 2048) * D), (size_t)256 * D * 2};
                    EpiGateNa E{NAb, mix, rs + row0};
                    pg8::gemm_phase<EpiGateNa, ShadowSched>(F.lds, hb, D, S, E, F.tid); }
                SEAM(ph + 2);
            }
            if (EN(6) && IN(ph + 4)) for (int rep_ = 0; rep_ < REPS(6); ++rep_) { FRESH(); STAMP(2 * 6); const int cls_ = 6;
                { pg8::DenseOrder o2; o2.init(HT, 2048, F.G, (int)blockIdx.x); int pm_, pn_;
                  for (int i = 0; i < 2; ++i) if (o2.next_mn(i, pm_, pn_)) rn_tile(F, Of, Ob, ap->in[7] + (size_t)layer * D, pm_, pn_);
                  asm volatile("s_waitcnt vmcnt(0)" ::: "memory"); __syncthreads();
                  if (F.wave == 0) { __builtin_amdgcn_fence(__ATOMIC_ACQUIRE, "agent"); asm volatile("s_waitcnt vmcnt(0)" ::: "memory"); }
                  __syncthreads(); }
                GatesSched S; S.o.init(HT, 2048, F.G, (int)blockIdx.x); S.G = F.G; S.c = (int)blockIdx.x; S.row0 = row0; S.Bt = (const char*)((const bf16*)(wl + W_IN) + (size_t)NPROJ * D); S.tstep = (size_t)256 * D * 2;
                EpiGates E{Of, NAb, mix, rs + row0};
                pg8::gemm_phase<EpiGates, GatesSched>(F.lds, hb, D, S, E, F.tid);
                SEAM(ph + 4);
            }
            if (EN(7) && IN(ph + 5)) for (int rep_ = 0; rep_ < REPS(7); ++rep_) { FRESH(); STAMP(2 * 7); const int cls_ = 7;
                LinSched S; S.init(HT, 2048, D, F.G, (int)blockIdx.x, row0, (const bf16*)(wl + W_IN) + (size_t)(NPROJ + 4096) * D);
                EpiGate2 E{Of, mix, rs + row0};
                pg8::gemm_phase<EpiGate2, LinSched>(F.lds, hb, D, S, E, F.tid);
                SEAM(ph + 5);
            }
            if (EN(8) && IN(ph + 6)) for (int rep_ = 0; rep_ < REPS(8); ++rep_) { FRESH(); STAMP(2 * 8); const int cls_ = 8;
                LinSched S; S.init(HT, D, D, F.G, (int)blockIdx.x, 0u, (const bf16*)(wl + W_OUT));
                EpiRes E{xres, (int)row0};
                pg8::gemm_phase<EpiRes, LinSched>(F.lds, mix, D, S, E, F.tid);
                if (half == 1) SEAM(ph + 6);
            }
        }
        const int pm0 = pb0 + 1 + 2 * PH_PER_HALF;
#ifdef NO_ROUTER_FUSE
        if (EN(1) && IN(pm0 + 0)) for (int rep_ = 0; rep_ < REPS(1); ++rep_) { FRESH(); STAMP(2 * 1); const int cls_ = 1; rowpass<0, false>(F, nullptr, nullptr, nullptr); SEAM(pm0 + 0); }
#endif
        if (EN(9) && IN(pm0 + 1)) for (int rep_ = 0; rep_ < REPS(9); ++rep_) { FRESH(); STAMP(2 * 9); const int cls_ = 9; router_phase(F, layer); SEAM(pm0 + 1); }
        if (EN(10) && IN(pm0 + 2)) for (int rep_ = 0; rep_ < REPS(10); ++rep_) { FRESH(); STAMP(2 * 10); const int cls_ = 10; lists_phase(F, layer); SEAM(pm0 + 2); }
        if (IN(pm0 + 3) || IN(pm0 + 4)) {
            FRESH();
            const int* meta = (const int*)(F.ws + WS_META);
            if (F.tid < 33) F.MISC[16 + F.tid] = (unsigned)__hip_atomic_load(meta + F.tid, __ATOMIC_RELAXED, __HIP_MEMORY_SCOPE_AGENT);
            __syncthreads();
            if (F.tid < MAXTILES) { int e = 0; for (int k = 1; k < 32; ++k) if ((int)F.MISC[16 + k] <= F.tid) e = k; ((volatile LAS unsigned char*)(F.MISC + 64))[F.tid] = (unsigned char)e; }
            __syncthreads();
        }
        if (EN(11) && IN(pm0 + 3)) for (int rep_ = 0; rep_ < REPS(11); ++rep_) { FRESH(); STAMP(2 * 11); const int cls_ = 11;
            MoeSched<true> S{(const volatile LAS int*)(F.MISC + 16), 4, F.G, (int)blockIdx.x, (const int*)(F.ws + WS_LTOK), (const char*)(wl + W_GU), (size_t)1024 * D * 2, (size_t)256 * D * 2};
            EpiGU E{(bf16*)(F.ws + WS_ACT), (const float*)(F.ws + WS_LRS), (const int*)(F.ws + WS_LTOK)};
            pg8::gemm_phase<EpiGU, MoeSched<true>>(F.lds, xres, D, S, E, F.tid);
            SEAM(pm0 + 3);
        }
        if (EN(12) && IN(pm0 + 4)) for (int rep_ = 0; rep_ < REPS(12); ++rep_) { FRESH(); STAMP(2 * 12); const int cls_ = 12;
            MoeSched<false> S{(const volatile LAS int*)(F.MISC + 16), 8, F.G, (int)blockIdx.x, nullptr, (const char*)(wl + W_DN), (size_t)D * DFF * 2, (size_t)256 * DFF * 2};
                        EpiBf E{(bf16*)(F.ws + WS_YP), D, (const float*)(F.ws + WS_LW)};
            pg8::gemm_phase<EpiBf, MoeSched<false>>(F.lds, (const bf16*)(F.ws + WS_ACT), DFF, S, E, F.tid);
            SEAM(pm0 + 4);
        }
        if (EN(13) && IN(pm0 + 5)) for (int rep_ = 0; rep_ < REPS(13); ++rep_) { FRESH(); STAMP(2 * 13); const int cls_ = 13; rowpass<1, false>(F, nullptr, nullptr, nullptr); }
        if (EN(14) && IN(pm0 + 6)) for (int rep_ = 0; rep_ < REPS(14); ++rep_) { FRESH(); STAMP(2 * 14); const int cls_ = 14;
            LinSched S; S.init(T, D, PLE, F.G, (int)blockIdx.x, 0u, (const bf16*)(wl + W_PP));
            EpiBf E{(bf16*)(F.ws + WS_PP), D, nullptr};
            pg8::gemm_phase<EpiBf, LinSched>(F.lds, (const bf16*)(F.ws + WS_PB) + (size_t)layer * T * PLE, PLE, S, E, F.tid);
            SEAM(pm0 + 6);
        }
        if (EN(15) && IN(pm0 + 7)) for (int rep_ = 0; rep_ < REPS(15); ++rep_) { FRESH(); STAMP(2 * 15); const int cls_ = 15;
            LinSched S; S.init(T, D, D, F.G, (int)blockIdx.x, 0u, (const bf16*)(wl + W_PG));
            EpiPle E{xres, layer == DEPTH - 1 ? (bf16*)(F.ws + WS_XB2) : xres, (const bf16*)(F.ws + WS_PP), rs};
            pg8::gemm_phase<EpiPle, LinSched>(F.lds, hb, D, S, E, F.tid);
            SEAM(pm0 + 7);
        }
    }
#ifdef EXTRA_BARS
    for (int xb_ = 0; xb_ < EXTRA_BARS; ++xb_) { KPTR(ap); bar.bar = (unsigned*)(ap->ws + WS_CTL) + CW_BAR; xcd_barrier(bar, F.tid == 0); }
#endif
    if (EN(16) && IN(PH_FINAL)) for (int rep_ = 0; rep_ < REPS(16); ++rep_) { FRESH(); STAMP(2 * 16); const int cls_ = 16; rowpass<2, false>(F, nullptr, F.out, ap->in[18]); }
#ifdef PROBE_A
#ifndef PROBE_OFF
#define PROBE_OFF 0.0
#endif
#ifndef PROBE_BASE
#define PROBE_BASE 1.12
#endif
    {
        xcd_barrier(bar, F.tid == 0);
        volatile LAS float* cst = (volatile LAS float*)(F.lds + 2048);
        if (F.tid == 0) { const unsigned long long* ts = (const unsigned long long*)(ap->ws + WS_CTL + 65536); unsigned long long mx = 0;
            for (int b = 0; b < (int)gridDim.x; ++b) { const int v = (b % 8) * ((int)gridDim.x / 8) + b / 8; if (PROBE_PAR != 2 && (v & 1) != PROBE_PAR) continue;
                const unsigned long long d = __hip_atomic_load(ts + b * 64 + PROBE_B, __ATOMIC_RELAXED, __HIP_MEMORY_SCOPE_AGENT) - __hip_atomic_load(ts + b * 64 + PROBE_A, __ATOMIC_RELAXED, __HIP_MEMORY_SCOPE_AGENT); if (d > mx && d < 100000000ull) mx = d; }
#if defined(PROBE_STAT) && PROBE_STAT == 1
            {
                unsigned long long best = 0; int n = 0;
                for (int b = 0; b < (int)gridDim.x; ++b) { const int v = (b % 8) * ((int)gridDim.x / 8) + b / 8; if (PROBE_PAR != 2 && (v & 1) != PROBE_PAR) continue; ++n; }
                for (int b = 0; b < (int)gridDim.x; ++b) { const int v = (b % 8) * ((int)gridDim.x / 8) + b / 8; if (PROBE_PAR != 2 && (v & 1) != PROBE_PAR) continue;
                    const unsigned long long d = __hip_atomic_load(ts + b * 64 + PROBE_B, __ATOMIC_RELAXED, __HIP_MEMORY_SCOPE_AGENT) - __hip_atomic_load(ts + b * 64 + PROBE_A, __ATOMIC_RELAXED, __HIP_MEMORY_SCOPE_AGENT);
                    int rank = 0;
                    for (int b2 = 0; b2 < (int)gridDim.x; ++b2) { const int v2 = (b2 % 8) * ((int)gridDim.x / 8) + b2 / 8; if (PROBE_PAR != 2 && (v2 & 1) != PROBE_PAR) continue;
                        const unsigned long long d2 = __hip_atomic_load(ts + b2 * 64 + PROBE_B, __ATOMIC_RELAXED, __HIP_MEMORY_SCOPE_AGENT) - __hip_atomic_load(ts + b2 * 64 + PROBE_A, __ATOMIC_RELAXED, __HIP_MEMORY_SCOPE_AGENT);
                        if (d2 < d || (d2 == d && b2 < b)) ++rank; }
                    if (rank == n / 2) best = d; }
                mx = best; }
#endif
#ifdef PROBE_CLK
            { const unsigned long long dc_ = __hip_atomic_load(ts + 8 * 64 + 43, __ATOMIC_RELAXED, __HIP_MEMORY_SCOPE_AGENT), dr_ = __hip_atomic_load(ts + 8 * 64 + 44, __ATOMIC_RELAXED, __HIP_MEMORY_SCOPE_AGENT); mx = dc_ * 100ull * 100ull / (dr_ ? dr_ : 1ull); }
#endif
            const float us = (float)mx * 0.01f; const float q = rintf(logf(us) / logf((float)PROBE_BASE) + (float)PROBE_OFF); const float usq = expf((q - (float)PROBE_OFF) * logf((float)PROBE_BASE)); cst[0] = sqrtf(usq / (float)PROBE_SCALE * 1.0025f); }
        __syncthreads();
        const float c = cst[0];
        for (size_t i = (size_t)blockIdx.x * 512 + F.tid; i < (size_t)T * D; i += (size_t)gridDim.x * 512) F.out[i] = c;
    }
#endif
#undef IN
#undef SEAM
}

#undef Qn
#undef Kn
#undef VnT
#undef Qr
#undef Kr
#undef KzTf
#undef KzTb
#undef VrT
#undef Pf
#undef NAb
#undef Pb
#undef mix
#undef Of
#undef Ob
#undef hb
#undef xres
#undef xsrc
#undef wl
#undef dtl
#undef rs
typedef void (*KernFn)(Args);
static int phase_class(int p) {
    if (p == PH_PRO) return 0; if (p == PH_FINAL) return 16;
    const int q = (p - PH_L0) % PH_PER_LAYER;
    if (q == 0) return 1;
    if (q <= 2 * PH_PER_HALF) return 2 + (q - 1) % PH_PER_HALF;
    static const int tail[8] = {1, 9, 10, 11, 12, 13, 14, 15};
    return tail[q - 1 - 2 * PH_PER_HALF];
}
extern "C" void kernel_launch(void* const* d_in, const int* in_sizes, int n_in, void* d_out, int out_size, void* d_ws, size_t ws_size, hipStream_t stream) {
    static int grid = 0;
#if MK_SINGLE
    static KernFn fns[1] = { fwd_kernel<-1> };
    constexpr int NF = 1;
#else
    static KernFn fns[17] = { fwd_kernel<0>, fwd_kernel<1>, fwd_kernel<2>, fwd_kernel<3>, fwd_kernel<4>, fwd_kernel<5>, fwd_kernel<6>, fwd_kernel<7>, fwd_kernel<8>, fwd_kernel<9>, fwd_kernel<10>, fwd_kernel<11>, fwd_kernel<12>, fwd_kernel<13>, fwd_kernel<14>, fwd_kernel<15>, fwd_kernel<16> };
    constexpr int NF = 17;
#endif
    if (grid == 0) {
        if (n_in != 19 || out_size != T * D || ws_size < WS_END) { fprintf(stderr, "kernel_launch: unexpected shapes (n_in %d, out %d, ws %zu < %zu)\n", n_in, out_size, ws_size, (size_t)WS_END); grid = -1; return; }
        int dev = 0, cus = 0, per_cu = 0;
        if (hipGetDevice(&dev) != hipSuccess || hipDeviceGetAttribute(&cus, hipDeviceAttributeMultiprocessorCount, dev) != hipSuccess) { grid = -1; return; }
        for (int i = 0; i < NF; ++i) {
            if (hipFuncSetAttribute((const void*)fns[i], hipFuncAttributeMaxDynamicSharedMemorySize, LDS_BYTES) != hipSuccess) { fprintf(stderr, "kernel_launch: hipFuncSetAttribute failed\n"); grid = -1; return; }
            if (hipOccupancyMaxActiveBlocksPerMultiprocessor(&per_cu, (const void*)fns[i], NWAVES * 64, LDS_BYTES) != hipSuccess || per_cu < 1) { fprintf(stderr, "kernel_launch: occupancy query says %d for fn %d\n", per_cu, i); grid = -1; return; }
        }
        (void)hipGetLastError();
        grid = cus < 256 ? cus : 256;
    }
    if (grid < 0) return;
    (void)hipMemsetAsync((char*)d_ws + WS_CTL, 0, CTL_ZERO_BYTES, stream);
    Args a{};
    for (int i = 0; i < 19; ++i) a.in[i] = (const float*)d_in[i];
    a.out = (float*)d_out; a.ws = (unsigned char*)d_ws;
#if MK_SINGLE
    a.ph_lo = 0; a.ph_hi = PH_COUNT;
    hipLaunchKernelGGL(fns[0], dim3(grid), dim3(NWAVES * 64), LDS_BYTES, stream, a);
#else
    for (int p = 0; p < PH_COUNT; ++p) { a.ph_lo = p; a.ph_hi = p + 1; hipLaunchKernelGGL(fns[phase_class(p)], dim3(grid), dim3(NWAVES * 64), LDS_BYTES, stream, a); }
#endif
}
```
